# Optimizing an MI355X kernel written in HIP

```python
import math
import jax, jax.numpy as jnp
from jax import lax
import numpy as np

D_MODEL = 1024
BATCH = 16
SEQ = 2048
DEPTH = 1

CHUNK = 64
Q_BLOCK = 128
FOX_HEADS = 8
FOX_HEAD_DIM = 64
FOX_WIDTH = FOX_HEADS * FOX_HEAD_DIM
MLSTM_HEADS = 4
MLSTM_INNER = D_MODEL
MLSTM_V_DIM = MLSTM_INNER // MLSTM_HEADS
MLSTM_QK_DIM = MLSTM_V_DIM // 2
CONV_WIDTH = 4
D_FF = -(-(8 * D_MODEL) // (3 * 256)) * 256
FOX_FORGET_BIAS = 3.0
MLSTM_FORGET_BIAS = 3.0
LN_EPS = 1e-5
IN_SPLITS = (FOX_WIDTH, FOX_WIDTH, FOX_WIDTH, FOX_HEADS,
             MLSTM_INNER, MLSTM_INNER, MLSTM_HEADS, MLSTM_HEADS, MLSTM_INNER,
             D_MODEL, D_MODEL)
D_IN = sum(IN_SPLITS)

kernel_name = "hybrid_fox_mlstm_adaln_deepnorm_block"


def _ln(x, g=None, b=None):
    xf = x.astype(jnp.float32)
    mu = jnp.mean(xf, axis=-1, keepdims=True)
    var = jnp.mean(jnp.square(xf - mu), axis=-1, keepdims=True)
    y = ((xf - mu) * lax.rsqrt(var + LN_EPS)).astype(x.dtype)
    if g is not None:
        y = y * g + b
    return y


def _forgetting_attention(q, k, v, f_logit):
    B, S, H, d = q.shape
    log_f = jax.nn.log_sigmoid(f_logit.astype(jnp.float32))
    F = jnp.cumsum(log_f, axis=1).transpose(0, 2, 1)
    q = q.transpose(0, 2, 1, 3)
    k = k.transpose(0, 2, 1, 3)
    v = v.transpose(0, 2, 1, 3)
    scale = d ** -0.5
    outs = []
    for start in range(0, S, Q_BLOCK):
        end = start + Q_BLOCK
        logits = jnp.einsum('bhqd,bhkd->bhqk', q[:, :, start:end], k[:, :, :end]).astype(jnp.float32) * scale
        logits = logits + F[:, :, start:end, None] - F[:, :, None, :end]
        q_pos = jnp.arange(start, end)[:, None]
        k_pos = jnp.arange(end)[None, :]
        logits = jnp.where(k_pos <= q_pos, logits, -jnp.inf)
        p = jax.nn.softmax(logits, axis=-1).astype(v.dtype)
        outs.append(jnp.einsum('bhqk,bhkd->bhqd', p, v[:, :, :end]))
    o = jnp.concatenate(outs, axis=2)
    return o.transpose(0, 2, 1, 3).reshape(B, S, H * d)


def _mlstm_chunkwise(q, k, v, i_pre, f_pre):
    out_dtype = v.dtype
    B, S, H, dk = q.shape
    dv = v.shape[-1]
    NC, L = S // CHUNK, CHUNK
    f32 = jnp.float32
    q = (q.astype(f32) * dk ** -0.5).reshape(B, NC, L, H, dk).transpose(0, 3, 1, 2, 4)
    k = k.astype(f32).reshape(B, NC, L, H, dk).transpose(0, 3, 1, 2, 4)
    v = v.astype(f32).reshape(B, NC, L, H, dv).transpose(0, 3, 1, 2, 4)
    ig = i_pre.astype(f32).reshape(B, NC, L, H).transpose(0, 3, 1, 2)
    lf = jax.nn.log_sigmoid(f_pre.astype(f32)).reshape(B, NC, L, H).transpose(0, 3, 1, 2)
    b = jnp.cumsum(lf, axis=-1)
    g = b[..., -1]
    a = g[..., None] - b + ig

    def step(carry, xs):
        C, n, m = carry
        k_c, v_c, a_c, g_c = xs
        m_new = jnp.maximum(g_c + m, jnp.max(a_c, axis=-1))
        decay = jnp.exp(g_c + m - m_new)
        w = jnp.exp(a_c - m_new[..., None])
        C_new = decay[..., None, None] * C + jnp.einsum('bhl,bhlk,bhlv->bhkv', w, k_c, v_c)
        n_new = decay[..., None] * n + jnp.einsum('bhl,bhlk->bhk', w, k_c)
        return (C_new, n_new, m_new), (C, n, m)

    init = (jnp.zeros((B, H, dk, dv), f32), jnp.zeros((B, H, dk), f32), jnp.zeros((B, H), f32))
    xs = (k.transpose(2, 0, 1, 3, 4), v.transpose(2, 0, 1, 3, 4),
          a.transpose(2, 0, 1, 3), g.transpose(2, 0, 1))
    _, (C_prev, n_prev, m_prev) = lax.scan(step, init, xs)
    C_prev = C_prev.transpose(1, 2, 0, 3, 4)
    n_prev = n_prev.transpose(1, 2, 0, 3)
    m_prev = m_prev.transpose(1, 2, 0)

    causal = jnp.tril(jnp.ones((L, L), dtype=bool))
    D = jnp.where(causal, b[..., :, None] - b[..., None, :] + ig[..., None, :], -jnp.inf)
    inter = b + m_prev[..., None]
    m_t = jnp.maximum(inter, jnp.max(D, axis=-1))
    scores = jnp.einsum('bhcld,bhcsd->bhcls', q, k) * jnp.exp(D - m_t[..., None])
    w_inter = jnp.exp(inter - m_t)
    num = (w_inter[..., None] * jnp.einsum('bhcld,bhcdv->bhclv', q, C_prev)
           + jnp.einsum('bhcls,bhcsv->bhclv', scores, v))
    den = w_inter * jnp.einsum('bhcld,bhcd->bhcl', q, n_prev) + jnp.sum(scores, axis=-1)
    h = num / jnp.maximum(jnp.abs(den), jnp.exp(-m_t))[..., None]
    return h.transpose(0, 2, 3, 1, 4).reshape(B, S, H * dv).astype(out_dtype)


def _causal_depthwise_conv(u, w, b):
    out = lax.conv_general_dilated(u, w[:, None, :], window_strides=(1,),
                                   padding=[(CONV_WIDTH - 1, 0)],
                                   dimension_numbers=('NWC', 'WIO', 'NWC'),
                                   feature_group_count=u.shape[-1])
    return out + b


def _head_norm(h, g, n_heads):
    B, S, W = h.shape
    return _ln(h.reshape(B, S, n_heads, W // n_heads)).reshape(B, S, W) * g


def _hybrid_mixer(h, w_in, b_in, conv_w, conv_b, w_mq, w_mk, mh_norm_g, w_pa, w_pb, w_out):
    B, S, _ = h.shape
    proj = jnp.einsum('bsd,de->bse', h, w_in) + b_in
    fq, fk, fv, ff, mu, mv, mi, mf, mo, ga, gb = jnp.split(
        proj, np.cumsum(IN_SPLITS)[:-1].tolist(), axis=-1)
    shp = (B, S, FOX_HEADS, FOX_HEAD_DIM)
    att = _forgetting_attention(fq.reshape(shp), fk.reshape(shp), fv.reshape(shp), ff)
    u = jax.nn.silu(_causal_depthwise_conv(mu, conv_w, conv_b))
    uh = u.reshape(B, S, MLSTM_HEADS, MLSTM_V_DIM)
    mq = jnp.einsum('bshi,hik->bshk', uh, w_mq)
    mk = jnp.einsum('bshi,hik->bshk', uh, w_mk)
    hm = _mlstm_chunkwise(mq, mk, mv.reshape(B, S, MLSTM_HEADS, MLSTM_V_DIM), mi, mf)
    hm = _head_norm(hm, mh_norm_g, MLSTM_HEADS) * jax.nn.sigmoid(mo)
    y = (jax.nn.sigmoid(ga) * jnp.einsum('bsi,id->bsd', att, w_pa)
         + jax.nn.sigmoid(gb) * jnp.einsum('bsi,id->bsd', hm, w_pb))
    return jnp.einsum('bsd,de->bse', y, w_out)


def _swiglu(h, w_ffn_in, w_ffn_down):
    gate, up = jnp.split(jnp.einsum('bsd,df->bsf', h, w_ffn_in), 2, axis=-1)
    return jnp.einsum('bsf,fd->bsd', jax.nn.silu(gate) * up, w_ffn_down)


def setup_inputs(seed: int = 0) -> dict:
    key = jax.random.key(seed)
    ks = jax.random.split(key, 24)
    f32 = jnp.float32
    beta = (8.0 * DEPTH) ** -0.25
    nrm = lambda k, shape, s: jax.random.normal(k, shape, f32) * s
    ada_offset = jnp.concatenate([jnp.zeros((2 * D_MODEL,), f32), jnp.ones((D_MODEL,), f32),
                                  jnp.zeros((2 * D_MODEL,), f32), jnp.ones((D_MODEL,), f32)])
    parts = [jnp.zeros((n,), f32) for n in IN_SPLITS]
    parts[3] = jnp.full((FOX_HEADS,), FOX_FORGET_BIAS, f32)
    parts[7] = jnp.full((MLSTM_HEADS,), MLSTM_FORGET_BIAS, f32)
    in_offset = jnp.concatenate(parts)
    return {
        "x": nrm(ks[0], (BATCH, SEQ, D_MODEL), 1.0),
        "c": nrm(ks[1], (BATCH, D_MODEL), 1.0),
        "w_ada": nrm(ks[2], (DEPTH, D_MODEL, 6 * D_MODEL), 0.3 * D_MODEL ** -0.5),
        "b_ada": nrm(ks[3], (DEPTH, 6 * D_MODEL), 0.02) + ada_offset,
        "w_in": nrm(ks[4], (DEPTH, D_MODEL, D_IN), D_MODEL ** -0.5),
        "b_in": nrm(ks[5], (DEPTH, D_IN), 0.02) + in_offset,
        "conv_w": nrm(ks[6], (DEPTH, CONV_WIDTH, MLSTM_INNER), CONV_WIDTH ** -0.5),
        "conv_b": nrm(ks[7], (DEPTH, MLSTM_INNER), 0.02),
        "w_mq": nrm(ks[8], (DEPTH, MLSTM_HEADS, MLSTM_V_DIM, MLSTM_QK_DIM), MLSTM_V_DIM ** -0.5),
        "w_mk": nrm(ks[9], (DEPTH, MLSTM_HEADS, MLSTM_V_DIM, MLSTM_QK_DIM), MLSTM_V_DIM ** -0.5),
        "mh_norm_g": 1.0 + nrm(ks[10], (DEPTH, MLSTM_INNER), 0.02),
        "w_pa": nrm(ks[11], (DEPTH, FOX_WIDTH, D_MODEL), FOX_WIDTH ** -0.5),
        "w_pb": nrm(ks[12], (DEPTH, MLSTM_INNER, D_MODEL), MLSTM_INNER ** -0.5),
        "w_out": nrm(ks[13], (DEPTH, D_MODEL, D_MODEL), beta * D_MODEL ** -0.5),
        "ln1_g": 1.0 + nrm(ks[14], (DEPTH, D_MODEL), 0.02),
        "ln1_b": nrm(ks[15], (DEPTH, D_MODEL), 0.02),
        "w_ffn_in": nrm(ks[16], (DEPTH, D_MODEL, 2 * D_FF), D_MODEL ** -0.5),
        "w_ffn_down": nrm(ks[17], (DEPTH, D_FF, D_MODEL), beta * D_FF ** -0.5),
        "ln2_g": 1.0 + nrm(ks[18], (DEPTH, D_MODEL), 0.02),
        "ln2_b": nrm(ks[19], (DEPTH, D_MODEL), 0.02),
    }


def reference(x, c, w_ada, b_ada, w_in, b_in, conv_w, conv_b, w_mq, w_mk, mh_norm_g,
              w_pa, w_pb, w_out, ln1_g, ln1_b, w_ffn_in, w_ffn_down, ln2_g, ln2_b):
    alpha = (2.0 * DEPTH) ** 0.25
    for l in range(DEPTH):
        mod = jnp.einsum('bd,de->be', jax.nn.silu(c), w_ada[l]) + b_ada[l]
        sh1, sc1, g1, sh2, sc2, g2 = [m[:, None, :] for m in jnp.split(mod, 6, axis=-1)]
        h = _ln(x) * (1.0 + sc1) + sh1
        y = _hybrid_mixer(h, w_in[l], b_in[l], conv_w[l], conv_b[l], w_mq[l], w_mk[l],
                          mh_norm_g[l], w_pa[l], w_pb[l], w_out[l])
        x = _ln(alpha * x + g1 * y, ln1_g[l], ln1_b[l])
        h = _ln(x) * (1.0 + sc2) + sh2
        x = _ln(alpha * x + g2 * _swiglu(h, w_ffn_in[l], w_ffn_down[l]), ln2_g[l], ln2_b[l])
    return x
```

```cpp
#include <hip/hip_runtime.h>
#include <hip/hip_cooperative_groups.h>
#include <hip/hip_bf16.h>
#include <cmath>
#include <cstdio>
#include <cstdint>
namespace cg = cooperative_groups;

#ifndef FOX_REF_ATTN
#define FOX_REF_ATTN 1
#endif
#ifndef MK_N_LAUNCHES
#define MK_N_LAUNCHES 1
#endif

#define LAS __attribute__((address_space(3)))
typedef unsigned short bf16_t;
typedef short bf16x8 __attribute__((ext_vector_type(8)));
typedef short s16x4 __attribute__((ext_vector_type(4)));
typedef short v4i16_t __attribute__((ext_vector_type(4)));
typedef float f32x4 __attribute__((ext_vector_type(4)));
typedef float f32x2 __attribute__((ext_vector_type(2)));
typedef unsigned u32x4 __attribute__((ext_vector_type(4)));
typedef unsigned u32x2 __attribute__((ext_vector_type(2)));
typedef __bf16 bf16x2_t __attribute__((ext_vector_type(2)));

constexpr int BATCH = 16, SEQ = 2048, DM = 1024, MT = BATCH * SEQ;
constexpr int DIN = 6672, NP = 6656, DFF = 2816;
constexpr int C_FQ = 0, C_FK = 512, C_FV = 1024, C_MU = 1536, C_MV = 2560, C_MO = 3584, C_GA = 4608, C_GB = 5632;
constexpr float LN_EPS = 1e-5f, ALPHA = 1.189207115002721f, LOG2E = 1.4426950408889634f;
constexpr int LDS_BYTES = 147456;

constexpr size_t MiB = 1u << 20;
constexpr size_t WS_MOD = 1 * MiB, WS_WG = 2 * MiB, WS_BG = 2 * MiB + 65536, WS_FCUM = 3 * MiB, WS_G16 = 4 * MiB;
constexpr size_t WS_WT_IN = 8 * MiB, WS_WT_QK = 21 * MiB, WS_WT_PA = 22 * MiB, WS_WT_PB = 23 * MiB, WS_WT_OUT = 25 * MiB, WS_WT_FI = 27 * MiB, WS_WT_FD = 38 * MiB;
constexpr size_t WS_XB1 = 44 * MiB, WS_XB2 = 45 * MiB, WS_XB3 = 46 * MiB;
constexpr size_t WS_CNT = 65536;
constexpr size_t WS_PROJ = 48 * MiB;
constexpr size_t WS_ATT = 464 * MiB;
constexpr size_t WS_Z = 48 * MiB;
constexpr size_t WS_X1 = 176 * MiB;
constexpr size_t WS_ACT = 304 * MiB;
constexpr size_t WS_Z2 = 48 * MiB;
constexpr size_t DO_A = 0, DO_B = 64 * MiB;

__device__ __forceinline__ unsigned pk2(float lo, float hi) { f32x2 v = {lo, hi}; bf16x2_t b = __builtin_convertvector(v, bf16x2_t); return __builtin_bit_cast(unsigned, b); }
__device__ __forceinline__ float bflo(unsigned w) { return __uint_as_float(w << 16); }
__device__ __forceinline__ float bfhi(unsigned w) { return __uint_as_float(w & 0xffff0000u); }
__device__ __forceinline__ float sigmoidf_(float x) { return __builtin_amdgcn_rcpf(1.0f + __expf(-x)); }
__device__ __forceinline__ float logsig(float x) { return fminf(x, 0.f) - log1pf(expf(-fabsf(x))); }
__device__ __forceinline__ float wave_sum(float v) {
#pragma unroll
    for (int o = 1; o < 64; o <<= 1) v += __shfl_xor(v, o);
    return v;
}
__device__ __forceinline__ s16x4 vtr(const LAS unsigned char* p) { return __builtin_bit_cast(s16x4, __builtin_amdgcn_ds_read_tr16_b64_v4i16((LAS v4i16_t*)p)); }
#define LDS_WAIT() asm volatile("s_waitcnt lgkmcnt(0)" ::: "memory")
#define LBAR() do { asm volatile("s_waitcnt lgkmcnt(0)" ::: "memory"); __builtin_amdgcn_s_barrier(); asm volatile("" ::: "memory"); } while (0)

__device__ __forceinline__ void unpack8(const u32x4 w, float (&v)[8]) { v[0] = bflo(w.x); v[1] = bfhi(w.x); v[2] = bflo(w.y); v[3] = bfhi(w.y); v[4] = bflo(w.z); v[5] = bfhi(w.z); v[6] = bflo(w.w); v[7] = bfhi(w.w); }
__device__ __forceinline__ u32x4 pack8(const float (&v)[8]) { u32x4 w; w.x = pk2(v[0], v[1]); w.y = pk2(v[2], v[3]); w.z = pk2(v[4], v[5]); w.w = pk2(v[6], v[7]); return w; }
__device__ __forceinline__ void ld8f(const float* p, float (&v)[8]) { const f32x4 a = *(const f32x4*)p, b = *(const f32x4*)(p + 4); v[0] = a[0]; v[1] = a[1]; v[2] = a[2]; v[3] = a[3]; v[4] = b[0]; v[5] = b[1]; v[6] = b[2]; v[7] = b[3]; }

namespace pg8 {
constexpr int BM = 256, BK = 64, HALF = 128, HTB = HALF * BK * 2, STAGE_BYTES = 8 * HTB, NXCD = 8, WGM = 8;
__host__ __device__ __forceinline__ int lds_byte(int r, int c) { const int st = (r >> 4) * 2 + (c >> 5), rr = r & 15, cc = c & 31, ob = rr * 64 + cc * 2; return st * 1024 + (ob ^ (((ob >> 9) & 1) << 5)); }
__host__ __device__ __forceinline__ void stage_rc(int b, int& R, int& C) { const int st = b / 1024, sb = b % 1024, swz = sb ^ (((sb >> 9) & 1) << 5); R = (st >> 1) * 16 + swz / 64; C = (st & 1) * 32 + (swz % 64) / 2; }
__host__ __device__ __forceinline__ int perm32(int rho) { const int n = rho >> 4, i = rho & 15; return 8 * (i >> 2) + 4 * n + (i & 3); }

struct Unit { int pm, pn; };
struct Gemm { const bf16_t* A; const bf16_t* Bt; int M, N, K, lda, ldb, aoffN; };

struct StaticOrder {
    int nM, nN, nwg, G, c;
    __device__ void init(int M, int N, int G_, int c_) { nM = M / BM; nN = N / BM; nwg = nM * nN; G = G_; c = c_; }
    __device__ bool next(int i, Unit& u) const {
        const long L = (long)i * G + c; if (L >= nwg) return false;
        int wgid = (int)L; { const int q = nwg / NXCD, r = nwg % NXCD, xcd = wgid % NXCD, off = wgid / NXCD; wgid = (xcd < r ? xcd * (q + 1) : r * (q + 1) + (xcd - r) * q) + off; }
        const int nig = WGM * nN, gid = wgid / nig, fm = gid * WGM, gsz = (nM - fm) < WGM ? (nM - fm) : WGM;
        u.pm = fm + ((wgid % nig) % gsz); u.pn = (wgid % nig) / gsz; return true;
    }
};
template <class Epi, class Sched>
__device__ __forceinline__ void gemm_phase(LAS unsigned char* lds, const Gemm g, const Sched& S, const Epi& E) {
    const int tid = threadIdx.x, wid = __builtin_amdgcn_readfirstlane(tid >> 6), lane = tid & 63, wr = wid >> 2, wc = wid & 3, fr = lane & 15, fq = lane >> 4;
    const int K = g.K, nt = K / BK;
    unsigned voffA[2], voffB[2];
#pragma unroll
    for (int i = 0; i < 2; ++i) { int R, C; stage_rc(tid * 16 + i * 8192, R, C); const int Rb = Epi::PERM ? ((R & ~31) + perm32(R & 31)) : R;
        voffA[i] = (unsigned)(R * g.lda + C) * 2u; voffB[i] = (unsigned)(Rb * g.ldb + C) * 2u; }
    const size_t kstep = (size_t)(BK * 2);
    const size_t hstepA = (size_t)HALF * g.lda * 2, hstepB = (size_t)HALF * g.ldb * 2;
    const size_t tstepA = 2 * hstepA, tstepB = 2 * hstepB;
    const unsigned ldsw = (unsigned)wid * 1024u;
    const int aoff = lds_byte(wr * 64 + fr, fq * 8), boff = lds_byte(wc * 32 + fr, fq * 8);
#define PG8_SA(b, h) (((b) * 2 + (h)) * HTB)
#define PG8_SB(b, h) ((4 + (b) * 2 + (h)) * HTB)
#define PG8_STAGE(bufoff, gbase, voff) do { _Pragma("unroll") for (int _i = 0; _i < 2; ++_i) \
        __builtin_amdgcn_global_load_lds((const unsigned*)((const char*)(gbase) + (voff)[_i]), (LAS unsigned*)(lds + (bufoff) + ldsw + _i * 8192), 16, 0, 0); } while (0)
#define PG8_LDA(dst, b, h) do { _Pragma("unroll") for (int m = 0; m < 4; ++m) _Pragma("unroll") for (int k = 0; k < 2; ++k) dst[m][k] = *(const LAS bf16x8*)(lds + PG8_SA(b, h) + aoff + m * 2048 + k * 1024); } while (0)
#define PG8_LDB(dst, b, h) do { _Pragma("unroll") for (int n = 0; n < 2; ++n) _Pragma("unroll") for (int k = 0; k < 2; ++k) dst[n][k] = *(const LAS bf16x8*)(lds + PG8_SB(b, h) + boff + n * 2048 + k * 1024); } while (0)
#define PG8_MMA(ai, bj, At, Bt) do { __builtin_amdgcn_s_setprio(1); _Pragma("unroll") for (int m = 0; m < 4; ++m) _Pragma("unroll") for (int n = 0; n < 2; ++n) _Pragma("unroll") for (int k = 0; k < 2; ++k) \
        acc[ai][bj][m][n] = __builtin_amdgcn_mfma_f32_16x16x32_bf16(Bt[n][k], At[m][k], acc[ai][bj][m][n], 0, 0, 0); __builtin_amdgcn_s_setprio(0); } while (0)
#define PG8_WAIT_V(n) asm volatile("s_waitcnt vmcnt(" #n ")" ::: "memory")
#define PG8_WAIT_L(n) asm volatile("s_waitcnt lgkmcnt(" #n ")" ::: "memory")
#define PG8_BAR __builtin_amdgcn_s_barrier()
#define PG8_SCHED __builtin_amdgcn_sched_barrier(0)
    Unit cur, nxt; int ui = 0;
    if (!S.next(0, cur)) return;
    f32x4 acc[2][2][4][2];
#pragma unroll
    for (int a = 0; a < 2; ++a)
#pragma unroll
        for (int b = 0; b < 2; ++b)
#pragma unroll
            for (int m = 0; m < 4; ++m)
#pragma unroll
                for (int n = 0; n < 2; ++n) acc[a][b][m][n] = (f32x4){0.f, 0.f, 0.f, 0.f};
    bf16x8 At[4][2], B0[2][2], B1[2][2];
    const char* cA = (const char*)g.A + (size_t)cur.pm * tstepA + (size_t)cur.pn * g.aoffN; const char* cB = (const char*)g.Bt + (size_t)cur.pn * tstepB;
    PG8_STAGE(PG8_SB(0, 0), cB, voffB); PG8_STAGE(PG8_SB(0, 1), cB + hstepB, voffB); PG8_STAGE(PG8_SA(0, 0), cA, voffA); PG8_STAGE(PG8_SA(0, 1), cA + hstepA, voffA);
    if (wr == 1) PG8_BAR;
    PG8_WAIT_V(2); PG8_BAR;
    PG8_STAGE(PG8_SB(1, 0), cB + kstep, voffB); PG8_STAGE(PG8_SA(1, 0), cA + kstep, voffA); PG8_STAGE(PG8_SB(1, 1), cB + hstepB + kstep, voffB);
    PG8_WAIT_V(6); PG8_BAR;
    for (;;) {
        const bool has_next = S.next(ui + 1, nxt);
        const char* nA = has_next ? (const char*)g.A + (size_t)nxt.pm * tstepA + (size_t)nxt.pn * g.aoffN : cA; const char* nB = has_next ? (const char*)g.Bt + (size_t)nxt.pn * tstepB : cB;
        for (int t = 0; t < nt; t += 2) {
            const bool last = (t == nt - 2);
            const char* a1 = cA + (size_t)(t + 1) * kstep;
            const char* a2 = last ? nA : cA + (size_t)(t + 2) * kstep; const char* b2 = last ? nB : cB + (size_t)(t + 2) * kstep;
            const char* a3 = a2 + kstep; const char* b3 = b2 + kstep;
            PG8_LDB(B0, 0, 0); PG8_LDB(B1, 0, 1); PG8_SCHED; PG8_LDA(At, 0, 0); PG8_STAGE(PG8_SA(1, 1), a1 + hstepA, voffA);
            PG8_WAIT_V(8); PG8_WAIT_L(0); PG8_BAR; PG8_MMA(0, 0, At, B0); PG8_MMA(0, 1, At, B1); PG8_BAR; PG8_SCHED;
            PG8_LDA(At, 0, 1); PG8_STAGE(PG8_SB(0, 0), b2, voffB); PG8_STAGE(PG8_SB(0, 1), b2 + hstepB, voffB); PG8_STAGE(PG8_SA(0, 0), a2, voffA);
            PG8_WAIT_V(8); PG8_WAIT_L(0); PG8_BAR; PG8_MMA(1, 0, At, B0); PG8_MMA(1, 1, At, B1); PG8_BAR; PG8_SCHED;
            PG8_LDB(B0, 1, 0); PG8_LDB(B1, 1, 1); PG8_SCHED; PG8_LDA(At, 1, 0); PG8_STAGE(PG8_SA(0, 1), a2 + hstepA, voffA);
            PG8_WAIT_V(8); PG8_WAIT_L(0); PG8_BAR; PG8_MMA(0, 0, At, B0); PG8_MMA(0, 1, At, B1); PG8_BAR; PG8_SCHED;
            PG8_LDA(At, 1, 1); PG8_STAGE(PG8_SB(1, 0), b3, voffB); PG8_STAGE(PG8_SB(1, 1), b3 + hstepB, voffB); PG8_STAGE(PG8_SA(1, 0), a3, voffA);
            PG8_WAIT_V(8); PG8_WAIT_L(0); PG8_BAR; PG8_MMA(1, 0, At, B0); PG8_MMA(1, 1, At, B1); PG8_BAR; PG8_SCHED;
        }
        if (wr == 0) PG8_BAR;
        asm volatile("" ::: "memory"); PG8_SCHED;
        E(acc, cur, wr, wc, fr, fq);
        if (!has_next) break;
#pragma unroll
        for (int a = 0; a < 2; ++a)
#pragma unroll
            for (int b = 0; b < 2; ++b)
#pragma unroll
                for (int m = 0; m < 4; ++m)
#pragma unroll
                    for (int n = 0; n < 2; ++n) acc[a][b][m][n] = (f32x4){0.f, 0.f, 0.f, 0.f};
        cur = nxt; cA = nA; cB = nB; ++ui;
        if (wr == 1) PG8_BAR;
    }
    PG8_WAIT_V(0);
    PG8_BAR;
#undef PG8_SA
#undef PG8_SB
#undef PG8_STAGE
#undef PG8_LDA
#undef PG8_LDB
#undef PG8_MMA
#undef PG8_WAIT_V
#undef PG8_WAIT_L
#undef PG8_BAR
#undef PG8_SCHED
}

struct EpiProj {
    static constexpr bool PERM = true;
    bf16_t* O; int ldc; const float* bias; int has_shift;
    __device__ __forceinline__ void operator()(f32x4 (&acc)[2][2][4][2], const Unit& u, int wr, int wc, int fr, int fq) const {
        const int row0 = u.pm * BM + wr * 64 + fr; const int colt = u.pn * BM; const int col0 = colt + wc * 32 + 8 * fq;
        int shift = 0; if (has_shift) shift = (colt >= 1536 ? 8 : 0) + (colt >= 3584 ? 8 : 0);
        f32x4 bv[2][2];
#pragma unroll
        for (int bj = 0; bj < 2; ++bj)
#pragma unroll
            for (int n = 0; n < 2; ++n) bv[bj][n] = bias ? *(const f32x4*)(bias + col0 + shift + bj * HALF + 4 * n) : (f32x4){0.f, 0.f, 0.f, 0.f};
#pragma unroll
        for (int ai = 0; ai < 2; ++ai)
#pragma unroll
            for (int m = 0; m < 4; ++m) { bf16_t* rowp = O + (size_t)(row0 + ai * HALF + m * 16) * ldc + col0;
#pragma unroll
                for (int bj = 0; bj < 2; ++bj) { const f32x4 v0 = acc[ai][bj][m][0] + bv[bj][0], v1 = acc[ai][bj][m][1] + bv[bj][1];
                    u32x4 w; w.x = pk2(v0[0], v0[1]); w.y = pk2(v0[2], v0[3]); w.z = pk2(v1[0], v1[1]); w.w = pk2(v1[2], v1[3]);
                    *(u32x4*)(rowp + bj * HALF) = w; } }
    }
};
template <int MODE> struct EpiY {
    static constexpr bool PERM = true;
    bf16_t* Y; const bf16_t* G;
    __device__ __forceinline__ void operator()(f32x4 (&acc)[2][2][4][2], const Unit& u, int wr, int wc, int fr, int fq) const {
        const int row0 = u.pm * BM + wr * 64 + fr; const int col0 = u.pn * BM + wc * 32 + 8 * fq;
#pragma unroll
        for (int ai = 0; ai < 2; ++ai) {
            u32x4 gv[4][2], yo[4][2];
#pragma unroll
            for (int m = 0; m < 4; ++m)
#pragma unroll
                for (int bj = 0; bj < 2; ++bj) { const size_t row = (size_t)(row0 + ai * HALF + m * 16); const int col = col0 + bj * HALF;
                    gv[m][bj] = *(const u32x4*)(G + row * NP + col); if (MODE == 1) yo[m][bj] = *(const u32x4*)(Y + row * DM + col); }
            asm volatile("" ::: "memory");
#pragma unroll
            for (int m = 0; m < 4; ++m)
#pragma unroll
                for (int bj = 0; bj < 2; ++bj) { const size_t row = (size_t)(row0 + ai * HALF + m * 16); const int col = col0 + bj * HALF;
                    const f32x4 a0 = acc[ai][bj][m][0], a1 = acc[ai][bj][m][1]; float gsg[8], r[8]; unpack8(gv[m][bj], gsg);
#pragma unroll
                    for (int e = 0; e < 4; ++e) { r[e] = sigmoidf_(gsg[e]) * a0[e]; r[4 + e] = sigmoidf_(gsg[4 + e]) * a1[e]; }
                    if (MODE == 1) { float yv[8]; unpack8(yo[m][bj], yv);
#pragma unroll
                        for (int e = 0; e < 8; ++e) r[e] += yv[e]; }
                    *(u32x4*)(Y + row * DM + col) = pack8(r); }
            asm volatile("" ::: "memory");
        }
    }
};
template <int XBF> struct EpiRes {
    static constexpr bool PERM = true;
    const void* X; const float* gmod; bf16_t* Z;
    __device__ __forceinline__ void operator()(f32x4 (&acc)[2][2][4][2], const Unit& u, int wr, int wc, int fr, int fq) const {
        const int row0 = u.pm * BM + wr * 64 + fr; const int col0 = u.pn * BM + wc * 32 + 8 * fq; const int b = (u.pm * BM) >> 11;
        f32x4 gv[2][2];
#pragma unroll
        for (int bj = 0; bj < 2; ++bj)
#pragma unroll
            for (int n = 0; n < 2; ++n) gv[bj][n] = *(const f32x4*)(gmod + (size_t)b * 6144 + col0 + bj * HALF + n * 4);
#pragma unroll
        for (int ai = 0; ai < 2; ++ai) {
            f32x4 xv[4][2][2];
#pragma unroll
            for (int m = 0; m < 4; ++m)
#pragma unroll
                for (int bj = 0; bj < 2; ++bj) { const size_t off = (size_t)(row0 + ai * HALF + m * 16) * DM + col0 + bj * HALF;
                    if (XBF) { const u32x4 w = *(const u32x4*)((const bf16_t*)X + off); xv[m][bj][0] = (f32x4){bflo(w.x), bfhi(w.x), bflo(w.y), bfhi(w.y)}; xv[m][bj][1] = (f32x4){bflo(w.z), bfhi(w.z), bflo(w.w), bfhi(w.w)}; }
                    else { xv[m][bj][0] = *(const f32x4*)((const float*)X + off); xv[m][bj][1] = *(const f32x4*)((const float*)X + off + 4); } }
            asm volatile("" ::: "memory");
#pragma unroll
            for (int m = 0; m < 4; ++m)
#pragma unroll
                for (int bj = 0; bj < 2; ++bj) { const size_t off = (size_t)(row0 + ai * HALF + m * 16) * DM + col0 + bj * HALF;
                    const f32x4 o0 = xv[m][bj][0] * ALPHA + gv[bj][0] * acc[ai][bj][m][0], o1 = xv[m][bj][1] * ALPHA + gv[bj][1] * acc[ai][bj][m][1];
                    u32x4 w; w.x = pk2(o0[0], o0[1]); w.y = pk2(o0[2], o0[3]); w.z = pk2(o1[0], o1[1]); w.w = pk2(o1[2], o1[3]);
                    *(u32x4*)(Z + off) = w; }
            asm volatile("" ::: "memory");
        }
    }
};
struct EpiSwiglu {
    static constexpr bool PERM = true;
    bf16_t* O;
    __device__ __forceinline__ void operator()(f32x4 (&acc)[2][2][4][2], const Unit& u, int wr, int wc, int fr, int fq) const {
        const int row0 = u.pm * BM + wr * 64 + fr; const int col0 = u.pn * HALF + wc * 32 + 8 * fq;
#pragma unroll
        for (int ai = 0; ai < 2; ++ai)
#pragma unroll
            for (int m = 0; m < 4; ++m) { bf16_t* rowp = O + (size_t)(row0 + ai * HALF + m * 16) * DFF + col0;
                const f32x4 g0 = acc[ai][0][m][0], g1 = acc[ai][0][m][1], u0 = acc[ai][1][m][0], u1 = acc[ai][1][m][1];
                float r[8];
#pragma unroll
                for (int e = 0; e < 4; ++e) { r[e] = g0[e] * sigmoidf_(g0[e]) * u0[e]; r[4 + e] = g1[e] * sigmoidf_(g1[e]) * u1[e]; }
                u32x4 w; w.x = pk2(r[0], r[1]); w.y = pk2(r[2], r[3]); w.z = pk2(r[4], r[5]); w.w = pk2(r[6], r[7]);
                *(u32x4*)rowp = w; }
    }
};

struct PanelStats {
    unsigned long long* xbuf;
    unsigned* cnt;
    LAS unsigned char* scr;
    __device__ __forceinline__ void run(const f32x4 (&v)[2][2][4][2], const Unit& u, int wr, int wc, int fr, int fq) const {
        const int lane = threadIdx.x & 63, wid = __builtin_amdgcn_readfirstlane(threadIdx.x >> 6);
        LAS f32x2* P = (LAS f32x2*)scr;
        LAS f32x2* S = (LAS f32x2*)(scr + 8192);
#pragma unroll
        for (int ai = 0; ai < 2; ++ai)
#pragma unroll
            for (int m = 0; m < 4; ++m) {
                float s = 0.f;
#pragma unroll
                for (int bj = 0; bj < 2; ++bj)
#pragma unroll
                    for (int n = 0; n < 2; ++n) { const f32x4 x = v[ai][bj][m][n]; s += (x[0] + x[1]) + (x[2] + x[3]); }
                s += __shfl_xor(s, 16); s += __shfl_xor(s, 32);
                const float mw = s * (1.0f / 64.0f); float q = 0.f;
#pragma unroll
                for (int bj = 0; bj < 2; ++bj)
#pragma unroll
                    for (int n = 0; n < 2; ++n) { const f32x4 d = v[ai][bj][m][n] - mw; q += (d[0] * d[0] + d[1] * d[1]) + (d[2] * d[2] + d[3] * d[3]); }
                q += __shfl_xor(q, 16); q += __shfl_xor(q, 32);
                if (fq == 0) P[(ai * HALF + wr * 64 + m * 16 + fr) * 4 + wc] = (f32x2){mw, q};
            }
        asm volatile("s_waitcnt lgkmcnt(0)" ::: "memory"); __builtin_amdgcn_s_barrier(); asm volatile("" ::: "memory");
        const int row = wid * 32 + (lane & 31);
        if (lane < 32) {
            const f32x2 a = P[row * 4 + 0], b = P[row * 4 + 1], c = P[row * 4 + 2], d = P[row * 4 + 3];
            const float mt = (a.x + b.x + c.x + d.x) * 0.25f;
            const float da = a.x - mt, db = b.x - mt, dc = c.x - mt, dd = d.x - mt;
            const float m2 = (a.y + b.y) + (c.y + d.y) + 64.0f * ((da * da + db * db) + (dc * dc + dd * dd));
            unsigned long long* slot = xbuf + ((size_t)(u.pm * BM + row) * 4 + u.pn);
            __hip_atomic_store(slot, ((unsigned long long)__float_as_uint(m2) << 32) | __float_as_uint(mt), __ATOMIC_RELAXED, __HIP_MEMORY_SCOPE_AGENT);
        }
        asm volatile("s_waitcnt vmcnt(0)" ::: "memory");
        if (lane == 0) __hip_atomic_fetch_add(cnt + 64 * u.pm, 1u, __ATOMIC_RELAXED, __HIP_MEMORY_SCOPE_AGENT);
        if (wid == 0) {
            unsigned sp = 0;
            for (;;) {
                if ((unsigned)__builtin_amdgcn_readfirstlane(__hip_atomic_load(cnt + 64 * u.pm, __ATOMIC_RELAXED, __HIP_MEMORY_SCOPE_AGENT)) >= 32u) break;
                if (++sp > (1u << 24)) break;
                __builtin_amdgcn_s_sleep(2);
            }
            __builtin_amdgcn_fence(__ATOMIC_ACQUIRE, "agent");
        }
        asm volatile("s_waitcnt vmcnt(0) lgkmcnt(0)" ::: "memory"); __builtin_amdgcn_s_barrier(); asm volatile("" ::: "memory");
        if (lane < 32) {
            const unsigned long long* slot = xbuf + (size_t)(u.pm * BM + row) * 4; float mt[4], m2[4]; float ms = 0.f;
#pragma unroll
            for (int t = 0; t < 4; ++t) { const unsigned long long w = __hip_atomic_load(slot + t, __ATOMIC_RELAXED, __HIP_MEMORY_SCOPE_AGENT); mt[t] = __uint_as_float((unsigned)w); m2[t] = __uint_as_float((unsigned)(w >> 32)); ms += mt[t]; }
            const float mean = ms * 0.25f; float q = 0.f;
#pragma unroll
            for (int t = 0; t < 4; ++t) { const float dm = mt[t] - mean; q += m2[t] + 256.0f * dm * dm; }
            S[row] = (f32x2){mean, 1.0f / sqrtf(q * (1.0f / 1024.0f) + LN_EPS)};
        }
        asm volatile("s_waitcnt lgkmcnt(0)" ::: "memory"); __builtin_amdgcn_s_barrier(); asm volatile("" ::: "memory");
    }
};
__device__ __forceinline__ const char* uptr(const void* p) { const unsigned long long v = (unsigned long long)p;
    const unsigned lo = __builtin_amdgcn_readfirstlane((unsigned)v), hi = __builtin_amdgcn_readfirstlane((unsigned)(v >> 32)); return (const char*)(((unsigned long long)hi << 32) | lo); }
__device__ __forceinline__ f32x4 ld4bf(const bf16_t* p) { const u32x2 w = *(const u32x2*)p; return (f32x4){bflo(w.x), bfhi(w.x), bflo(w.y), bfhi(w.y)}; }
#define EPI_FOR4 _Pragma("unroll") for (int bj = 0; bj < 2; ++bj) _Pragma("unroll") for (int n = 0; n < 2; ++n)
#define EPI_ROWS _Pragma("unroll") for (int ai = 0; ai < 2; ++ai) _Pragma("unroll") for (int m = 0; m < 4; ++m)
struct EpiLnOut {
    static constexpr bool PERM = false;
    const bf16_t* X1; const float* gmod; const float* lg; const float* lb; float* OUT; PanelStats st;
    __device__ __forceinline__ void operator()(f32x4 (&acc)[2][2][4][2], const Unit& u, int wr, int wc, int fr, int fq) const {
        const int b = (u.pm * BM) >> 11; const unsigned loff = (unsigned)(fr * DM + 4 * fq), coff = 4 * fq;
        const size_t ub = (size_t)(u.pm * BM + wr * 64) * DM + u.pn * BM + wc * 32; const int cb = u.pn * BM + wc * 32;
        const float* gm = gmod + (size_t)b * 6144 + cb;
        EPI_FOR4 { const f32x4 gv = *(const f32x4*)(gm + (bj * HALF + n * 16) + coff);
            EPI_ROWS { const f32x4 xv = ld4bf(X1 + (ub + (size_t)((ai * HALF + m * 16) * DM + bj * HALF + n * 16)) + loff);
                acc[ai][bj][m][n] = xv * ALPHA + gv * acc[ai][bj][m][n]; }
            asm volatile("" ::: "memory"); __builtin_amdgcn_sched_barrier(0); }
        st.run(acc, u, wr, wc, fr, fq);
        const LAS f32x2* S = (const LAS f32x2*)(st.scr + 8192) + (wr * 64 + fr);
        EPI_FOR4 { const f32x4 g4 = *(const f32x4*)(lg + (cb + bj * HALF + n * 16) + coff), b4 = *(const f32x4*)(lb + (cb + bj * HALF + n * 16) + coff);
            EPI_ROWS { const f32x2 sr = S[ai * HALF + m * 16];
                *(f32x4*)(OUT + (ub + (size_t)((ai * HALF + m * 16) * DM + bj * HALF + n * 16)) + loff) = (acc[ai][bj][m][n] - sr.x) * sr.y * g4 + b4; }
            asm volatile("" ::: "memory"); __builtin_amdgcn_sched_barrier(0); }
    }
};
struct EpiLnMid {
    static constexpr bool PERM = false;
    const float* X; const float* lg; const float* lb; unsigned char* wsb; bf16_t* H2; LAS unsigned char* scr;
    __device__ __forceinline__ void operator()(f32x4 (&acc)[2][2][4][2], const Unit& u, int wr, int wc, int fr, int fq) const {
        const int b = (u.pm * BM) >> 11; const unsigned loff = (unsigned)(fr * DM + 4 * fq), coff = 4 * fq;
        const size_t ub = (size_t)(u.pm * BM + wr * 64) * DM + u.pn * BM + wc * 32; const int cb = u.pn * BM + wc * 32;
        const float* modb = (const float*)(wsb + WS_MOD) + (size_t)b * 6144 + cb; bf16_t* X1 = (bf16_t*)(wsb + WS_X1);
        const PanelStats st1{(unsigned long long*)(wsb + WS_XB1), (unsigned*)(wsb + WS_CNT), scr}, st2{(unsigned long long*)(wsb + WS_XB2), (unsigned*)(wsb + WS_CNT + 32768), scr};
        EPI_FOR4 { const f32x4 gv = *(const f32x4*)(modb + (2048 + bj * HALF + n * 16) + coff);
            EPI_ROWS { const f32x4 xv = *(const f32x4*)(X + (ub + (size_t)((ai * HALF + m * 16) * DM + bj * HALF + n * 16)) + loff);
                acc[ai][bj][m][n] = xv * ALPHA + gv * acc[ai][bj][m][n]; if (m & 1) asm volatile("" ::: "memory"); __builtin_amdgcn_sched_barrier(0); }
            asm volatile("" ::: "memory"); __builtin_amdgcn_sched_barrier(0); }
        st1.run(acc, u, wr, wc, fr, fq);
        { const LAS f32x2* S = (const LAS f32x2*)(st1.scr + 8192) + (wr * 64 + fr);
        EPI_FOR4 { const f32x4 g4 = *(const f32x4*)(lg + (cb + bj * HALF + n * 16) + coff), b4 = *(const f32x4*)(lb + (cb + bj * HALF + n * 16) + coff);
            EPI_ROWS { const f32x2 sr = S[ai * HALF + m * 16];
                const f32x4 o = (acc[ai][bj][m][n] - sr.x) * sr.y * g4 + b4; acc[ai][bj][m][n] = o;
                u32x2 w; w.x = pk2(o[0], o[1]); w.y = pk2(o[2], o[3]);
                *(u32x2*)(X1 + (ub + (size_t)((ai * HALF + m * 16) * DM + bj * HALF + n * 16)) + loff) = w; }
            asm volatile("" ::: "memory"); __builtin_amdgcn_sched_barrier(0); } }
        st2.run(acc, u, wr, wc, fr, fq);
        { const LAS f32x2* S = (const LAS f32x2*)(st2.scr + 8192) + (wr * 64 + fr);
        EPI_FOR4 { const f32x4 sh = *(const f32x4*)(modb + (3072 + bj * HALF + n * 16) + coff), sc = *(const f32x4*)(modb + (4096 + bj * HALF + n * 16) + coff) + 1.0f;
            EPI_ROWS { const f32x2 sr = S[ai * HALF + m * 16];
                const f32x4 o = (acc[ai][bj][m][n] - sr.x) * sr.y * sc + sh;
                u32x2 w; w.x = pk2(o[0], o[1]); w.y = pk2(o[2], o[3]);
                *(u32x2*)(H2 + (ub + (size_t)((ai * HALF + m * 16) * DM + bj * HALF + n * 16)) + loff) = w; }
            asm volatile("" ::: "memory"); __builtin_amdgcn_sched_barrier(0); } }
    }
};
#undef EPI_FOR4
#undef EPI_ROWS
}

__device__ __forceinline__ void tr_item(const float* __restrict__ src, int ld, int k0, int c0, bf16_t* dst, int dstK, int r0, LAS float* scr, int lane) {
    f32x4 t[8];
#pragma unroll
    for (int i = 0; i < 8; ++i) t[i] = *(const f32x4*)(src + (size_t)(k0 + 8 * i + (lane >> 3)) * ld + c0 + 4 * (lane & 7));
#pragma unroll
    for (int i = 0; i < 8; ++i) { LAS float* d = scr + (8 * i + (lane >> 3)) * 33 + 4 * (lane & 7); d[0] = t[i][0]; d[1] = t[i][1]; d[2] = t[i][2]; d[3] = t[i][3]; }
    LDS_WAIT();
    const int c = lane & 7;
#pragma unroll
    for (int j = 0; j < 4; ++j) { const int n = (lane >> 3) + 8 * j; const LAS float* s = scr + (8 * c) * 33 + n;
        u32x4 o; o.x = pk2(s[0 * 33], s[1 * 33]); o.y = pk2(s[2 * 33], s[3 * 33]); o.z = pk2(s[4 * 33], s[5 * 33]); o.w = pk2(s[6 * 33], s[7 * 33]);
        *(u32x4*)(dst + (size_t)(r0 + n) * dstK + k0 + 8 * c) = o; }
    LDS_WAIT();
}

__device__ __forceinline__ void split_arrive(unsigned* ctr);
__device__ __forceinline__ void split_wait(unsigned* ctr, unsigned want);
__device__ __forceinline__ void p0_prologue(LAS unsigned char* lds, const float* const* in, unsigned char* ws, unsigned* ctr) {
    const int tid = threadIdx.x, lane = tid & 63, wave = __builtin_amdgcn_readfirstlane(tid >> 6);
    const int G = gridDim.x;
    {
        const float* c = in[1]; const float* w_ada = in[2]; const float* b_ada = in[3]; float* MOD = (float*)(ws + WS_MOD);
        LAS float* sc = (LAS float*)lds; LAS float* red = (LAS float*)(lds + 65536);
        if ((int)blockIdx.x < 192) {
            for (int idx = tid; idx < 16384; idx += 512) { const int b = idx & 15, k = idx >> 4; const float v = c[b * 1024 + k]; sc[k * 16 + b] = v / (1.0f + expf(-v)); }
            __syncthreads();
            for (int item = blockIdx.x; item < 192; item += G) {
                const int e = item * 32 + (lane & 31), kbase = wave * 128 + (lane >> 5) * 64;
                float acc[16];
#pragma unroll
                for (int b = 0; b < 16; ++b) acc[b] = 0.f;
                for (int kk0 = 0; kk0 < 64; kk0 += 32) {
                    float wv[32];
#pragma unroll
                    for (int i = 0; i < 32; ++i) wv[i] = w_ada[(size_t)(kbase + kk0 + i) * 6144 + e];
#pragma unroll
                    for (int i = 0; i < 32; ++i) { const int k = kbase + kk0 + i; const float w = wv[i];
                        const LAS f32x4* s = (const LAS f32x4*)(sc + k * 16);
#pragma unroll
                        for (int q = 0; q < 4; ++q) { const f32x4 sv = s[q]; acc[4 * q + 0] += sv[0] * w; acc[4 * q + 1] += sv[1] * w; acc[4 * q + 2] += sv[2] * w; acc[4 * q + 3] += sv[3] * w; } } }
#pragma unroll
                for (int b = 0; b < 16; ++b) { acc[b] += __shfl_xor(acc[b], 32); if (lane < 32) red[(wave * 16 + b) * 32 + lane] = acc[b]; }
                __syncthreads();
                { const int b = tid >> 5, col = tid & 31; float s = 0.f;
#pragma unroll
                  for (int w = 0; w < 8; ++w) s += red[(w * 16 + b) * 32 + col];
                  MOD[b * 6144 + item * 32 + col] = s + b_ada[item * 32 + col]; }
                __syncthreads();
            }
        }
        __syncthreads();
    }
    {
        const float* w_in = in[4]; const float* b_in = in[5]; float* WG = (float*)(ws + WS_WG); float* BG = (float*)(ws + WS_BG);
        for (int idx = blockIdx.x * 512 + tid; idx < 16384; idx += G * 512) { const int j = idx >> 10, k = idx & 1023;
            const int col = j < 8 ? 1536 + j : (j < 12 ? 3592 + (j - 8) : 3596 + (j - 12));
            WG[idx] = w_in[(size_t)k * DIN + col]; if (k == 0) BG[j] = b_in[col]; }
    }
    split_arrive(ctr);
    {
        LAS float* scr = (LAS float*)(lds + wave * 16384);
        const int gw = blockIdx.x * 8 + wave, NGW = G * 8;
        constexpr int NITEMS = 3328 + 128 + 256 + 512 + 512 + 2816 + 1408;
        for (int it = gw; it < NITEMS; it += NGW) {
            int r = it; const float* src; int ld, k0, c0, dstK, r0; bf16_t* dst;
            if (r < 3328) { const int kb = r / 208, nb = r % 208, n0 = nb * 32; src = in[4]; ld = DIN; k0 = kb * 64; c0 = n0 + (n0 >= 1536 ? 8 : 0) + (n0 >= 3584 ? 8 : 0); dst = (bf16_t*)(ws + WS_WT_IN); dstK = 1024; r0 = n0; }
            else if ((r -= 3328) < 128) { const int sj = r >> 4, q = r & 15, h = sj >> 1, which = sj & 1, kb = q >> 2, nb = q & 3; src = (which ? in[9] : in[8]) + (size_t)h * 256 * 128; ld = 128; k0 = kb * 64; c0 = nb * 32; dst = (bf16_t*)(ws + WS_WT_QK); dstK = 256; r0 = h * 256 + which * 128 + nb * 32; }
            else if ((r -= 128) < 256) { const int kb = r >> 5, nb = r & 31; src = in[11]; ld = 1024; k0 = kb * 64; c0 = nb * 32; dst = (bf16_t*)(ws + WS_WT_PA); dstK = 512; r0 = nb * 32; }
            else if ((r -= 256) < 512) { const int kb = r >> 5, nb = r & 31; src = in[12]; ld = 1024; k0 = kb * 64; c0 = nb * 32; dst = (bf16_t*)(ws + WS_WT_PB); dstK = 1024; r0 = nb * 32; }
            else if ((r -= 512) < 512) { const int kb = r >> 5, nb = r & 31; src = in[13]; ld = 1024; k0 = kb * 64; c0 = nb * 32; dst = (bf16_t*)(ws + WS_WT_OUT); dstK = 1024; r0 = nb * 32; }
            else if ((r -= 512) < 2816) { const int kb = r / 176, nb = r % 176, n0 = nb * 32, pn = n0 >> 8, hh = (n0 & 255) >> 7, j = n0 & 127; src = in[16]; ld = 2 * DFF; k0 = kb * 64; c0 = hh * DFF + 128 * pn + j; dst = (bf16_t*)(ws + WS_WT_FI); dstK = 1024; r0 = n0; }
            else { r -= 2816; const int kb = r >> 5, nb = r & 31; src = in[17]; ld = 1024; k0 = kb * 64; c0 = nb * 32; dst = (bf16_t*)(ws + WS_WT_FD); dstK = DFF; r0 = nb * 32; }
            tr_item(src, ld, k0, c0, dst, dstK, r0, scr, lane);
        }
    }
    split_wait(ctr, gridDim.x);
}

__device__ __forceinline__ void p1_ln_gates(LAS unsigned char* lds, const float* x, const float* MOD, const float* WG, const float* BG, bf16_t* H1, float* G16) {
    const int tid = threadIdx.x, lane = tid & 63, wave = __builtin_amdgcn_readfirstlane(tid >> 6);
    LAS f32x4* WGl = (LAS f32x4*)lds;
    for (int idx = tid; idx < 4096; idx += 512) WGl[idx] = ((const f32x4*)WG)[idx];
    __syncthreads();
    for (int rp = blockIdx.x * 8 + wave; rp < MT / 2; rp += gridDim.x * 8) {
        const int r0 = 2 * rp, b = r0 >> 11;
        f32x4 v[2][4], shv[4], scv[4];
#pragma unroll
        for (int r = 0; r < 2; ++r)
#pragma unroll
            for (int j = 0; j < 4; ++j) v[r][j] = *(const f32x4*)(x + (size_t)(r0 + r) * DM + 4 * lane + 256 * j);
#pragma unroll
        for (int j = 0; j < 4; ++j) { shv[j] = *(const f32x4*)(MOD + (size_t)b * 6144 + 4 * lane + 256 * j); scv[j] = *(const f32x4*)(MOD + (size_t)b * 6144 + 1024 + 4 * lane + 256 * j) + 1.0f; }
        asm volatile("" ::: "memory");
#pragma unroll
        for (int r = 0; r < 2; ++r) {
            float s = 0.f;
#pragma unroll
            for (int j = 0; j < 4; ++j) s += (v[r][j][0] + v[r][j][1]) + (v[r][j][2] + v[r][j][3]);
            const float mean = wave_sum(s) * (1.f / DM); float s2 = 0.f;
#pragma unroll
            for (int j = 0; j < 4; ++j) { v[r][j] = v[r][j] - mean; s2 += (v[r][j][0] * v[r][j][0] + v[r][j][1] * v[r][j][1]) + (v[r][j][2] * v[r][j][2] + v[r][j][3] * v[r][j][3]); }
            const float rstd = 1.f / sqrtf(wave_sum(s2) * (1.f / DM) + LN_EPS);
#pragma unroll
            for (int j = 0; j < 4; ++j) {
                v[r][j] = v[r][j] * rstd * scv[j] + shv[j];
                u32x2 o; o.x = pk2(v[r][j][0], v[r][j][1]); o.y = pk2(v[r][j][2], v[r][j][3]);
                *(u32x2*)(H1 + (size_t)(r0 + r) * DM + 4 * lane + 256 * j) = o; }
        }
        float vals[32];
#pragma unroll
        for (int j16 = 0; j16 < 16; ++j16) { float p0 = 0.f, p1 = 0.f;
#pragma unroll
            for (int q = 0; q < 4; ++q) { const f32x4 w = WGl[j16 * 256 + lane + 64 * q];
                p0 += (v[0][q][0] * w[0] + v[0][q][1] * w[1]) + (v[0][q][2] * w[2] + v[0][q][3] * w[3]);
                p1 += (v[1][q][0] * w[0] + v[1][q][1] * w[1]) + (v[1][q][2] * w[2] + v[1][q][3] * w[3]); }
            vals[j16] = p0; vals[16 + j16] = p1; asm volatile("" ::: "memory"); }
#define BFLY(N, MASK) { const bool up = (lane & MASK) != 0; _Pragma("unroll") for (int i = 0; i < N; ++i) { const float lo = vals[i], hi = vals[i + N]; const float send = up ? lo : hi, keep = up ? hi : lo; vals[i] = keep + __shfl_xor(send, MASK); } }
        BFLY(16, 32) BFLY(8, 16) BFLY(4, 8) BFLY(2, 4) BFLY(1, 2)
#undef BFLY
        const float tot = vals[0] + __shfl_xor(vals[0], 1);
        const int idx = lane >> 1;
        if (!(lane & 1)) { const int j = idx & 15; float gval = tot + BG[j];
            if (j < 8) gval = logsig(gval) * LOG2E; else if (j >= 12) gval = logsig(gval);
            G16[(size_t)(r0 + (idx >> 4)) * 16 + j] = gval; }
    }
}

__device__ __forceinline__ void fscan(LAS unsigned char* lds, const float* G16, float* FCUM) {
    const int tid = threadIdx.x, lane = tid & 63, wave = __builtin_amdgcn_readfirstlane(tid >> 6);
    LAS float* wsum = (LAS float*)lds;
    for (int s = blockIdx.x; s < 128; s += gridDim.x) {
        const int b = s >> 3, hh = s & 7;
        float v[4];
#pragma unroll
        for (int i = 0; i < 4; ++i) v[i] = G16[(size_t)(b * SEQ + 4 * tid + i) * 16 + hh];
        v[1] += v[0]; v[2] += v[1]; v[3] += v[2];
        const float tot = v[3]; float sc = tot;
#pragma unroll
        for (int o = 1; o < 64; o <<= 1) { const float y = __shfl_up(sc, o); if (lane >= o) sc += y; }
        if (lane == 63) wsum[wave] = sc;
        __syncthreads();
        float off = 0.f;
        for (int w = 0; w < wave; ++w) off += wsum[w];
        const float excl = off + sc - tot;
#pragma unroll
        for (int i = 0; i < 4; ++i) FCUM[(size_t)s * SEQ + 4 * tid + i] = v[i] + excl;
        __syncthreads();
    }
}

__device__ __forceinline__ void conv_phase(const bf16_t* PROJ, const float* conv_w, const float* conv_b, bf16_t* U) {
    const int tid = threadIdx.x, lane = tid & 63, wave = __builtin_amdgcn_readfirstlane(tid >> 6);
    const int gw = blockIdx.x * 8 + wave, NGW = gridDim.x * 8;
    for (int it = gw; it < 4096; it += NGW) {
        const int rg = it >> 1, chf = it & 1, m0 = rg * 16, c = chf * 512 + lane * 8;
        float w[4][8], cb[8];
#pragma unroll
        for (int j = 0; j < 4; ++j) { const f32x4 a = *(const f32x4*)(conv_w + j * 1024 + c), bq = *(const f32x4*)(conv_w + j * 1024 + c + 4);
            w[j][0] = a[0]; w[j][1] = a[1]; w[j][2] = a[2]; w[j][3] = a[3]; w[j][4] = bq[0]; w[j][5] = bq[1]; w[j][6] = bq[2]; w[j][7] = bq[3]; }
        { const f32x4 a = *(const f32x4*)(conv_b + c), bq = *(const f32x4*)(conv_b + c + 4); cb[0] = a[0]; cb[1] = a[1]; cb[2] = a[2]; cb[3] = a[3]; cb[4] = bq[0]; cb[5] = bq[1]; cb[6] = bq[2]; cb[7] = bq[3]; }
        const bool has_prev = (m0 & (SEQ - 1)) != 0;
        u32x4 raw[19];
#pragma unroll
        for (int j = 0; j < 3; ++j) { raw[j] = (u32x4){0u, 0u, 0u, 0u}; if (has_prev) raw[j] = *(const u32x4*)(PROJ + (size_t)(m0 - 3 + j) * NP + C_MU + c); }
#pragma unroll
        for (int r = 0; r < 16; ++r) raw[3 + r] = *(const u32x4*)(PROJ + (size_t)(m0 + r) * NP + C_MU + c);
#pragma unroll
        for (int r = 0; r < 16; ++r) {
            float x0[8], x1[8], x2[8], x3[8]; unpack8(raw[r], x0); unpack8(raw[r + 1], x1); unpack8(raw[r + 2], x2); unpack8(raw[r + 3], x3);
            float y[8];
#pragma unroll
            for (int e = 0; e < 8; ++e) { const float t = w[0][e] * x0[e] + w[1][e] * x1[e] + w[2][e] * x2[e] + w[3][e] * x3[e] + cb[e]; y[e] = t * sigmoidf_(t); }
            *(u32x4*)(U + (size_t)(m0 + r) * DM + c) = pack8(y);
        }
    }
}


namespace fox_attn {
using bf16=__hip_bfloat16;
using bf16x8=__attribute__((ext_vector_type(8)))short;
using s16x4=__attribute__((ext_vector_type(4)))short;
using f32x16=__attribute__((ext_vector_type(16)))float;
using u32x4=__attribute__((ext_vector_type(4)))unsigned;
using f32x4v=__attribute__((ext_vector_type(4)))float;
constexpr int BATCH=16,NHEAD=8,SEQ=2048,D=64,DM=6656,OP=512;
constexpr int NW=8,QBLK=32,QB=QBLK*NW,KVBLK=64,NQB=SEQ/QB;
constexpr int ATTN_UNIT_ROWS=QB;
__device__ __forceinline__ int crow(int r,int hi){return (r&3)+8*(r>>2)+4*hi;}
#define SBAR() __builtin_amdgcn_sched_barrier(0)
__device__ __forceinline__ void cmask(f32x16&p0,f32x16&p1,int jb,int qrel,int hi){
  const float NEG=-INFINITY; int kb=64*jb+4*hi;
  #pragma unroll
  for(int r=0;r<16;++r){int kv=kb+(r&3)+8*(r>>2); if(kv>qrel)p0[r]=NEG; if(kv+32>qrel)p1[r]=NEG;}
}

constexpr int NSLOT=3, SLOTB=8192;
constexpr int LDS_K=0, LDS_V=NSLOT*SLOTB, LDS_WS=2*NSLOT*SLOTB, LDS_OST=LDS_WS+NW*64*4, LDS_BYTES=LDS_OST+NW*4096;
constexpr float C2=0.125f*1.4426950408889634f;
__device__ __forceinline__ void glds16(const void*gsrc,unsigned lds_dst){unsigned keep;
  asm volatile("s_mov_b32 %0, m0\n\ts_mov_b32 m0, %2\n\ts_nop 0\n\tglobal_load_lds_dwordx4 %1, off\n\ts_mov_b32 m0, %0":"=&s"(keep):"v"(gsrc),"s"(lds_dst):"memory");}
__device__ __forceinline__ float max3f(float a,float b,float c){float r;asm("v_max3_f32 %0, %1, %2, %3":"=v"(r):"v"(a),"v"(b),"v"(c));return r;}
__device__ __forceinline__ float max2f(float a,float b){float r;asm("v_max_f32_e32 %0, %1, %2":"=v"(r):"v"(a),"v"(b));return r;}
__device__ __forceinline__ float fadd_s(float a,float b){float r;asm("v_add_f32_e32 %0, %1, %2":"=v"(r):"v"(a),"v"(b));return r;}
__device__ __forceinline__ float fsub_s(float a,float b){float r;asm("v_sub_f32_e32 %0, %1, %2":"=v"(r):"v"(a),"v"(b));return r;}
typedef float f32x2_t __attribute__((ext_vector_type(2))); typedef __bf16 bf16x2_t __attribute__((ext_vector_type(2)));
__device__ __forceinline__ unsigned cvtpk_s(float lo,float hi){f32x2_t v={lo,hi};bf16x2_t b=__builtin_convertvector(v,bf16x2_t);return __builtin_bit_cast(unsigned,b);}
#define WAIT_BAR(N) asm volatile("s_waitcnt vmcnt(" #N ") lgkmcnt(0)\n\ts_barrier":::"memory")

__device__ __forceinline__ void qkt(f32x16&p0,f32x16&p1,const char*Kslot,const bf16x8*qr,const f32x16&negm,int r32,int hi){
  const char*kb=Kslot+hi*1024+r32*16;
  #pragma unroll
  for(int d0=0;d0<4;++d0){
    const bf16x8 b0=*reinterpret_cast<const bf16x8*>(kb+d0*2048);
    const bf16x8 b1=*reinterpret_cast<const bf16x8*>(kb+d0*2048+512);
    if(d0==0){p0=__builtin_amdgcn_mfma_f32_32x32x16_bf16(b0,qr[0],negm,0,0,0);p1=__builtin_amdgcn_mfma_f32_32x32x16_bf16(b1,qr[0],negm,0,0,0);}
    else{p0=__builtin_amdgcn_mfma_f32_32x32x16_bf16(b0,qr[d0],p0,0,0,0);p1=__builtin_amdgcn_mfma_f32_32x32x16_bf16(b1,qr[d0],p1,0,0,0);}}
}
typedef __attribute__((address_space(3))) const char* lds_cptr;
typedef short v4i16_t __attribute__((ext_vector_type(4)));
__device__ __forceinline__ void kload8(bf16x8*kf,lds_cptr kp){
  kf[0]=*(const __attribute__((address_space(3))) bf16x8*)(kp);      kf[1]=*(const __attribute__((address_space(3))) bf16x8*)(kp+512);
  kf[2]=*(const __attribute__((address_space(3))) bf16x8*)(kp+2048); kf[3]=*(const __attribute__((address_space(3))) bf16x8*)(kp+2560);
  kf[4]=*(const __attribute__((address_space(3))) bf16x8*)(kp+4096); kf[5]=*(const __attribute__((address_space(3))) bf16x8*)(kp+4608);
  kf[6]=*(const __attribute__((address_space(3))) bf16x8*)(kp+6144); kf[7]=*(const __attribute__((address_space(3))) bf16x8*)(kp+6656);
}
__device__ __forceinline__ void kload2(bf16x8*kf,lds_cptr kp,int j){ kf[2*j]=*(const __attribute__((address_space(3))) bf16x8*)(kp+j*2048); kf[2*j+1]=*(const __attribute__((address_space(3))) bf16x8*)(kp+j*2048+512); }
__device__ __forceinline__ s16x4 vtr(lds_cptr p){ return __builtin_bit_cast(s16x4,__builtin_amdgcn_ds_read_tr16_b64_v4i16((__attribute__((address_space(3))) v4i16_t*)p)); }
__device__ __forceinline__ float rowmax(const f32x16&p0,const f32x16&p1){
  float a=max3f(p0[0],p0[1],p1[0]),b=max3f(p0[2],p0[3],p1[1]);a=max3f(a,p1[2],p1[3]);
  #pragma unroll
  for(int r=4;r<16;r+=4){a=max3f(a,p0[r],p0[r+1]);b=max3f(b,p0[r+2],p0[r+3]);a=max3f(a,p1[r],p1[r+1]);b=max3f(b,p1[r+2],p1[r+3]);}
  const float m=max2f(a,b);
  auto rr=__builtin_amdgcn_permlane32_swap(__float_as_uint(m),__float_as_uint(m),false,false);
  return max2f(__uint_as_float(rr[0]),__uint_as_float(rr[1]));
}
__device__ __forceinline__ void pv(f32x16*o,int vb,bf16x8 pa0,bf16x8 pa1,bf16x8 pa2,bf16x8 pa3){
  #pragma unroll
  for(int d0=0;d0<2;++d0){s16x4 lo[4],hi[4];
    #pragma unroll
    for(int ks=0;ks<4;++ks){
      asm volatile("ds_read_b64_tr_b16 %0,%1 offset:%c2":"=&v"(lo[ks]):"v"(vb),"i"(d0*4096+ks*1024):"memory");
      asm volatile("ds_read_b64_tr_b16 %0,%1 offset:%c2":"=&v"(hi[ks]):"v"(vb),"i"(d0*4096+ks*1024+512):"memory");}
    asm volatile("s_waitcnt lgkmcnt(0)":::"memory");SBAR();
    #define PK(k) (bf16x8){lo[k][0],lo[k][1],lo[k][2],lo[k][3],hi[k][0],hi[k][1],hi[k][2],hi[k][3]}
    o[d0]=__builtin_amdgcn_mfma_f32_32x32x16_bf16(pa0,PK(0),o[d0],0,0,0);
    o[d0]=__builtin_amdgcn_mfma_f32_32x32x16_bf16(pa1,PK(1),o[d0],0,0,0);
    o[d0]=__builtin_amdgcn_mfma_f32_32x32x16_bf16(pa2,PK(2),o[d0],0,0,0);
    o[d0]=__builtin_amdgcn_mfma_f32_32x32x16_bf16(pa3,PK(3),o[d0],0,0,0);
    #undef PK
  }
}

#ifndef ATTN_STORE16
#define ATTN_STORE16(p,v) (*(u32x4*)(p)=(v))
#endif
template<int THRL> __device__ __forceinline__ void attn_unit(int b,int h,int qb,const bf16*Q,const bf16*__restrict__ K,const bf16*__restrict__ V,bf16*O,const float*__restrict__ Frow,char*shm){
  int tid_=threadIdx.x; asm volatile("":"+v"(tid_));
  const int tid=tid_,lane=tid&63,r32=lane&31,hi=lane>>5; const int wid=__builtin_amdgcn_readfirstlane(tid>>6);
  const long rowbase=(long)b*SEQ; const int q0=qb*QB;
  const bf16*Qw=Q+(rowbase+q0+wid*QBLK)*DM+h*D;
  const bf16*Kh=K+rowbase*DM+h*D,*Vh=V+rowbase*DM+h*D;
  const unsigned lds0=(unsigned)(uintptr_t)shm;
  float*wsf=(float*)(shm+LDS_WS)+wid*64;
  const bf16*ksrc=Kh+(long)lane*DM+wid*8;
  const bf16*vsrc=Vh+(long)(16*(wid&3)+(lane>>2))*DM+(wid>>2)*32+(lane&3)*8;
  const unsigned kdst=lds0+LDS_K+wid*1024, vdst=lds0+LDS_V+wid*1024;
  #define DMA_K(t,slot) glds16(ksrc+(long)(t)*KVBLK*DM,(unsigned)__builtin_amdgcn_readfirstlane(kdst+(slot)))
  #define DMA_V(t,slot) glds16(vsrc+(long)(t)*KVBLK*DM,(unsigned)__builtin_amdgcn_readfirstlane(vdst+(slot)))
  const int vb0=(int)(lds0+LDS_V)+((lane>>4)&1)*32+(lane&3)*8+(4*hi+((lane&15)>>2))*64;
  const char*Kbase=shm+LDS_K; bf16x8 kf[8];
  const lds_cptr shm3=(lds_cptr)shm; const lds_cptr kp0=shm3+LDS_K+hi*1024+r32*16; const lds_cptr vp0=shm3+LDS_V+((lane>>4)&1)*32+(lane&3)*8+(4*hi+((lane&15)>>2))*64;
  const int NT=(q0+QB)/KVBLK;
  float*nfk=(float*)(shm+LDS_BYTES);
  for(int i=tid;i<NT*KVBLK;i+=512)nfk[i]=-Frow[i];
  asm volatile("s_waitcnt vmcnt(0) lgkmcnt(0)\n\ts_barrier":::"memory");
  #define BIAS(P0,P1,t) do{ const float*nb_=nfk+(t)*KVBLK+4*hi; const float mh_=mhat; _Pragma("unroll") for(int r_=0;r_<16;++r_){ P0[r_]+=nb_[(r_&3)+8*(r_>>2)]-mh_; } \
      _Pragma("unroll") for(int r_=0;r_<16;++r_){ P1[r_]+=nb_[(r_&3)+8*(r_>>2)+32]-mh_; } }while(0)
  DMA_K(0,0);DMA_V(0,0);DMA_K(1,SLOTB);
  bf16x8 qr[4];
  #pragma unroll
  for(int d0=0;d0<4;++d0){ const u32x4 qw_=*reinterpret_cast<const u32x4*>(&Qw[(long)r32*DM+d0*16+hi*8]); u32x4 qs_;
    #define QSC(w) cvtpk_s(__uint_as_float((w)<<16)*C2,__uint_as_float((w)&0xffff0000u)*C2)
    qs_.x=QSC(qw_.x);qs_.y=QSC(qw_.y);qs_.z=QSC(qw_.z);qs_.w=QSC(qw_.w);
    #undef QSC
    qr[d0]=__builtin_bit_cast(bf16x8,qs_); }
  float mhat=0.f,l_reg=0.f;f32x16 o[2];o[0]=f32x16{};o[1]=f32x16{};const f32x16 negm=f32x16{};
  const int qrel=wid*QBLK+r32;
  #define CMASK(P0,P1,t) do{int jb_=(t)-(NT-4); if(jb_>=0)cmask(P0,P1,jb_,qrel,hi);}while(0)
  bool resc=false;
  #define START(P0,P1) do{ const float rm=rowmax(P0,P1); resc=false; \
    { const float dl=rm; mhat=fadd_s(mhat,dl); \
      _Pragma("unroll") for(int r=0;r<16;++r){P0[r]=fsub_s(P0[r],dl);P1[r]=fsub_s(P1[r],dl);} \
        } \
    _Pragma("unroll") for(int r=0;r<16;++r)P0[r]=__builtin_amdgcn_exp2f(P0[r]); }while(0)
  #define RESC() do{ if(resc){ asm volatile("s_waitcnt lgkmcnt(0)":::"memory"); \
      _Pragma("unroll") for(int d_=0;d_<2;++d_) _Pragma("unroll") for(int r=0;r<16;++r)o[d_][r]*=wsf[crow(r,hi)]; } }while(0)
  f32x16 pA0,pA1,pB0,pB1;
  int sl_prev=0,sl_cur=0,sl_next=SLOTB;
  #define ROT() do{sl_prev=sl_cur;sl_cur=sl_next;sl_next=(sl_next==(NSLOT-1)*SLOTB)?0:sl_next+SLOTB;}while(0)
  DMA_K(2,2*SLOTB);
  WAIT_BAR(3);
  qkt(pA0,pA1,Kbase,qr,negm,r32,hi);asm volatile("s_nop 15\n\ts_nop 7":"+v"(pA0),"+v"(pA1));BIAS(pA0,pA1,0);CMASK(pA0,pA1,0);
  START(pA0,pA1);
  _Pragma("unroll") for(int r=0;r<16;++r)pA1[r]=__builtin_amdgcn_exp2f(pA1[r]);
  WAIT_BAR(0);
  DMA_K(3,0);DMA_V(1,SLOTB);
  ROT();
  kload8(kf,kp0+sl_cur);
  WAIT_BAR(2);
  s16x4 vlo[8],vhi[8]; u32x4 pw0,pw1,pw2,pw3;
  #define PKW(P,B) cvtpk_s(P[B],P[B+1])
  #define PAF(k) __builtin_bit_cast(bf16x8,pw##k)
  #define VFR(i) (bf16x8){vlo[i][0],vlo[i][1],vlo[i][2],vlo[i][3],vhi[i][0],vhi[i][1],vhi[i][2],vhi[i][3]}
  #define PIN(x) asm volatile("":"+v"(x))
  #define MX3(a,b,c) __builtin_fmaxf(__builtin_fmaxf((a),(b)),(c))
  #define GAPA(MF,A0,A1,A2,A3,W0,W1,PW) do{ MF; sacc+=A0; sacc+=A1; sacc+=A2; sacc+=A3; PIN(sacc); W0; W1; PIN(PW); SBAR(); }while(0)
  #define EX(v) __builtin_amdgcn_exp2f(v)
  #define GAPB(MF,X,B) do{ MF; X[B]=EX(X[B]); X[B+1]=EX(X[B+1]); X[B+2]=EX(X[B+2]); X[B+3]=EX(X[B+3]); PIN(X); SBAR(); }while(0)
  #define VRD(i) do{ vlo[i]=vtr(vp_+(((i)>>2)*4096+((i)&3)*1024)); vhi[i]=vtr(vp_+(((i)>>2)*4096+((i)&3)*1024+512)); }while(0)
  #define KRD(G,j) do{ if(G){ kload2(kf,kp0+sl_next,j); SBAR(); } }while(0)
  #define STEP(C0,C1,P0,P1,t,GK,GV,GL) do{ SBAR(); \
    const lds_cptr vp_=vp0+sl_prev; \
    VRD(0); SBAR(); float sacc=(P0[0]+P0[1]); \
    GAPA(C0=__builtin_amdgcn_mfma_f32_32x32x16_bf16(kf[0],qr[0],negm,0,0,0), P0[2],P0[3],P0[4],P0[5],     pw0[0]=PKW(P0,0), pw0[1]=PKW(P0,2), pw0); \
    VRD(4); SBAR(); GAPA(C1=__builtin_amdgcn_mfma_f32_32x32x16_bf16(kf[1],qr[0],negm,0,0,0), P0[6],P0[7],P0[8],P0[9],     pw0[2]=PKW(P0,4), pw0[3]=PKW(P0,6), pw0); \
    VRD(1); SBAR(); GAPA(C0=__builtin_amdgcn_mfma_f32_32x32x16_bf16(kf[2],qr[1],C0,0,0,0),   P0[10],P0[11],P0[12],P0[13], pw1[0]=PKW(P0,8), pw1[1]=PKW(P0,10), pw1); \
    VRD(5); SBAR(); GAPA(C1=__builtin_amdgcn_mfma_f32_32x32x16_bf16(kf[3],qr[1],C1,0,0,0),   P0[14],P0[15],P1[0],P1[1],   pw1[2]=PKW(P0,12),pw1[3]=PKW(P0,14), pw1); \
    VRD(2); SBAR(); GAPA(C0=__builtin_amdgcn_mfma_f32_32x32x16_bf16(kf[4],qr[2],C0,0,0,0),   P1[2],P1[3],P1[4],P1[5],     pw2[0]=PKW(P1,0), pw2[1]=PKW(P1,2), pw2); \
    VRD(6); SBAR(); GAPA(C1=__builtin_amdgcn_mfma_f32_32x32x16_bf16(kf[5],qr[2],C1,0,0,0),   P1[6],P1[7],P1[8],P1[9],     pw2[2]=PKW(P1,4), pw2[3]=PKW(P1,6), pw2); \
    VRD(3); SBAR(); GAPA(C0=__builtin_amdgcn_mfma_f32_32x32x16_bf16(kf[6],qr[3],C0,0,0,0),   P1[10],P1[11],P1[12],P1[13], pw3[0]=PKW(P1,8), pw3[1]=PKW(P1,10), pw3); \
    VRD(7); SBAR(); GAPA(C1=__builtin_amdgcn_mfma_f32_32x32x16_bf16(kf[7],qr[3],C1,0,0,0),   P1[14],P1[15],0.f,0.f,       pw3[2]=PKW(P1,12),pw3[3]=PKW(P1,14), pw3); \
    l_reg+=sacc; \
    if(GK){DMA_K((t)+3,sl_cur);} if(GV){DMA_V((t)+1,sl_next);} \
    BIAS(C0,C1,t); CMASK(C0,C1,t); \
    { float a=MX3(C0[0],C0[1],C1[0]),b=MX3(C0[2],C0[3],C1[1]); a=MX3(a,C1[2],C1[3]); \
      _Pragma("unroll") for(int r=4;r<16;r+=4){a=MX3(a,C0[r],C0[r+1]);b=MX3(b,C0[r+2],C0[r+3]);a=MX3(a,C1[r],C1[r+1]);b=MX3(b,C1[r+2],C1[r+3]);} \
      float rm=__builtin_fmaxf(a,b); { auto rr=__builtin_amdgcn_permlane32_swap(__float_as_uint(rm),__float_as_uint(rm),false,false); rm=__builtin_fmaxf(__uint_as_float(rr[0]),__uint_as_float(rr[1])); } \
      resc=false; \
      if(__builtin_expect(__any(rm>(float)THRL),0)){ const float dl=__builtin_fmaxf(rm,0.f); mhat+=dl; \
        _Pragma("unroll") for(int r=0;r<16;++r){C0[r]-=dl;C1[r]-=dl;} \
          \
        const float f=__builtin_amdgcn_exp2f(-dl); l_reg*=f; if(hi==0)wsf[r32]=f; resc=true; } } \
    SBAR(); \
    GAPB(o[0]=__builtin_amdgcn_mfma_f32_32x32x16_bf16(PAF(0),VFR(0),o[0],0,0,0), C0,0); \
    GAPB(o[1]=__builtin_amdgcn_mfma_f32_32x32x16_bf16(PAF(0),VFR(4),o[1],0,0,0), C0,4); \
    KRD(GL,0); GAPB(o[0]=__builtin_amdgcn_mfma_f32_32x32x16_bf16(PAF(1),VFR(1),o[0],0,0,0), C0,8); \
    KRD(GL,1); GAPB(o[1]=__builtin_amdgcn_mfma_f32_32x32x16_bf16(PAF(1),VFR(5),o[1],0,0,0), C0,12); \
    KRD(GL,2); GAPB(o[0]=__builtin_amdgcn_mfma_f32_32x32x16_bf16(PAF(2),VFR(2),o[0],0,0,0), C1,0); \
    KRD(GL,3); GAPB(o[1]=__builtin_amdgcn_mfma_f32_32x32x16_bf16(PAF(2),VFR(6),o[1],0,0,0), C1,4); \
    GAPB(o[0]=__builtin_amdgcn_mfma_f32_32x32x16_bf16(PAF(3),VFR(3),o[0],0,0,0), C1,8); \
    GAPB(o[1]=__builtin_amdgcn_mfma_f32_32x32x16_bf16(PAF(3),VFR(7),o[1],0,0,0), C1,12); \
    }while(0)
  int t=1;
  #undef CMASK
  #define CMASK(P0,P1,t) do{}while(0)
  for(;t+5<NT;t+=2){
    STEP(pB0,pB1,pA0,pA1,t,true,true,true);     WAIT_BAR(2); RESC(); ROT();
    STEP(pA0,pA1,pB0,pB1,t+1,true,true,true);   WAIT_BAR(2); RESC(); ROT();
  }
  #undef CMASK
  #define CMASK(P0,P1,t) do{int jb_=(t)-(NT-4); if(jb_>=0)cmask(P0,P1,jb_,qrel,hi);}while(0)
  #define ENDW(tt) do{ if((tt)+3<NT){WAIT_BAR(2);} else if((tt)+2<NT){WAIT_BAR(1);} else {WAIT_BAR(0);} }while(0)
  for(;t+1<NT;t+=2){
    STEP(pB0,pB1,pA0,pA1,t,(t+3<NT),(t+1<NT),(t+1<NT));       ENDW(t);   RESC(); ROT();
    STEP(pA0,pA1,pB0,pB1,t+1,(t+4<NT),(t+2<NT),(t+2<NT));     ENDW(t+1); RESC(); ROT();
  }
  STEP(pB0,pB1,pA0,pA1,NT-1,false,false,false); RESC();
  { float sacc=pB0[0]+pB0[1]; _Pragma("unroll") for(int r=2;r<16;++r)sacc+=pB0[r]; _Pragma("unroll") for(int r=0;r<16;++r)sacc+=pB1[r]; l_reg+=sacc;
    pw0=(u32x4){PKW(pB0,0),PKW(pB0,2),PKW(pB0,4),PKW(pB0,6)};pw1=(u32x4){PKW(pB0,8),PKW(pB0,10),PKW(pB0,12),PKW(pB0,14)};pw2=(u32x4){PKW(pB1,0),PKW(pB1,2),PKW(pB1,4),PKW(pB1,6)};pw3=(u32x4){PKW(pB1,8),PKW(pB1,10),PKW(pB1,12),PKW(pB1,14)};
    SBAR(); pv(o,vb0+sl_cur,PAF(0),PAF(1),PAF(2),PAF(3)); }
  #undef PKW
  #undef PAF
  #undef VFR
  #undef PIN
  #undef MX3
  #undef GAPA
  #undef GAPB
  #undef EX
  #undef VRD
  #undef KRD
  #undef STEP
  #undef ENDW
  {auto rr=__builtin_amdgcn_permlane32_swap(__float_as_uint(l_reg),__float_as_uint(l_reg),false,false);l_reg=__uint_as_float(rr[0])+__uint_as_float(rr[1]);}
  if(hi==0)wsf[32+r32]=l_reg;asm volatile("s_waitcnt lgkmcnt(0)":::"memory");
  float rli[16];
  #pragma unroll
  for(int r=0;r<16;++r)rli[r]=__builtin_amdgcn_rcpf(wsf[32+crow(r,hi)]);
  bf16*Ow=O+(rowbase+q0+wid*QBLK)*OP+h*D;
  { bf16*stg=(bf16*)(shm+LDS_OST)+wid*2048;
    #pragma unroll
    for(int r=0;r<16;++r){const int orow=crow(r,hi);
      #pragma unroll
      for(int d0=0;d0<2;++d0)stg[orow*64+d0*32+r32]=__float2bfloat16(o[d0][r]*rli[r]);}
    asm volatile("s_waitcnt lgkmcnt(0)":::"memory");
    #pragma unroll
    for(int i=0;i<4;++i){const int row=i*8+(lane>>3),ch=lane&7; const u32x4 v=*(const u32x4*)(stg+row*64+ch*8); ATTN_STORE16(Ow+(long)row*OP+ch*8,v);} }
  asm volatile("s_waitcnt lgkmcnt(0)\n\ts_barrier":::"memory");
  #undef BIAS
  #undef DMA_K
  #undef DMA_V
  #undef CMASK
  #undef START
  #undef RESC
  #undef ROT
}
constexpr int ATTN_LDS_BYTES=LDS_BYTES+8192;
#undef SBAR
#undef WAIT_BAR
}

__device__ __forceinline__ void attn_phase_ref(char* shm, const bf16_t* PROJ, const float* FCUM, bf16_t* ATT) {
    const int vblk = (gridDim.x % 8 == 0) ? (int)((blockIdx.x & 7) * (gridDim.x >> 3) + (blockIdx.x >> 3)) : (int)blockIdx.x;
    for (int uid = vblk; uid < 1024; uid += gridDim.x) {
        const int round = uid >> 8, v = uid & 255, bh = v >> 1, par = v & 1, b = bh >> 3, hh = bh & 7;
        const int qb = par ? (round == 0 ? 1 : round == 1 ? 6 : round == 2 ? 3 : 4) : (round == 0 ? 0 : round == 1 ? 7 : round == 2 ? 2 : 5);
        fox_attn::attn_unit<8>(b, hh, qb, (const fox_attn::bf16*)(PROJ + C_FQ), (const fox_attn::bf16*)(PROJ + C_FK), (const fox_attn::bf16*)(PROJ + C_FV), (fox_attn::bf16*)ATT, FCUM + (size_t)bh * SEQ, shm);
    }
}

__device__ __forceinline__ float xmax16(float m) { auto r = __builtin_amdgcn_permlane16_swap(__float_as_uint(m), __float_as_uint(m), false, false); return fmaxf(__uint_as_float(r[0]), __uint_as_float(r[1])); }
__device__ __forceinline__ float xmax32(float m) { auto r = __builtin_amdgcn_permlane32_swap(__float_as_uint(m), __float_as_uint(m), false, false); return fmaxf(__uint_as_float(r[0]), __uint_as_float(r[1])); }
__device__ __forceinline__ float xadd16(float m) { auto r = __builtin_amdgcn_permlane16_swap(__float_as_uint(m), __float_as_uint(m), false, false); return __uint_as_float(r[0]) + __uint_as_float(r[1]); }
__device__ __forceinline__ float xadd32(float m) { auto r = __builtin_amdgcn_permlane32_swap(__float_as_uint(m), __float_as_uint(m), false, false); return __uint_as_float(r[0]) + __uint_as_float(r[1]); }
template <bool MASK> struct BoolC { static constexpr bool value = MASK; };
__device__ __forceinline__ void attn_phase(LAS unsigned char* lds, const bf16_t* PROJ, const float* FCUM, bf16_t* ATT) {
    const int tid = threadIdx.x, lane = tid & 63, wave = __builtin_amdgcn_readfirstlane(tid >> 6);
    const int g = lane >> 4, c16 = lane & 15, q4 = (lane & 15) >> 2, p4 = lane & 3;
    LAS unsigned char* Ks = lds;
    constexpr float C1 = 0.125f * LOG2E;
    const int lrow = tid >> 3, lch = tid & 7;
    const int vblk = (gridDim.x % 8 == 0) ? (int)((blockIdx.x & 7) * (gridDim.x >> 3) + (blockIdx.x >> 3)) : (int)blockIdx.x;
    for (int uid = vblk; uid < 1024; uid += gridDim.x) {
        const int round = uid >> 8, v = uid & 255, bh = v >> 1, par = v & 1, b = bh >> 3, hh = bh & 7;
        const int qb = par ? (round == 0 ? 1 : round == 1 ? 6 : round == 2 ? 3 : 4) : (round == 0 ? 0 : round == 1 ? 7 : round == 2 ? 2 : 5);
        const int q0 = qb * 256, NT = 4 * (qb + 1);
        const size_t rowbase = (size_t)b * SEQ;
        bf16x8 qf[2][2]; float mrun[2], lrun[2]; f32x4 acc[2][4];
#pragma unroll
        for (int qt = 0; qt < 2; ++qt) { const int qr = q0 + 32 * wave + 16 * qt + c16;
#pragma unroll
            for (int kd = 0; kd < 2; ++kd) qf[qt][kd] = *(const bf16x8*)(PROJ + (rowbase + qr) * NP + C_FQ + hh * 64 + 32 * kd + 8 * g);
            mrun[qt] = -1e30f; lrun[qt] = 0.f;
#pragma unroll
            for (int dt = 0; dt < 4; ++dt) acc[qt][dt] = (f32x4){0.f, 0.f, 0.f, 0.f}; }
        u32x4 kreg[2], vreg[2]; float freg[2];
#define ATT_LOAD(tt, S) do { const size_t r_ = rowbase + (size_t)(tt) * 64 + lrow; \
            kreg[S] = *(const u32x4*)(PROJ + r_ * NP + C_FK + hh * 64 + lch * 8); vreg[S] = *(const u32x4*)(PROJ + r_ * NP + C_FV + hh * 64 + lch * 8); \
            freg[S] = FCUM[(size_t)bh * SEQ + (tt) * 64 + (tid & 63)]; } while (0)
#define ATT_STORE(tt, S) do { LAS unsigned char* kb_ = Ks + ((tt) & 1) * 18688; \
            *(LAS u32x4*)(kb_ + lrow * 128 + ((lch ^ ((lrow >> 1) & 7)) * 16)) = kreg[S]; *(LAS u32x4*)(kb_ + 9216 + lrow * 144 + lch * 16) = vreg[S]; if (tid < 64) ((LAS float*)(kb_ + 18432))[tid] = -freg[S]; } while (0)
        ATT_LOAD(0, 0); ATT_LOAD(1, 1);
        LBAR();
        ATT_STORE(0, 0);
        LBAR();
        auto tile = [&](const int t, auto maskc) {
            constexpr bool MASK = decltype(maskc)::value;
            const LAS unsigned char* Kb = Ks + (t & 1) * 18688; const LAS unsigned char* Vb = Kb + 9216; const LAS float* fb = (const LAS float*)(Kb + 18432);
            if (!MASK || 64 * t <= q0 + 32 * wave + 31) {
                f32x4 s[4][2];
#pragma unroll
                for (int kt = 0; kt < 4; ++kt) {
#pragma unroll
                    for (int kd = 0; kd < 2; ++kd) { const bf16x8 kf = *(const LAS bf16x8*)(Kb + (16 * kt + c16) * 128 + (((4 * kd + g) ^ ((c16 >> 1) & 7)) * 16));
#pragma unroll
                        for (int qt = 0; qt < 2; ++qt) s[kt][qt] = __builtin_amdgcn_mfma_f32_16x16x32_bf16(kf, qf[qt][kd], kd == 0 ? (f32x4){0.f, 0.f, 0.f, 0.f} : s[kt][qt], 0, 0, 0); } }
#pragma unroll
                for (int kt = 0; kt < 4; ++kt) { const f32x4 nfk = *(const LAS f32x4*)(fb + 16 * kt + 4 * g);
#pragma unroll
                    for (int qt = 0; qt < 2; ++qt) { s[kt][qt] = s[kt][qt] * C1 + nfk;
                        if (MASK) {
#pragma unroll
                            for (int i = 0; i < 4; ++i) { const int kv = 64 * t + 16 * kt + 4 * g + i, qq = q0 + 32 * wave + 16 * qt + c16; if (kv > qq) s[kt][qt][i] = -1e30f; } } } }
                bf16x8 pf[2][2];
#pragma unroll
                for (int qt = 0; qt < 2; ++qt) {
                    float m0 = fmaxf(fmaxf(s[0][qt][0], s[0][qt][1]), fmaxf(s[0][qt][2], s[0][qt][3]));
#pragma unroll
                    for (int kt = 1; kt < 4; ++kt) { m0 = fmaxf(fmaxf(m0, s[kt][qt][0]), s[kt][qt][1]); m0 = fmaxf(fmaxf(m0, s[kt][qt][2]), s[kt][qt][3]); }
                    m0 = xmax32(xmax16(m0));
                    const float mnew = fmaxf(mrun[qt], m0), corr = __builtin_amdgcn_exp2f(mrun[qt] - mnew);
                    mrun[qt] = mnew;
#pragma unroll
                    for (int dt = 0; dt < 4; ++dt) acc[qt][dt] = acc[qt][dt] * corr;
                    f32x4 ps = (f32x4){0.f, 0.f, 0.f, 0.f};
#pragma unroll
                    for (int kt = 0; kt < 4; ++kt) { const f32x4 d = s[kt][qt] - mnew; f32x4 p;
                        p[0] = __builtin_amdgcn_exp2f(d[0]); p[1] = __builtin_amdgcn_exp2f(d[1]); p[2] = __builtin_amdgcn_exp2f(d[2]); p[3] = __builtin_amdgcn_exp2f(d[3]);
                        ps = ps + p; s[kt][qt] = p; }
                    lrun[qt] = lrun[qt] * corr + ((ps[0] + ps[1]) + (ps[2] + ps[3]));
#pragma unroll
                    for (int ks = 0; ks < 2; ++ks) { u32x4 w; w.x = pk2(s[2 * ks][qt][0], s[2 * ks][qt][1]); w.y = pk2(s[2 * ks][qt][2], s[2 * ks][qt][3]);
                        w.z = pk2(s[2 * ks + 1][qt][0], s[2 * ks + 1][qt][1]); w.w = pk2(s[2 * ks + 1][qt][2], s[2 * ks + 1][qt][3]); pf[qt][ks] = __builtin_bit_cast(bf16x8, w); }
                }
#pragma unroll
                for (int dt = 0; dt < 4; ++dt)
#pragma unroll
                    for (int ks = 0; ks < 2; ++ks) {
                        const s16x4 lo = vtr(Vb + (32 * ks + 4 * g + q4) * 144 + (16 * dt + 4 * p4) * 2), hi = vtr(Vb + (32 * ks + 16 + 4 * g + q4) * 144 + (16 * dt + 4 * p4) * 2);
                        const bf16x8 vf = (bf16x8){lo[0], lo[1], lo[2], lo[3], hi[0], hi[1], hi[2], hi[3]};
#pragma unroll
                        for (int qt = 0; qt < 2; ++qt) acc[qt][dt] = __builtin_amdgcn_mfma_f32_16x16x32_bf16(vf, pf[qt][ks], acc[qt][dt], 0, 0, 0);
                    }
            }
        };
        for (int t0 = 0; t0 < NT; t0 += 2) {
            const bool diag = (t0 >= NT - 4);
            ATT_LOAD(t0 + 2 < NT ? t0 + 2 : NT - 1, 0);
            if (diag) tile(t0, BoolC<true>{}); else tile(t0, BoolC<false>{});
            ATT_STORE(t0 + 1, 1); LBAR();
            ATT_LOAD(t0 + 3 < NT ? t0 + 3 : NT - 1, 1);
            if (diag) tile(t0 + 1, BoolC<true>{}); else tile(t0 + 1, BoolC<false>{});
            if (t0 + 2 < NT) ATT_STORE(t0 + 2, 0);
            LBAR();
        }
#undef ATT_LOAD
#undef ATT_STORE
#pragma unroll
        for (int qt = 0; qt < 2; ++qt) { float lt = xadd32(xadd16(lrun[qt])); const float inv = 1.0f / lt;
            const size_t qr = rowbase + q0 + 32 * wave + 16 * qt + c16;
#pragma unroll
            for (int dt = 0; dt < 4; ++dt) { const f32x4 o = acc[qt][dt] * inv; u32x2 w; w.x = pk2(o[0], o[1]); w.y = pk2(o[2], o[3]);
                *(u32x2*)(ATT + qr * 512 + hh * 64 + 16 * dt + 4 * g) = w; } }
    }
    LBAR();
}

__device__ __forceinline__ void mlstm_phase(LAS unsigned char* lds, const bf16_t* PROJ, const bf16_t* MQK, const float* G16, bf16_t* HRAW) {
    const int tid = threadIdx.x, lane = tid & 63, wave = __builtin_amdgcn_readfirstlane(tid >> 6);
    const int g = lane >> 4, c16 = lane & 15, q4 = (lane & 15) >> 2, p4 = lane & 3;
    LAS unsigned char* Qs = lds; LAS unsigned char* Ks = lds + 17408; LAS unsigned char* Vs = lds + 34816; LAS unsigned char* Vw = lds + 44032; LAS unsigned char* Cbt = lds + 53248;
    LAS float* bb = (LAS float*)(lds + 70656); LAS float* ee = (LAS float*)(lds + 78848); LAS float* cm = (LAS float*)(lds + 87040);
    LAS float* nbuf = (LAS float*)(lds + 95232); LAS float* wl = (LAS float*)(lds + 96256); LAS float* gch = (LAS float*)(lds + 96512);
    LAS float* amax = (LAS float*)(lds + 96640); LAS float* mprev = (LAS float*)(lds + 96768); LAS unsigned char* Hs = lds + 97280;
    constexpr float QSCALE = 0.08838834764831845f;
    const int vblk = (gridDim.x % 8 == 0) ? (int)((blockIdx.x & 7) * (gridDim.x >> 3) + (blockIdx.x >> 3)) : (int)blockIdx.x;
    for (int item = vblk; item < 256; item += gridDim.x) {
        const int bhid = item >> 2, vs = item & 3, b = bhid >> 2, h = bhid & 3;
        const size_t rowbase = (size_t)b * SEQ;
        {
            float lf[4], ig[4];
#pragma unroll
            for (int i = 0; i < 4; ++i) { const float* gp = G16 + (rowbase + 4 * tid + i) * 16; lf[i] = gp[12 + h]; ig[i] = gp[8 + h]; }
            lf[1] += lf[0]; lf[2] += lf[1]; lf[3] += lf[2];
            const float tot = lf[3]; float sc = tot;
#pragma unroll
            for (int o = 1; o < 16; o <<= 1) { const float y = __shfl_up(sc, o, 16); if (c16 >= o) sc += y; }
            const float excl = sc - tot;
            float bi[4], ei[4], pm[4];
#pragma unroll
            for (int i = 0; i < 4; ++i) { bi[i] = lf[i] + excl; ei[i] = ig[i] - bi[i]; }
            pm[0] = ei[0]; pm[1] = fmaxf(pm[0], ei[1]); pm[2] = fmaxf(pm[1], ei[2]); pm[3] = fmaxf(pm[2], ei[3]);
            float scm = pm[3];
#pragma unroll
            for (int o = 1; o < 16; o <<= 1) { const float y = __shfl_up(scm, o, 16); if (c16 >= o) scm = fmaxf(scm, y); }
            float exm = __shfl_up(scm, 1, 16); if (c16 == 0) exm = -1e30f;
#pragma unroll
            for (int i = 0; i < 4; ++i) { bb[4 * tid + i] = bi[i]; ee[4 * tid + i] = ei[i]; cm[4 * tid + i] = fmaxf(pm[i], exm); }
            if (c16 == 15) { gch[tid >> 4] = bi[3]; amax[tid >> 4] = bi[3] + fmaxf(pm[3], exm); }
            if (tid < 128) nbuf[tid] = 0.f;
            for (int i = tid; i < 17408 / 4; i += 512) ((LAS unsigned*)Cbt)[i] = 0u;
        }
        LBAR();
        if (tid == 0) { float m = 0.f; for (int c = 0; c < 32; ++c) { mprev[c] = m; m = fmaxf(gch[c] + m, amax[c]); } mprev[32] = m; }
        LBAR();
        f32x4 Cst[2][4], Cn[2];
#pragma unroll
        for (int dd = 0; dd < 2; ++dd) { Cn[dd] = (f32x4){0.f, 0.f, 0.f, 0.f};
#pragma unroll
            for (int vt = 0; vt < 4; ++vt) Cst[dd][vt] = (f32x4){0.f, 0.f, 0.f, 0.f}; }
        const int vrow = tid >> 3, vch = tid & 7;
#define MLOAD(cc, Q, K, V) do { _Pragma("unroll") for (int i_ = 0; i_ < 2; ++i_) { const int p_ = tid + 512 * i_, row_ = p_ >> 4, ch_ = p_ & 15; const size_t r_ = rowbase + (size_t)(cc) * 64 + row_; \
            Q[i_] = *(const u32x4*)(MQK + r_ * DM + h * 256 + ch_ * 8); K[i_] = *(const u32x4*)(MQK + r_ * DM + h * 256 + 128 + ch_ * 8); } \
            V = *(const u32x4*)(PROJ + (rowbase + (size_t)(cc) * 64 + vrow) * NP + C_MV + h * 256 + vs * 64 + vch * 8); } while (0)
        u32x4 qA[2], kA[2], vA, qB[2], kB[2], vB;
        MLOAD(0, qA, kA, vA); MLOAD(1, qB, kB, vB);
        auto chunk = [&](const int c, u32x4 (&qreg)[2], u32x4 (&kreg)[2], u32x4& vreg) {
            const float mp = mprev[c], mn = mprev[c + 1], gc = gch[c];
#pragma unroll
            for (int i = 0; i < 2; ++i) { const int p = tid + 512 * i, row = p >> 4, ch = p & 15;
                *(LAS u32x4*)(Qs + row * 272 + ch * 16) = qreg[i]; *(LAS u32x4*)(Ks + row * 272 + ch * 16) = kreg[i]; }
            *(LAS u32x4*)(Vs + vrow * 144 + vch * 16) = vreg;
            { const float wv = __expf(gc + ee[64 * c + vrow] - mn); u32x4 o;
              o.x = pk2(bflo(vreg.x) * wv, bfhi(vreg.x) * wv); o.y = pk2(bflo(vreg.y) * wv, bfhi(vreg.y) * wv); o.z = pk2(bflo(vreg.z) * wv, bfhi(vreg.z) * wv); o.w = pk2(bflo(vreg.w) * wv, bfhi(vreg.w) * wv);
              *(LAS u32x4*)(Vw + vrow * 144 + vch * 16) = o; }
            if (tid < 64) wl[tid] = __expf(gc + ee[64 * c + tid] - mn);
            LBAR();
            MLOAD(c + 2 < 32 ? c + 2 : 31, qreg, kreg, vreg);
            const float decay = __expf(gc + mp - mn);
            if (wave < 4) {
                const int lt = wave, l = 16 * lt + c16;
                const float mx_l = fmaxf(mp, cm[64 * c + l]), winter = __expf(mp - mx_l);
                const LAS float* nb_ = nbuf + (c & 1) * 128;
                bf16x8 qf[4]; f32x4 n0[4], n1[4], e4[4];
#pragma unroll
                for (int kd = 0; kd < 4; ++kd) { qf[kd] = *(const LAS bf16x8*)(Qs + l * 272 + (32 * kd + 8 * g) * 2); n0[kd] = *(const LAS f32x4*)(nb_ + 32 * kd + 8 * g); n1[kd] = *(const LAS f32x4*)(nb_ + 32 * kd + 8 * g + 4); }
#pragma unroll
                for (int st = 0; st < 4; ++st) e4[st] = *(const LAS f32x4*)(ee + 64 * c + 16 * st + 4 * g);
                f32x4 sT[4], acc[4];
#pragma unroll
                for (int h2 = 0; h2 < 2; ++h2) {
                    bf16x8 kf[2][4];
#pragma unroll
                    for (int s2 = 0; s2 < 2; ++s2)
#pragma unroll
                        for (int kd = 0; kd < 4; ++kd) kf[s2][kd] = *(const LAS bf16x8*)(Ks + (16 * (2 * h2 + s2) + c16) * 272 + (32 * kd + 8 * g) * 2);
#pragma unroll
                    for (int s2 = 0; s2 < 2; ++s2) { sT[2 * h2 + s2] = (f32x4){0.f, 0.f, 0.f, 0.f};
#pragma unroll
                        for (int kd = 0; kd < 4; ++kd) sT[2 * h2 + s2] = __builtin_amdgcn_mfma_f32_16x16x32_bf16(kf[s2][kd], qf[kd], sT[2 * h2 + s2], 0, 0, 0); }
                    asm volatile("" ::: "memory");
                }
                float qn = 0.f;
#pragma unroll
                for (int kd = 0; kd < 4; ++kd) { const u32x4 qw = __builtin_bit_cast(u32x4, qf[kd]);
                    qn += bflo(qw.x) * n0[kd][0] + bfhi(qw.x) * n0[kd][1] + bflo(qw.y) * n0[kd][2] + bfhi(qw.y) * n0[kd][3] + bflo(qw.z) * n1[kd][0] + bfhi(qw.z) * n1[kd][1] + bflo(qw.w) * n1[kd][2] + bfhi(qw.w) * n1[kd][3]; }
                qn = xadd32(xadd16(qn));
#pragma unroll
                for (int h2 = 0; h2 < 2; ++h2) {
                    bf16x8 cf[2][4];
#pragma unroll
                    for (int j2 = 0; j2 < 2; ++j2)
#pragma unroll
                        for (int kd = 0; kd < 4; ++kd) cf[j2][kd] = *(const LAS bf16x8*)(Cbt + (16 * (2 * h2 + j2) + c16) * 272 + (32 * kd + 8 * g) * 2);
#pragma unroll
                    for (int j2 = 0; j2 < 2; ++j2) { acc[2 * h2 + j2] = (f32x4){0.f, 0.f, 0.f, 0.f};
#pragma unroll
                        for (int kd = 0; kd < 4; ++kd) acc[2 * h2 + j2] = __builtin_amdgcn_mfma_f32_16x16x32_bf16(cf[j2][kd], qf[kd], acc[2 * h2 + j2], 0, 0, 0); }
                    asm volatile("" ::: "memory");
                }
                bf16x8 vf[2][4];
#pragma unroll
                for (int ks = 0; ks < 2; ++ks)
#pragma unroll
                    for (int j = 0; j < 4; ++j) {
                        const s16x4 lo = vtr(Vs + (32 * ks + 4 * g + q4) * 144 + (16 * j + 4 * p4) * 2), hi = vtr(Vs + (32 * ks + 16 + 4 * g + q4) * 144 + (16 * j + 4 * p4) * 2);
                        vf[ks][j] = (bf16x8){lo[0], lo[1], lo[2], lo[3], hi[0], hi[1], hi[2], hi[3]}; }
                float psum = 0.f;
#pragma unroll
                for (int st = 0; st < 4; ++st)
#pragma unroll
                    for (int i = 0; i < 4; ++i) { const int sidx = 16 * st + 4 * g + i; float val = sT[st][i] * QSCALE * __expf(e4[st][i] - mx_l); if (sidx > l) val = 0.f; psum += val; sT[st][i] = val; }
                const float wis = winter * QSCALE;
#pragma unroll
                for (int j = 0; j < 4; ++j) acc[j] = acc[j] * wis;
#pragma unroll
                for (int ks = 0; ks < 2; ++ks) {
                    u32x4 w; w.x = pk2(sT[2 * ks][0], sT[2 * ks][1]); w.y = pk2(sT[2 * ks][2], sT[2 * ks][3]); w.z = pk2(sT[2 * ks + 1][0], sT[2 * ks + 1][1]); w.w = pk2(sT[2 * ks + 1][2], sT[2 * ks + 1][3]);
                    const bf16x8 pf = __builtin_bit_cast(bf16x8, w);
#pragma unroll
                    for (int j = 0; j < 4; ++j) acc[j] = __builtin_amdgcn_mfma_f32_16x16x32_bf16(vf[ks][j], pf, acc[j], 0, 0, 0);
                }
                psum = xadd32(xadd16(psum));
                const float den = wis * qn + psum, mt = bb[64 * c + l] + mx_l;
                const float inv = 1.0f / fmaxf(fabsf(den), __expf(-mt));
#pragma unroll
                for (int j = 0; j < 4; ++j) { const f32x4 o = acc[j] * inv; u32x2 w; w.x = pk2(o[0], o[1]); w.y = pk2(o[2], o[3]);
                    *(LAS u32x2*)(Hs + l * 144 + (16 * j + 4 * g) * 2) = w; }
            } else {
                const int dt0 = 2 * (wave - 4);
                bf16x8 vb[2][4], ka[2][2]; f32x4 w0[2], w1[2];
#pragma unroll
                for (int kl = 0; kl < 2; ++kl) {
                    w0[kl] = *(const LAS f32x4*)(wl + 32 * kl + 8 * g); w1[kl] = *(const LAS f32x4*)(wl + 32 * kl + 8 * g + 4);
#pragma unroll
                    for (int dd = 0; dd < 2; ++dd) {
                        const s16x4 alo = vtr(Ks + (32 * kl + 8 * g + q4) * 272 + (16 * (dt0 + dd) + 4 * p4) * 2), ahi = vtr(Ks + (32 * kl + 8 * g + 4 + q4) * 272 + (16 * (dt0 + dd) + 4 * p4) * 2);
                        ka[kl][dd] = (bf16x8){alo[0], alo[1], alo[2], alo[3], ahi[0], ahi[1], ahi[2], ahi[3]}; }
#pragma unroll
                    for (int vt = 0; vt < 4; ++vt) {
                        const s16x4 blo = vtr(Vw + (32 * kl + 8 * g + q4) * 144 + (16 * vt + 4 * p4) * 2), bhi = vtr(Vw + (32 * kl + 8 * g + 4 + q4) * 144 + (16 * vt + 4 * p4) * 2);
                        vb[kl][vt] = (bf16x8){blo[0], blo[1], blo[2], blo[3], bhi[0], bhi[1], bhi[2], bhi[3]}; }
                }
#pragma unroll
                for (int dd = 0; dd < 2; ++dd) { Cn[dd] = Cn[dd] * decay;
#pragma unroll
                    for (int vt = 0; vt < 4; ++vt) Cst[dd][vt] = Cst[dd][vt] * decay; }
#pragma unroll
                for (int kl = 0; kl < 2; ++kl) {
                    u32x4 wa; wa.x = pk2(w0[kl][0], w0[kl][1]); wa.y = pk2(w0[kl][2], w0[kl][3]); wa.z = pk2(w1[kl][0], w1[kl][1]); wa.w = pk2(w1[kl][2], w1[kl][3]);
                    if (c16 != 0) wa = (u32x4){0u, 0u, 0u, 0u};
#pragma unroll
                    for (int dd = 0; dd < 2; ++dd) {
                        Cn[dd] = __builtin_amdgcn_mfma_f32_16x16x32_bf16(ka[kl][dd], __builtin_bit_cast(bf16x8, wa), Cn[dd], 0, 0, 0);
#pragma unroll
                        for (int vt = 0; vt < 4; ++vt) Cst[dd][vt] = __builtin_amdgcn_mfma_f32_16x16x32_bf16(ka[kl][dd], vb[kl][vt], Cst[dd][vt], 0, 0, 0);
                    }
                }
                if (c16 == 0) {
#pragma unroll
                    for (int dd = 0; dd < 2; ++dd) *(LAS f32x4*)(nbuf + ((c + 1) & 1) * 128 + 16 * (dt0 + dd) + 4 * g) = Cn[dd]; }
            }
            LBAR();
            *(u32x4*)(HRAW + (rowbase + (size_t)c * 64 + vrow) * DM + h * 256 + vs * 64 + vch * 8) = *(const LAS u32x4*)(Hs + vrow * 144 + vch * 16);
            if (wave >= 4) {
                const int dt0 = 2 * (wave - 4);
#pragma unroll
                for (int dd = 0; dd < 2; ++dd)
#pragma unroll
                    for (int vt = 0; vt < 4; ++vt) { u32x2 w; w.x = pk2(Cst[dd][vt][0], Cst[dd][vt][1]); w.y = pk2(Cst[dd][vt][2], Cst[dd][vt][3]);
                        *(LAS u32x2*)(Cbt + (16 * vt + c16) * 272 + (16 * (dt0 + dd) + 4 * g) * 2) = w; }
            }
        };
        for (int c0 = 0; c0 < 32; c0 += 2) { chunk(c0, qA, kA, vA); chunk(c0 + 1, qB, kB, vB); }
#undef MLOAD
        LBAR();
    }
}

__device__ __forceinline__ void headnorm_phase(const bf16_t* PROJ, const float* gnorm, bf16_t* HM) {
    const int tid = threadIdx.x, lane = tid & 63, wave = __builtin_amdgcn_readfirstlane(tid >> 6);
    float gq[16]; { float t0[8], t1[8]; ld8f(gnorm + 16 * lane, t0); ld8f(gnorm + 16 * lane + 8, t1);
#pragma unroll
        for (int e = 0; e < 8; ++e) { gq[e] = t0[e]; gq[8 + e] = t1[e]; } }
    for (int m0 = (blockIdx.x * 8 + wave) * 4; m0 < MT; m0 += gridDim.x * 32) {
        u32x4 hr[4][2], mr[4][2];
#pragma unroll
        for (int r = 0; r < 4; ++r) { const bf16_t* hp = HM + (size_t)(m0 + r) * DM + 16 * lane; const bf16_t* mo = PROJ + (size_t)(m0 + r) * NP + C_MO + 16 * lane;
            hr[r][0] = *(const u32x4*)hp; hr[r][1] = *(const u32x4*)(hp + 8); mr[r][0] = *(const u32x4*)mo; mr[r][1] = *(const u32x4*)(mo + 8); }
#pragma unroll
        for (int r = 0; r < 4; ++r) {
            float v[16], og[16];
            { float t0[8], t1[8]; unpack8(hr[r][0], t0); unpack8(hr[r][1], t1);
#pragma unroll
              for (int e = 0; e < 8; ++e) { v[e] = t0[e]; v[8 + e] = t1[e]; }
              unpack8(mr[r][0], t0); unpack8(mr[r][1], t1);
#pragma unroll
              for (int e = 0; e < 8; ++e) { og[e] = t0[e]; og[8 + e] = t1[e]; } }
            float s = 0.f;
#pragma unroll
            for (int i = 0; i < 16; ++i) s += v[i];
#pragma unroll
            for (int o = 1; o < 16; o <<= 1) s += __shfl_xor(s, o);
            const float mean = s * (1.f / 256.f); float s2 = 0.f;
#pragma unroll
            for (int i = 0; i < 16; ++i) { v[i] -= mean; s2 += v[i] * v[i]; }
#pragma unroll
            for (int o = 1; o < 16; o <<= 1) s2 += __shfl_xor(s2, o);
            const float rstd = 1.f / sqrtf(s2 * (1.f / 256.f) + LN_EPS);
            float r0[8], r1[8];
#pragma unroll
            for (int e = 0; e < 8; ++e) { r0[e] = v[e] * rstd * gq[e] * sigmoidf_(og[e]); r1[e] = v[8 + e] * rstd * gq[8 + e] * sigmoidf_(og[8 + e]); }
            bf16_t* hp = HM + (size_t)(m0 + r) * DM + 16 * lane;
            *(u32x4*)hp = pack8(r0); *(u32x4*)(hp + 8) = pack8(r1);
        }
    }
}

__device__ __forceinline__ void ln16(float (&v)[2][8]) {
    float s = 0.f;
#pragma unroll
    for (int j = 0; j < 2; ++j)
#pragma unroll
        for (int e = 0; e < 8; ++e) s += v[j][e];
    const float mean = wave_sum(s) * (1.f / DM); float s2 = 0.f;
#pragma unroll
    for (int j = 0; j < 2; ++j)
#pragma unroll
        for (int e = 0; e < 8; ++e) { v[j][e] -= mean; s2 += v[j][e] * v[j][e]; }
    const float rstd = 1.f / sqrtf(wave_sum(s2) * (1.f / DM) + LN_EPS);
#pragma unroll
    for (int j = 0; j < 2; ++j)
#pragma unroll
        for (int e = 0; e < 8; ++e) v[j][e] *= rstd;
}
__device__ __forceinline__ void ln_mid_phase(const bf16_t* Z, const float* lg, const float* lb, const float* MOD, bf16_t* X1, bf16_t* H2) {
    const int tid = threadIdx.x, lane = tid & 63, wave = __builtin_amdgcn_readfirstlane(tid >> 6);
    float gg[2][8], bq[2][8];
#pragma unroll
    for (int j = 0; j < 2; ++j) { ld8f(lg + 8 * lane + 512 * j, gg[j]); ld8f(lb + 8 * lane + 512 * j, bq[j]); }
    for (int m0 = (blockIdx.x * 8 + wave) * 4; m0 < MT; m0 += gridDim.x * 32) {
        const int b = m0 >> 11;
        u32x4 raw[4][2]; float sh[2][8], sc[2][8];
#pragma unroll
        for (int r = 0; r < 4; ++r)
#pragma unroll
            for (int j = 0; j < 2; ++j) raw[r][j] = *(const u32x4*)(Z + (size_t)(m0 + r) * DM + 8 * lane + 512 * j);
#pragma unroll
        for (int j = 0; j < 2; ++j) { ld8f(MOD + (size_t)b * 6144 + 3072 + 8 * lane + 512 * j, sh[j]); ld8f(MOD + (size_t)b * 6144 + 4096 + 8 * lane + 512 * j, sc[j]); }
        asm volatile("" ::: "memory");
#pragma unroll
        for (int r = 0; r < 4; ++r) {
            float v[2][8]; unpack8(raw[r][0], v[0]); unpack8(raw[r][1], v[1]);
            ln16(v);
#pragma unroll
            for (int j = 0; j < 2; ++j) {
#pragma unroll
                for (int e = 0; e < 8; ++e) v[j][e] = v[j][e] * gg[j][e] + bq[j][e];
                *(u32x4*)(X1 + (size_t)(m0 + r) * DM + 8 * lane + 512 * j) = pack8(v[j]); }
            ln16(v);
#pragma unroll
            for (int j = 0; j < 2; ++j) {
#pragma unroll
                for (int e = 0; e < 8; ++e) v[j][e] = v[j][e] * (sc[j][e] + 1.0f) + sh[j][e];
                *(u32x4*)(H2 + (size_t)(m0 + r) * DM + 8 * lane + 512 * j) = pack8(v[j]); }
        }
    }
}
__device__ __forceinline__ void ln_out_phase(const bf16_t* Z, const float* lg, const float* lb, float* OUT) {
    const int tid = threadIdx.x, lane = tid & 63, wave = __builtin_amdgcn_readfirstlane(tid >> 6);
    float gg[2][8], bq[2][8];
#pragma unroll
    for (int j = 0; j < 2; ++j) { ld8f(lg + 8 * lane + 512 * j, gg[j]); ld8f(lb + 8 * lane + 512 * j, bq[j]); }
    for (int m0 = (blockIdx.x * 8 + wave) * 4; m0 < MT; m0 += gridDim.x * 32) {
        u32x4 raw[4][2];
#pragma unroll
        for (int r = 0; r < 4; ++r)
#pragma unroll
            for (int j = 0; j < 2; ++j) raw[r][j] = *(const u32x4*)(Z + (size_t)(m0 + r) * DM + 8 * lane + 512 * j);
#pragma unroll
        for (int r = 0; r < 4; ++r) {
            float v[2][8]; unpack8(raw[r][0], v[0]); unpack8(raw[r][1], v[1]);
            ln16(v);
#pragma unroll
            for (int j = 0; j < 2; ++j) { float* op = OUT + (size_t)(m0 + r) * DM + 8 * lane + 512 * j;
                *(f32x4*)op = (f32x4){v[j][0] * gg[j][0] + bq[j][0], v[j][1] * gg[j][1] + bq[j][1], v[j][2] * gg[j][2] + bq[j][2], v[j][3] * gg[j][3] + bq[j][3]};
                *(f32x4*)(op + 4) = (f32x4){v[j][4] * gg[j][4] + bq[j][4], v[j][5] * gg[j][5] + bq[j][5], v[j][6] * gg[j][6] + bq[j][6], v[j][7] * gg[j][7] + bq[j][7]}; }
        }
    }
}

#define XB_TMO      128
#define XB_XCNT(j)  (256  + 64 * (j))
#define XB_XSUB(j)  (1280 + 64 * (j))
#define XB_XGEN(j)  (2304 + 64 * (j))
#define XB_TOP      3328
#define XB_TOPGEN   3392
#define XCD_BAR_WORDS 3456
#define XB_SPIN_CAP (1u << 22)
__device__ __forceinline__ unsigned xb_ld(unsigned* p)              { return __hip_atomic_load(p, __ATOMIC_RELAXED, __HIP_MEMORY_SCOPE_AGENT); }
__device__ __forceinline__ unsigned xb_add(unsigned* p, unsigned v) { return __hip_atomic_fetch_add(p, v, __ATOMIC_RELAXED, __HIP_MEMORY_SCOPE_AGENT); }
__device__ __forceinline__ unsigned xb_xcc_id() { return (unsigned)__builtin_amdgcn_s_getreg((3 << 11) | 20) & 0xFu; }
#define XB_SPIN(cond, bar) do { unsigned _sp = 0; while (cond) { __builtin_amdgcn_s_sleep(1); \
    if ((++_sp & 255u) == 0u) { if (xb_ld(&(bar)[XB_TMO])) break; if (_sp > XB_SPIN_CAP) { atomicAdd(&(bar)[XB_TMO], 1u); break; } } } } while (0)
struct XcdBarrier { unsigned* bar; unsigned x; volatile LAS unsigned* st; };
__device__ __forceinline__ XcdBarrier xcd_barrier_post(unsigned* bar, volatile LAS unsigned* st) {
    XcdBarrier b; b.bar = bar; b.x = xb_xcc_id(); b.st = st;
    if (threadIdx.x == 0) (void)xb_add(&bar[XB_XCNT(b.x)], 1u);
    return b;
}
__device__ __forceinline__ void xcd_barrier_complete(unsigned* bar, unsigned x, unsigned& nloc, unsigned& nx) {
    const unsigned G = gridDim.x * gridDim.y * gridDim.z;
    unsigned sum, cnt, mine, sp = 0u;
    for (;;) {
        sum = 0u; cnt = 0u; mine = 0u;
#pragma unroll
        for (unsigned j = 0; j < 16; ++j) { const unsigned c = xb_ld(&bar[XB_XCNT(j)]); sum += c; cnt += (c > 0u) ? 1u : 0u; mine = (j == x) ? c : mine; }
        if (sum == G) break;
        __builtin_amdgcn_s_sleep(1);
        if ((++sp & 255u) == 0u) { if (xb_ld(&bar[XB_TMO])) break; if (sp > XB_SPIN_CAP) { atomicAdd(&bar[XB_TMO], 1u); break; } }
    }
    nloc = mine > 0u ? mine : 1u; nx = cnt > 0u ? cnt : 1u;
}
__device__ __forceinline__ void xcd_barrier(const XcdBarrier& b) {
    asm volatile("s_waitcnt vmcnt(0)" ::: "memory");
    __syncthreads();
    if (threadIdx.x == 0) {
        unsigned* bar = b.bar;
        __builtin_amdgcn_s_waitcnt(0);
        unsigned nloc = b.st[0], nx = b.st[1];
        if (nloc == 0u) { xcd_barrier_complete(bar, b.x, nloc, nx); b.st[0] = nloc; b.st[1] = nx; }
        const unsigned old = xb_add(&bar[XB_XSUB(b.x)], 1u);
        const unsigned gen = old / nloc;
        if (old + 1u == (gen + 1u) * nloc) {
            __builtin_amdgcn_fence(__ATOMIC_RELEASE, "agent");
            asm volatile("s_waitcnt vmcnt(0)" ::: "memory");
            const unsigned og = xb_add(&bar[XB_TOP], 1u);
            const unsigned tg = og / nx;
            if (og + 1u == (tg + 1u) * nx) xb_add(&bar[XB_TOPGEN], 1u);
            else XB_SPIN(xb_ld(&bar[XB_TOPGEN]) == tg, bar);
            __builtin_amdgcn_fence(__ATOMIC_ACQUIRE, "agent");
            xb_add(&bar[XB_XGEN(b.x)], 1u);
            asm volatile("s_waitcnt vmcnt(0)" ::: "memory");
        } else {
            XB_SPIN(xb_ld(&bar[XB_XGEN(b.x)]) == gen, bar);
            __builtin_amdgcn_fence(__ATOMIC_ACQUIRE, "agent");
            asm volatile("s_waitcnt vmcnt(0)" ::: "memory");
        }
    }
    __syncthreads();
}

__device__ __forceinline__ void split_arrive(unsigned* ctr) {
    asm volatile("s_waitcnt vmcnt(0)" ::: "memory");
    __syncthreads();
    if (threadIdx.x == 0) { __builtin_amdgcn_fence(__ATOMIC_RELEASE, "agent"); asm volatile("s_waitcnt vmcnt(0)" ::: "memory"); (void)xb_add(ctr, 1u); }
}
__device__ __forceinline__ void split_wait(unsigned* ctr, unsigned want) {
    if (threadIdx.x == 0) { unsigned sp = 0; while (xb_ld(ctr) < want) { __builtin_amdgcn_s_sleep(2); if (++sp > (1u << 24)) break; }
        __builtin_amdgcn_fence(__ATOMIC_ACQUIRE, "agent"); asm volatile("s_waitcnt vmcnt(0)" ::: "memory"); }
    __syncthreads();
}

constexpr int N_PHASES = 12;
struct Args { const float* in[20]; float* out; unsigned char* ws; int ph_lo, ph_hi; };

__global__ void __launch_bounds__(512, 2) fwd_megakernel(Args a) {
    extern __shared__ __attribute__((aligned(16))) unsigned char lds_raw[];
    LAS unsigned char* lds = (LAS unsigned char*)lds_raw;
    cg::grid_group grid = cg::this_grid();
    unsigned char* ws = a.ws; unsigned char* dob = (unsigned char*)a.out;
    const int lo = a.ph_lo, hi = a.ph_hi, G = gridDim.x;
#ifndef REP_ID
#define REP_ID 0
#endif
#ifndef PH_MASK
#define PH_MASK 0x1ff
#endif
#define IN(k) (((PH_MASK >> (k)) & 1) && lo <= (k) && (k) < hi)
#define SEAM(k) do { if (IN(k) && IN((k) + 1)) { xcd_barrier(xbar); } } while (0)
    volatile LAS unsigned* MISC = (volatile LAS unsigned*)(lds + 131072 + 320);
    if (threadIdx.x < 32) MISC[threadIdx.x] = 0u;
    __syncthreads();
    XcdBarrier xbar = xcd_barrier_post((unsigned*)ws, MISC + 8);
    float* MOD = (float*)(ws + WS_MOD); float* G16 = (float*)(ws + WS_G16); float* FCUM = (float*)(ws + WS_FCUM);
    bf16_t* PROJ = (bf16_t*)(ws + WS_PROJ); bf16_t* ATT = (bf16_t*)(ws + WS_ATT);
    bf16_t* BUFA = (bf16_t*)(dob + DO_A); bf16_t* BUFB = (bf16_t*)(dob + DO_B);

    unsigned* SC = (unsigned*)(ws + WS_CNT + 98304);
    if (lo > 1000) grid.sync();
    if (IN(0)) {
        p0_prologue(lds, a.in, ws, SC);
        p1_ln_gates(lds, a.in[0], MOD, (const float*)(ws + WS_WG), (const float*)(ws + WS_BG), BUFA, G16);
    }
    SEAM(0);
    if (IN(1)) {
        fscan(lds, G16, FCUM);
        pg8::Gemm g{BUFA, (const bf16_t*)(ws + WS_WT_IN), MT, NP, 1024, 1024, 1024, 0}; pg8::StaticOrder S; S.init(MT, NP, G, (int)blockIdx.x);
        pg8::EpiProj E{PROJ, NP, a.in[5], 1};
        pg8::gemm_phase(lds, g, S, E);
    }
    SEAM(1);
    if (IN(2)) {
        conv_phase(PROJ, a.in[6], a.in[7], BUFA);
        split_arrive(SC + 64);
#if FOX_REF_ATTN
        attn_phase_ref((char*)lds_raw, PROJ, FCUM, ATT);
#else
        attn_phase(lds, PROJ, FCUM, ATT);
#endif
        split_wait(SC + 64, G);
        pg8::Gemm g{BUFA, (const bf16_t*)(ws + WS_WT_QK), MT, 1024, 256, 1024, 256, 512}; pg8::StaticOrder S; S.init(MT, 1024, G, (int)blockIdx.x);
        pg8::EpiProj E{BUFB, 1024, nullptr, 0};
        pg8::gemm_phase(lds, g, S, E);
    }
    SEAM(2);
    if (IN(3)) mlstm_phase(lds, PROJ, BUFB, G16, BUFA);
    SEAM(3);
    if (IN(4)) {
        headnorm_phase(PROJ, a.in[10], BUFA);
        split_arrive(SC + 128);
        { pg8::Gemm g{ATT, (const bf16_t*)(ws + WS_WT_PA), MT, 1024, 512, 512, 512, 0}; pg8::StaticOrder S; S.init(MT, 1024, G, (int)blockIdx.x);
          pg8::EpiY<0> E{BUFB, PROJ + C_GA};
          pg8::gemm_phase(lds, g, S, E); }
        split_wait(SC + 128, G);
        { pg8::Gemm g{BUFA, (const bf16_t*)(ws + WS_WT_PB), MT, 1024, 1024, 1024, 1024, 0}; pg8::StaticOrder S; S.init(MT, 1024, G, (int)blockIdx.x);
          pg8::EpiY<1> E{BUFB, PROJ + C_GB};
          pg8::gemm_phase(lds, g, S, E); }
    }
    SEAM(4);
    if (IN(5)) {
        pg8::Gemm g{BUFB, (const bf16_t*)(ws + WS_WT_OUT), MT, 1024, 1024, 1024, 1024, 0}; pg8::StaticOrder S; S.init(MT, 1024, G, (int)blockIdx.x);
        pg8::EpiRes<0> E{(const void*)a.in[0], MOD + 2048, (bf16_t*)(ws + WS_Z)};
        pg8::gemm_phase(lds, g, S, E);
    }
    SEAM(5);
    if (IN(6)) ln_mid_phase((const bf16_t*)(ws + WS_Z), a.in[14], a.in[15], MOD, (bf16_t*)(ws + WS_X1), BUFA);
    SEAM(6);
    if (IN(7)) {
        pg8::Gemm g{BUFA, (const bf16_t*)(ws + WS_WT_FI), MT, 2 * DFF, 1024, 1024, 1024, 0}; pg8::StaticOrder S; S.init(MT, 2 * DFF, G, (int)blockIdx.x);
        pg8::EpiSwiglu E{(bf16_t*)(ws + WS_ACT)};
        pg8::gemm_phase(lds, g, S, E);
    }
    SEAM(7);
    if (IN(8)) {
        pg8::Gemm g{(const bf16_t*)(ws + WS_ACT), (const bf16_t*)(ws + WS_WT_FD), MT, 1024, DFF, DFF, DFF, 0}; pg8::StaticOrder S; S.init(MT, 1024, G, (int)blockIdx.x);
        pg8::PanelStats st{(unsigned long long*)(ws + WS_XB3), (unsigned*)(ws + WS_CNT + 65536), lds + 132096};
        pg8::EpiLnOut E{(const bf16_t*)(ws + WS_X1), MOD + 5120, a.in[18], a.in[19], a.out, st};
        pg8::gemm_phase(lds, g, S, E);
    }
#undef IN
#undef SEAM
}

extern "C" void kernel_launch(void* const* d_in, const int* in_sizes, int n_in, void* d_out, int out_size, void* d_ws, size_t ws_size, hipStream_t stream) {
    static int grid = 0;
    if (grid == 0) {
        int dev = 0, cus = 0, per_cu = 0;
        hipGetDevice(&dev);
        hipDeviceGetAttribute(&cus, hipDeviceAttributeMultiprocessorCount, dev);
        if (hipFuncSetAttribute((const void*)fwd_megakernel, hipFuncAttributeMaxDynamicSharedMemorySize, LDS_BYTES) != hipSuccess) fprintf(stderr, "kernel_launch: hipFuncSetAttribute failed\n");
        if (hipOccupancyMaxActiveBlocksPerMultiprocessor(&per_cu, (const void*)fwd_megakernel, 512, LDS_BYTES) != hipSuccess || per_cu < 1) per_cu = 1;
        (void)hipGetLastError();
        grid = cus * per_cu; if (grid <= 0) grid = 256;
    }
    (void)hipMemsetAsync(d_ws, 0, 262144, stream);
    Args a{};
    for (int i = 0; i < 20; ++i) a.in[i] = (const float*)d_in[i];
    a.out = (float*)d_out; a.ws = (unsigned char*)d_ws;
    constexpr int NPH = 9;
    const int nl = MK_N_LAUNCHES;
    for (int li = 0; li < nl; ++li) {
        a.ph_lo = (nl == 1) ? 0 : li; a.ph_hi = (nl == 1) ? NPH : li + 1;
        void* args[] = {&a};
        hipError_t e = hipLaunchCooperativeKernel((const void*)fwd_megakernel, dim3(grid), dim3(512), args, LDS_BYTES, stream);
        if (e != hipSuccess) { fprintf(stderr, "cooperative launch failed: %s (grid %d)\n", hipGetErrorString(e), grid); break; }
    }
}
```

```cpp
#include <hip/hip_runtime.h>
#include <hip/hip_cooperative_groups.h>
#include <hip/hip_bf16.h>
#include <cmath>
#include <cstdio>
#include <cstdint>
namespace cg = cooperative_groups;

#ifndef FOX_REF_ATTN
#define FOX_REF_ATTN 1
#endif
#ifndef MK_N_LAUNCHES
#define MK_N_LAUNCHES 1
#endif

#define LAS __attribute__((address_space(3)))
typedef unsigned short bf16_t;
typedef short bf16x8 __attribute__((ext_vector_type(8)));
typedef short s16x4 __attribute__((ext_vector_type(4)));
typedef short v4i16_t __attribute__((ext_vector_type(4)));
typedef float f32x4 __attribute__((ext_vector_type(4)));
typedef float f32x2 __attribute__((ext_vector_type(2)));
typedef unsigned u32x4 __attribute__((ext_vector_type(4)));
typedef unsigned u32x2 __attribute__((ext_vector_type(2)));
typedef __bf16 bf16x2_t __attribute__((ext_vector_type(2)));

constexpr int BATCH = 16, SEQ = 2048, DM = 1024, MT = BATCH * SEQ;
constexpr int DIN = 6672, NP = 6656, DFF = 2816;
constexpr int C_FQ = 0, C_FK = 512, C_FV = 1024, C_MU = 1536, C_MV = 2560, C_MO = 3584, C_GA = 4608, C_GB = 5632;
constexpr float LN_EPS = 1e-5f, ALPHA = 1.189207115002721f, LOG2E = 1.4426950408889634f;
constexpr int LDS_BYTES = 147456;

constexpr size_t MiB = 1u << 20;
constexpr size_t WS_MOD = 1 * MiB, WS_WG = 2 * MiB, WS_BG = 2 * MiB + 65536, WS_FCUM = 3 * MiB, WS_G16 = 4 * MiB;
constexpr size_t WS_WT_IN = 8 * MiB, WS_WT_QK = 21 * MiB, WS_WT_PA = 22 * MiB, WS_WT_PB = 23 * MiB, WS_WT_OUT = 25 * MiB, WS_WT_FI = 27 * MiB, WS_WT_FD = 38 * MiB;
constexpr size_t WS_XB1 = 44 * MiB, WS_XB2 = 45 * MiB, WS_XB3 = 46 * MiB;
constexpr size_t WS_CNT = 65536;
constexpr size_t WS_PROJ = 48 * MiB;
constexpr size_t WS_ATT = 464 * MiB;
constexpr size_t WS_Z = 48 * MiB;
constexpr size_t WS_X1 = 176 * MiB;
constexpr size_t WS_ACT = 304 * MiB;
constexpr size_t WS_Z2 = 48 * MiB;
constexpr size_t DO_A = 0, DO_B = 64 * MiB;

__device__ __forceinline__ unsigned pk2(float lo, float hi) { f32x2 v = {lo, hi}; bf16x2_t b = __builtin_convertvector(v, bf16x2_t); return __builtin_bit_cast(unsigned, b); }
__device__ __forceinline__ float bflo(unsigned w) { return __uint_as_float(w << 16); }
__device__ __forceinline__ float bfhi(unsigned w) { return __uint_as_float(w & 0xffff0000u); }
__device__ __forceinline__ float sigmoidf_(float x) { return __builtin_amdgcn_rcpf(1.0f + __expf(-x)); }
__device__ __forceinline__ float logsig(float x) { return fminf(x, 0.f) - log1pf(expf(-fabsf(x))); }
__device__ __forceinline__ float wave_sum(float v) {
#pragma unroll
    for (int o = 1; o < 64; o <<= 1) v += __shfl_xor(v, o);
    return v;
}
__device__ __forceinline__ s16x4 vtr(const LAS unsigned char* p) { return __builtin_bit_cast(s16x4, __builtin_amdgcn_ds_read_tr16_b64_v4i16((LAS v4i16_t*)p)); }
#define LDS_WAIT() asm volatile("s_waitcnt lgkmcnt(0)" ::: "memory")
#define LBAR() do { asm volatile("s_waitcnt lgkmcnt(0)" ::: "memory"); __builtin_amdgcn_s_barrier(); asm volatile("" ::: "memory"); } while (0)

__device__ __forceinline__ void unpack8(const u32x4 w, float (&v)[8]) { v[0] = bflo(w.x); v[1] = bfhi(w.x); v[2] = bflo(w.y); v[3] = bfhi(w.y); v[4] = bflo(w.z); v[5] = bfhi(w.z); v[6] = bflo(w.w); v[7] = bfhi(w.w); }
__device__ __forceinline__ u32x4 pack8(const float (&v)[8]) { u32x4 w; w.x = pk2(v[0], v[1]); w.y = pk2(v[2], v[3]); w.z = pk2(v[4], v[5]); w.w = pk2(v[6], v[7]); return w; }
__device__ __forceinline__ void ld8f(const float* p, float (&v)[8]) { const f32x4 a = *(const f32x4*)p, b = *(const f32x4*)(p + 4); v[0] = a[0]; v[1] = a[1]; v[2] = a[2]; v[3] = a[3]; v[4] = b[0]; v[5] = b[1]; v[6] = b[2]; v[7] = b[3]; }

namespace pg8 {
constexpr int BM = 256, BK = 64, HALF = 128, HTB = HALF * BK * 2, STAGE_BYTES = 8 * HTB, NXCD = 8, WGM = 8;
__host__ __device__ __forceinline__ int lds_byte(int r, int c) { const int st = (r >> 4) * 2 + (c >> 5), rr = r & 15, cc = c & 31, ob = rr * 64 + cc * 2; return st * 1024 + (ob ^ (((ob >> 9) & 1) << 5)); }
__host__ __device__ __forceinline__ void stage_rc(int b, int& R, int& C) { const int st = b / 1024, sb = b % 1024, swz = sb ^ (((sb >> 9) & 1) << 5); R = (st >> 1) * 16 + swz / 64; C = (st & 1) * 32 + (swz % 64) / 2; }
__host__ __device__ __forceinline__ int perm32(int rho) { const int n = rho >> 4, i = rho & 15; return 8 * (i >> 2) + 4 * n + (i & 3); }

struct Unit { int pm, pn; };
struct Gemm { const bf16_t* A; const bf16_t* Bt; int M, N, K, lda, ldb, aoffN; };

struct StaticOrder {
    int nM, nN, nwg, G, c;
    __device__ void init(int M, int N, int G_, int c_) { nM = M / BM; nN = N / BM; nwg = nM * nN; G = G_; c = c_; }
    __device__ bool next(int i, Unit& u) const {
        const long L = (long)i * G + c; if (L >= nwg) return false;
        int wgid = (int)L; { const int q = nwg / NXCD, r = nwg % NXCD, xcd = wgid % NXCD, off = wgid / NXCD; wgid = (xcd < r ? xcd * (q + 1) : r * (q + 1) + (xcd - r) * q) + off; }
        const int nig = WGM * nN, gid = wgid / nig, fm = gid * WGM, gsz = (nM - fm) < WGM ? (nM - fm) : WGM;
        u.pm = fm + ((wgid % nig) % gsz); u.pn = (wgid % nig) / gsz; return true;
    }
};
template <class Epi, class Sched>
__device__ __forceinline__ void gemm_phase(LAS unsigned char* lds, const Gemm g, const Sched& S, const Epi& E) {
    const int tid = threadIdx.x, wid = __builtin_amdgcn_readfirstlane(tid >> 6), lane = tid & 63, wr = wid >> 2, wc = wid & 3, fr = lane & 15, fq = lane >> 4;
    const int K = g.K, nt = K / BK;
    unsigned voffA[2], voffB[2];
#pragma unroll
    for (int i = 0; i < 2; ++i) { int R, C; stage_rc(tid * 16 + i * 8192, R, C); const int Rb = Epi::PERM ? ((R & ~31) + perm32(R & 31)) : R;
        voffA[i] = (unsigned)(R * g.lda + C) * 2u; voffB[i] = (unsigned)(Rb * g.ldb + C) * 2u; }
    const size_t kstep = (size_t)(BK * 2);
    const size_t hstepA = (size_t)HALF * g.lda * 2, hstepB = (size_t)HALF * g.ldb * 2;
    const size_t tstepA = 2 * hstepA, tstepB = 2 * hstepB;
    const unsigned ldsw = (unsigned)wid * 1024u;
    const int aoff = lds_byte(wr * 64 + fr, fq * 8), boff = lds_byte(wc * 32 + fr, fq * 8);
#define PG8_SA(b, h) (((b) * 2 + (h)) * HTB)
#define PG8_SB(b, h) ((4 + (b) * 2 + (h)) * HTB)
#define PG8_STAGE(bufoff, gbase, voff) do { _Pragma("unroll") for (int _i = 0; _i < 2; ++_i) \
        __builtin_amdgcn_global_load_lds((const unsigned*)((const char*)(gbase) + (voff)[_i]), (LAS unsigned*)(lds + (bufoff) + ldsw + _i * 8192), 16, 0, 0); } while (0)
#define PG8_LDA(dst, b, h) do { _Pragma("unroll") for (int m = 0; m < 4; ++m) _Pragma("unroll") for (int k = 0; k < 2; ++k) dst[m][k] = *(const LAS bf16x8*)(lds + PG8_SA(b, h) + aoff + m * 2048 + k * 1024); } while (0)
#define PG8_LDB(dst, b, h) do { _Pragma("unroll") for (int n = 0; n < 2; ++n) _Pragma("unroll") for (int k = 0; k < 2; ++k) dst[n][k] = *(const LAS bf16x8*)(lds + PG8_SB(b, h) + boff + n * 2048 + k * 1024); } while (0)
#define PG8_MMA(ai, bj, At, Bt) do { __builtin_amdgcn_s_setprio(1); _Pragma("unroll") for (int m = 0; m < 4; ++m) _Pragma("unroll") for (int n = 0; n < 2; ++n) _Pragma("unroll") for (int k = 0; k < 2; ++k) \
        acc[ai][bj][m][n] = __builtin_amdgcn_mfma_f32_16x16x32_bf16(Bt[n][k], At[m][k], acc[ai][bj][m][n], 0, 0, 0); __builtin_amdgcn_s_setprio(0); } while (0)
#define PG8_WAIT_V(n) asm volatile("s_waitcnt vmcnt(" #n ")" ::: "memory")
#define PG8_WAIT_L(n) asm volatile("s_waitcnt lgkmcnt(" #n ")" ::: "memory")
#define PG8_BAR __builtin_amdgcn_s_barrier()
#define PG8_SCHED __builtin_amdgcn_sched_barrier(0)
    Unit cur, nxt; int ui = 0;
    if (!S.next(0, cur)) return;
    f32x4 acc[2][2][4][2];
#pragma unroll
    for (int a = 0; a < 2; ++a)
#pragma unroll
        for (int b = 0; b < 2; ++b)
#pragma unroll
            for (int m = 0; m < 4; ++m)
#pragma unroll
                for (int n = 0; n < 2; ++n) acc[a][b][m][n] = (f32x4){0.f, 0.f, 0.f, 0.f};
    bf16x8 At[4][2], B0[2][2], B1[2][2];
    const char* cA = (const char*)g.A + (size_t)cur.pm * tstepA + (size_t)cur.pn * g.aoffN; const char* cB = (const char*)g.Bt + (size_t)cur.pn * tstepB;
    PG8_STAGE(PG8_SB(0, 0), cB, voffB); PG8_STAGE(PG8_SB(0, 1), cB + hstepB, voffB); PG8_STAGE(PG8_SA(0, 0), cA, voffA); PG8_STAGE(PG8_SA(0, 1), cA + hstepA, voffA);
    if (wr == 1) PG8_BAR;
    PG8_WAIT_V(2); PG8_BAR;
    PG8_STAGE(PG8_SB(1, 0), cB + kstep, voffB); PG8_STAGE(PG8_SA(1, 0), cA + kstep, voffA); PG8_STAGE(PG8_SB(1, 1), cB + hstepB + kstep, voffB);
    PG8_WAIT_V(6); PG8_BAR;
    for (;;) {
        const bool has_next = S.next(ui + 1, nxt);
        const char* nA = has_next ? (const char*)g.A + (size_t)nxt.pm * tstepA + (size_t)nxt.pn * g.aoffN : cA; const char* nB = has_next ? (const char*)g.Bt + (size_t)nxt.pn * tstepB : cB;
        for (int t = 0; t < nt; t += 2) {
            const bool last = (t == nt - 2);
            const char* a1 = cA + (size_t)(t + 1) * kstep;
            const char* a2 = last ? nA : cA + (size_t)(t + 2) * kstep; const char* b2 = last ? nB : cB + (size_t)(t + 2) * kstep;
            const char* a3 = a2 + kstep; const char* b3 = b2 + kstep;
            PG8_LDB(B0, 0, 0); PG8_LDB(B1, 0, 1); PG8_SCHED; PG8_LDA(At, 0, 0); PG8_STAGE(PG8_SA(1, 1), a1 + hstepA, voffA);
            PG8_WAIT_V(8); PG8_WAIT_L(0); PG8_BAR; PG8_MMA(0, 0, At, B0); PG8_MMA(0, 1, At, B1); PG8_BAR; PG8_SCHED;
            PG8_LDA(At, 0, 1); PG8_STAGE(PG8_SB(0, 0), b2, voffB); PG8_STAGE(PG8_SB(0, 1), b2 + hstepB, voffB); PG8_STAGE(PG8_SA(0, 0), a2, voffA);
            PG8_WAIT_V(8); PG8_WAIT_L(0); PG8_BAR; PG8_MMA(1, 0, At, B0); PG8_MMA(1, 1, At, B1); PG8_BAR; PG8_SCHED;
            PG8_LDB(B0, 1, 0); PG8_LDB(B1, 1, 1); PG8_SCHED; PG8_LDA(At, 1, 0); PG8_STAGE(PG8_SA(0, 1), a2 + hstepA, voffA);
            PG8_WAIT_V(8); PG8_WAIT_L(0); PG8_BAR; PG8_MMA(0, 0, At, B0); PG8_MMA(0, 1, At, B1); PG8_BAR; PG8_SCHED;
            PG8_LDA(At, 1, 1); PG8_STAGE(PG8_SB(1, 0), b3, voffB); PG8_STAGE(PG8_SB(1, 1), b3 + hstepB, voffB); PG8_STAGE(PG8_SA(1, 0), a3, voffA);
            PG8_WAIT_V(8); PG8_WAIT_L(0); PG8_BAR; PG8_MMA(1, 0, At, B0); PG8_MMA(1, 1, At, B1); PG8_BAR; PG8_SCHED;
        }
        if (wr == 0) PG8_BAR;
        asm volatile("" ::: "memory"); PG8_SCHED;
        E(acc, cur, wr, wc, fr, fq);
        if (!has_next) break;
#pragma unroll
        for (int a = 0; a < 2; ++a)
#pragma unroll
            for (int b = 0; b < 2; ++b)
#pragma unroll
                for (int m = 0; m < 4; ++m)
#pragma unroll
                    for (int n = 0; n < 2; ++n) acc[a][b][m][n] = (f32x4){0.f, 0.f, 0.f, 0.f};
        cur = nxt; cA = nA; cB = nB; ++ui;
        if (wr == 1) PG8_BAR;
    }
    PG8_WAIT_V(0);
    PG8_BAR;
#undef PG8_SA
#undef PG8_SB
#undef PG8_STAGE
#undef PG8_LDA
#undef PG8_LDB
#undef PG8_MMA
#undef PG8_WAIT_V
#undef PG8_WAIT_L
#undef PG8_BAR
#undef PG8_SCHED
}

struct EpiProj {
    static constexpr bool PERM = true;
    bf16_t* O; int ldc; const float* bias; int has_shift;
    __device__ __forceinline__ void operator()(f32x4 (&acc)[2][2][4][2], const Unit& u, int wr, int wc, int fr, int fq) const {
        const int row0 = u.pm * BM + wr * 64 + fr; const int colt = u.pn * BM; const int col0 = colt + wc * 32 + 8 * fq;
        int shift = 0; if (has_shift) shift = (colt >= 1536 ? 8 : 0) + (colt >= 3584 ? 8 : 0);
        f32x4 bv[2][2];
#pragma unroll
        for (int bj = 0; bj < 2; ++bj)
#pragma unroll
            for (int n = 0; n < 2; ++n) bv[bj][n] = bias ? *(const f32x4*)(bias + col0 + shift + bj * HALF + 4 * n) : (f32x4){0.f, 0.f, 0.f, 0.f};
#pragma unroll
        for (int ai = 0; ai < 2; ++ai)
#pragma unroll
            for (int m = 0; m < 4; ++m) { bf16_t* rowp = O + (size_t)(row0 + ai * HALF + m * 16) * ldc + col0;
#pragma unroll
                for (int bj = 0; bj < 2; ++bj) { const f32x4 v0 = acc[ai][bj][m][0] + bv[bj][0], v1 = acc[ai][bj][m][1] + bv[bj][1];
                    u32x4 w; w.x = pk2(v0[0], v0[1]); w.y = pk2(v0[2], v0[3]); w.z = pk2(v1[0], v1[1]); w.w = pk2(v1[2], v1[3]);
                    __builtin_nontemporal_store(w, (u32x4*)(rowp + bj * HALF)); } }
    }
};
template <int MODE> struct EpiY {
    static constexpr bool PERM = true;
    bf16_t* Y; const bf16_t* G;
    __device__ __forceinline__ void operator()(f32x4 (&acc)[2][2][4][2], const Unit& u, int wr, int wc, int fr, int fq) const {
        const int row0 = u.pm * BM + wr * 64 + fr; const int col0 = u.pn * BM + wc * 32 + 8 * fq;
#pragma unroll
        for (int ai = 0; ai < 2; ++ai) {
            u32x4 gv[4][2], yo[4][2];
#pragma unroll
            for (int m = 0; m < 4; ++m)
#pragma unroll
                for (int bj = 0; bj < 2; ++bj) { const size_t row = (size_t)(row0 + ai * HALF + m * 16); const int col = col0 + bj * HALF;
                    gv[m][bj] = *(const u32x4*)(G + row * NP + col); if (MODE == 1) yo[m][bj] = *(const u32x4*)(Y + row * DM + col); }
            asm volatile("" ::: "memory");
#pragma unroll
            for (int m = 0; m < 4; ++m)
#pragma unroll
                for (int bj = 0; bj < 2; ++bj) { const size_t row = (size_t)(row0 + ai * HALF + m * 16); const int col = col0 + bj * HALF;
                    const f32x4 a0 = acc[ai][bj][m][0], a1 = acc[ai][bj][m][1]; float gsg[8], r[8]; unpack8(gv[m][bj], gsg);
#pragma unroll
                    for (int e = 0; e < 4; ++e) { r[e] = sigmoidf_(gsg[e]) * a0[e]; r[4 + e] = sigmoidf_(gsg[4 + e]) * a1[e]; }
                    if (MODE == 1) { float yv[8]; unpack8(yo[m][bj], yv);
#pragma unroll
                        for (int e = 0; e < 8; ++e) r[e] += yv[e]; }
                    *(u32x4*)(Y + row * DM + col) = pack8(r); }
            asm volatile("" ::: "memory");
        }
    }
};
template <int XBF> struct EpiRes {
    static constexpr bool PERM = true;
    const void* X; const float* gmod; bf16_t* Z;
    __device__ __forceinline__ void operator()(f32x4 (&acc)[2][2][4][2], const Unit& u, int wr, int wc, int fr, int fq) const {
        const int row0 = u.pm * BM + wr * 64 + fr; const int col0 = u.pn * BM + wc * 32 + 8 * fq; const int b = (u.pm * BM) >> 11;
        f32x4 gv[2][2];
#pragma unroll
        for (int bj = 0; bj < 2; ++bj)
#pragma unroll
            for (int n = 0; n < 2; ++n) gv[bj][n] = *(const f32x4*)(gmod + (size_t)b * 6144 + col0 + bj * HALF + n * 4);
#pragma unroll
        for (int ai = 0; ai < 2; ++ai) {
            f32x4 xv[4][2][2];
#pragma unroll
            for (int m = 0; m < 4; ++m)
#pragma unroll
                for (int bj = 0; bj < 2; ++bj) { const size_t off = (size_t)(row0 + ai * HALF + m * 16) * DM + col0 + bj * HALF;
                    if (XBF) { const u32x4 w = *(const u32x4*)((const bf16_t*)X + off); xv[m][bj][0] = (f32x4){bflo(w.x), bfhi(w.x), bflo(w.y), bfhi(w.y)}; xv[m][bj][1] = (f32x4){bflo(w.z), bfhi(w.z), bflo(w.w), bfhi(w.w)}; }
                    else { xv[m][bj][0] = *(const f32x4*)((const float*)X + off); xv[m][bj][1] = *(const f32x4*)((const float*)X + off + 4); } }
            asm volatile("" ::: "memory");
#pragma unroll
            for (int m = 0; m < 4; ++m)
#pragma unroll
                for (int bj = 0; bj < 2; ++bj) { const size_t off = (size_t)(row0 + ai * HALF + m * 16) * DM + col0 + bj * HALF;
                    const f32x4 o0 = xv[m][bj][0] * ALPHA + gv[bj][0] * acc[ai][bj][m][0], o1 = xv[m][bj][1] * ALPHA + gv[bj][1] * acc[ai][bj][m][1];
                    u32x4 w; w.x = pk2(o0[0], o0[1]); w.y = pk2(o0[2], o0[3]); w.z = pk2(o1[0], o1[1]); w.w = pk2(o1[2], o1[3]);
                    *(u32x4*)(Z + off) = w; }
            asm volatile("" ::: "memory");
        }
    }
};
struct EpiSwiglu {
    static constexpr bool PERM = true;
    bf16_t* O;
    __device__ __forceinline__ void operator()(f32x4 (&acc)[2][2][4][2], const Unit& u, int wr, int wc, int fr, int fq) const {
        const int row0 = u.pm * BM + wr * 64 + fr; const int col0 = u.pn * HALF + wc * 32 + 8 * fq;
#pragma unroll
        for (int ai = 0; ai < 2; ++ai)
#pragma unroll
            for (int m = 0; m < 4; ++m) { bf16_t* rowp = O + (size_t)(row0 + ai * HALF + m * 16) * DFF + col0;
                const f32x4 g0 = acc[ai][0][m][0], g1 = acc[ai][0][m][1], u0 = acc[ai][1][m][0], u1 = acc[ai][1][m][1];
                float r[8];
#pragma unroll
                for (int e = 0; e < 4; ++e) { r[e] = g0[e] * sigmoidf_(g0[e]) * u0[e]; r[4 + e] = g1[e] * sigmoidf_(g1[e]) * u1[e]; }
                u32x4 w; w.x = pk2(r[0], r[1]); w.y = pk2(r[2], r[3]); w.z = pk2(r[4], r[5]); w.w = pk2(r[6], r[7]);
                __builtin_nontemporal_store(w, (u32x4*)rowp); }
    }
};

struct PanelStats {
    unsigned long long* xbuf;
    unsigned* cnt;
    LAS unsigned char* scr;
    __device__ __forceinline__ void run(const f32x4 (&v)[2][2][4][2], const Unit& u, int wr, int wc, int fr, int fq) const {
        const int lane = threadIdx.x & 63, wid = __builtin_amdgcn_readfirstlane(threadIdx.x >> 6);
        LAS f32x2* P = (LAS f32x2*)scr;
        LAS f32x2* S = (LAS f32x2*)(scr + 8192);
#pragma unroll
        for (int ai = 0; ai < 2; ++ai)
#pragma unroll
            for (int m = 0; m < 4; ++m) {
                float s = 0.f;
#pragma unroll
                for (int bj = 0; bj < 2; ++bj)
#pragma unroll
                    for (int n = 0; n < 2; ++n) { const f32x4 x = v[ai][bj][m][n]; s += (x[0] + x[1]) + (x[2] + x[3]); }
                s += __shfl_xor(s, 16); s += __shfl_xor(s, 32);
                const float mw = s * (1.0f / 64.0f); float q = 0.f;
#pragma unroll
                for (int bj = 0; bj < 2; ++bj)
#pragma unroll
                    for (int n = 0; n < 2; ++n) { const f32x4 d = v[ai][bj][m][n] - mw; q += (d[0] * d[0] + d[1] * d[1]) + (d[2] * d[2] + d[3] * d[3]); }
                q += __shfl_xor(q, 16); q += __shfl_xor(q, 32);
                if (fq == 0) P[(ai * HALF + wr * 64 + m * 16 + fr) * 4 + wc] = (f32x2){mw, q};
            }
        asm volatile("s_waitcnt lgkmcnt(0)" ::: "memory"); __builtin_amdgcn_s_barrier(); asm volatile("" ::: "memory");
        const int row = wid * 32 + (lane & 31);
        if (lane < 32) {
            const f32x2 a = P[row * 4 + 0], b = P[row * 4 + 1], c = P[row * 4 + 2], d = P[row * 4 + 3];
            const float mt = (a.x + b.x + c.x + d.x) * 0.25f;
            const float da = a.x - mt, db = b.x - mt, dc = c.x - mt, dd = d.x - mt;
            const float m2 = (a.y + b.y) + (c.y + d.y) + 64.0f * ((da * da + db * db) + (dc * dc + dd * dd));
            unsigned long long* slot = xbuf + ((size_t)(u.pm * BM + row) * 4 + u.pn);
            __hip_atomic_store(slot, ((unsigned long long)__float_as_uint(m2) << 32) | __float_as_uint(mt), __ATOMIC_RELAXED, __HIP_MEMORY_SCOPE_AGENT);
        }
        asm volatile("s_waitcnt vmcnt(0)" ::: "memory");
        if (lane == 0) __hip_atomic_fetch_add(cnt + 64 * u.pm, 1u, __ATOMIC_RELAXED, __HIP_MEMORY_SCOPE_AGENT);
        if (wid == 0) {
            unsigned sp = 0;
            for (;;) {
                if ((unsigned)__builtin_amdgcn_readfirstlane(__hip_atomic_load(cnt + 64 * u.pm, __ATOMIC_RELAXED, __HIP_MEMORY_SCOPE_AGENT)) >= 32u) break;
                if (++sp > (1u << 24)) break;
                __builtin_amdgcn_s_sleep(2);
            }
            __builtin_amdgcn_fence(__ATOMIC_ACQUIRE, "agent");
        }
        asm volatile("s_waitcnt vmcnt(0) lgkmcnt(0)" ::: "memory"); __builtin_amdgcn_s_barrier(); asm volatile("" ::: "memory");
        if (lane < 32) {
            const unsigned long long* slot = xbuf + (size_t)(u.pm * BM + row) * 4; float mt[4], m2[4]; float ms = 0.f;
#pragma unroll
            for (int t = 0; t < 4; ++t) { const unsigned long long w = __hip_atomic_load(slot + t, __ATOMIC_RELAXED, __HIP_MEMORY_SCOPE_AGENT); mt[t] = __uint_as_float((unsigned)w); m2[t] = __uint_as_float((unsigned)(w >> 32)); ms += mt[t]; }
            const float mean = ms * 0.25f; float q = 0.f;
#pragma unroll
            for (int t = 0; t < 4; ++t) { const float dm = mt[t] - mean; q += m2[t] + 256.0f * dm * dm; }
            S[row] = (f32x2){mean, 1.0f / sqrtf(q * (1.0f / 1024.0f) + LN_EPS)};
        }
        asm volatile("s_waitcnt lgkmcnt(0)" ::: "memory"); __builtin_amdgcn_s_barrier(); asm volatile("" ::: "memory");
    }
};
__device__ __forceinline__ const char* uptr(const void* p) { const unsigned long long v = (unsigned long long)p;
    const unsigned lo = __builtin_amdgcn_readfirstlane((unsigned)v), hi = __builtin_amdgcn_readfirstlane((unsigned)(v >> 32)); return (const char*)(((unsigned long long)hi << 32) | lo); }
__device__ __forceinline__ f32x4 ld4bf(const bf16_t* p) { const u32x2 w = *(const u32x2*)p; return (f32x4){bflo(w.x), bfhi(w.x), bflo(w.y), bfhi(w.y)}; }
#define EPI_FOR4 _Pragma("unroll") for (int bj = 0; bj < 2; ++bj) _Pragma("unroll") for (int n = 0; n < 2; ++n)
#define EPI_ROWS _Pragma("unroll") for (int ai = 0; ai < 2; ++ai) _Pragma("unroll") for (int m = 0; m < 4; ++m)
struct EpiLnOut {
    static constexpr bool PERM = false;
    const bf16_t* X1; const float* gmod; const float* lg; const float* lb; float* OUT; PanelStats st;
    __device__ __forceinline__ void operator()(f32x4 (&acc)[2][2][4][2], const Unit& u, int wr, int wc, int fr, int fq) const {
        const int b = (u.pm * BM) >> 11; const unsigned loff = (unsigned)(fr * DM + 4 * fq), coff = 4 * fq;
        const size_t ub = (size_t)(u.pm * BM + wr * 64) * DM + u.pn * BM + wc * 32; const int cb = u.pn * BM + wc * 32;
        const float* gm = gmod + (size_t)b * 6144 + cb;
        EPI_FOR4 { const f32x4 gv = *(const f32x4*)(gm + (bj * HALF + n * 16) + coff);
            EPI_ROWS { const f32x4 xv = ld4bf(X1 + (ub + (size_t)((ai * HALF + m * 16) * DM + bj * HALF + n * 16)) + loff);
                acc[ai][bj][m][n] = xv * ALPHA + gv * acc[ai][bj][m][n]; }
            asm volatile("" ::: "memory"); __builtin_amdgcn_sched_barrier(0); }
        st.run(acc, u, wr, wc, fr, fq);
        const LAS f32x2* S = (const LAS f32x2*)(st.scr + 8192) + (wr * 64 + fr);
        EPI_FOR4 { const f32x4 g4 = *(const f32x4*)(lg + (cb + bj * HALF + n * 16) + coff), b4 = *(const f32x4*)(lb + (cb + bj * HALF + n * 16) + coff);
            EPI_ROWS { const f32x2 sr = S[ai * HALF + m * 16];
                __builtin_nontemporal_store((f32x4)((acc[ai][bj][m][n] - sr.x) * sr.y * g4 + b4), (f32x4*)(OUT + (ub + (size_t)((ai * HALF + m * 16) * DM + bj * HALF + n * 16)) + loff)); }
            asm volatile("" ::: "memory"); __builtin_amdgcn_sched_barrier(0); }
    }
};
struct EpiLnMid {
    static constexpr bool PERM = false;
    const float* X; const float* lg; const float* lb; unsigned char* wsb; bf16_t* H2; LAS unsigned char* scr;
    __device__ __forceinline__ void operator()(f32x4 (&acc)[2][2][4][2], const Unit& u, int wr, int wc, int fr, int fq) const {
        const int b = (u.pm * BM) >> 11; const unsigned loff = (unsigned)(fr * DM + 4 * fq), coff = 4 * fq;
        const size_t ub = (size_t)(u.pm * BM + wr * 64) * DM + u.pn * BM + wc * 32; const int cb = u.pn * BM + wc * 32;
        const float* modb = (const float*)(wsb + WS_MOD) + (size_t)b * 6144 + cb; bf16_t* X1 = (bf16_t*)(wsb + WS_X1);
        const PanelStats st1{(unsigned long long*)(wsb + WS_XB1), (unsigned*)(wsb + WS_CNT), scr}, st2{(unsigned long long*)(wsb + WS_XB2), (unsigned*)(wsb + WS_CNT + 32768), scr};
        EPI_FOR4 { const f32x4 gv = *(const f32x4*)(modb + (2048 + bj * HALF + n * 16) + coff);
            EPI_ROWS { const f32x4 xv = *(const f32x4*)(X + (ub + (size_t)((ai * HALF + m * 16) * DM + bj * HALF + n * 16)) + loff);
                acc[ai][bj][m][n] = xv * ALPHA + gv * acc[ai][bj][m][n]; if (m & 1) asm volatile("" ::: "memory"); __builtin_amdgcn_sched_barrier(0); }
            asm volatile("" ::: "memory"); __builtin_amdgcn_sched_barrier(0); }
        st1.run(acc, u, wr, wc, fr, fq);
        { const LAS f32x2* S = (const LAS f32x2*)(st1.scr + 8192) + (wr * 64 + fr);
        EPI_FOR4 { const f32x4 g4 = *(const f32x4*)(lg + (cb + bj * HALF + n * 16) + coff), b4 = *(const f32x4*)(lb + (cb + bj * HALF + n * 16) + coff);
            EPI_ROWS { const f32x2 sr = S[ai * HALF + m * 16];
                const f32x4 o = (acc[ai][bj][m][n] - sr.x) * sr.y * g4 + b4; acc[ai][bj][m][n] = o;
                u32x2 w; w.x = pk2(o[0], o[1]); w.y = pk2(o[2], o[3]);
                *(u32x2*)(X1 + (ub + (size_t)((ai * HALF + m * 16) * DM + bj * HALF + n * 16)) + loff) = w; }
            asm volatile("" ::: "memory"); __builtin_amdgcn_sched_barrier(0); } }
        st2.run(acc, u, wr, wc, fr, fq);
        { const LAS f32x2* S = (const LAS f32x2*)(st2.scr + 8192) + (wr * 64 + fr);
        EPI_FOR4 { const f32x4 sh = *(const f32x4*)(modb + (3072 + bj * HALF + n * 16) + coff), sc = *(const f32x4*)(modb + (4096 + bj * HALF + n * 16) + coff) + 1.0f;
            EPI_ROWS { const f32x2 sr = S[ai * HALF + m * 16];
                const f32x4 o = (acc[ai][bj][m][n] - sr.x) * sr.y * sc + sh;
                u32x2 w; w.x = pk2(o[0], o[1]); w.y = pk2(o[2], o[3]);
                *(u32x2*)(H2 + (ub + (size_t)((ai * HALF + m * 16) * DM + bj * HALF + n * 16)) + loff) = w; }
            asm volatile("" ::: "memory"); __builtin_amdgcn_sched_barrier(0); } }
    }
};
#undef EPI_FOR4
#undef EPI_ROWS
}

__device__ __forceinline__ void tr_item(const float* __restrict__ src, int ld, int k0, int c0, bf16_t* dst, int dstK, int r0, LAS float* scr, int lane) {
    f32x4 t[8];
#pragma unroll
    for (int i = 0; i < 8; ++i) t[i] = *(const f32x4*)(src + (size_t)(k0 + 8 * i + (lane >> 3)) * ld + c0 + 4 * (lane & 7));
#pragma unroll
    for (int i = 0; i < 8; ++i) { LAS float* d = scr + (8 * i + (lane >> 3)) * 33 + 4 * (lane & 7); d[0] = t[i][0]; d[1] = t[i][1]; d[2] = t[i][2]; d[3] = t[i][3]; }
    LDS_WAIT();
    const int c = lane & 7;
#pragma unroll
    for (int j = 0; j < 4; ++j) { const int n = (lane >> 3) + 8 * j; const LAS float* s = scr + (8 * c) * 33 + n;
        u32x4 o; o.x = pk2(s[0 * 33], s[1 * 33]); o.y = pk2(s[2 * 33], s[3 * 33]); o.z = pk2(s[4 * 33], s[5 * 33]); o.w = pk2(s[6 * 33], s[7 * 33]);
        *(u32x4*)(dst + (size_t)(r0 + n) * dstK + k0 + 8 * c) = o; }
    LDS_WAIT();
}

__device__ __forceinline__ void split_arrive(unsigned* ctr);
__device__ __forceinline__ void split_wait(unsigned* ctr, unsigned want);
__device__ __forceinline__ void p0_prologue(LAS unsigned char* lds, const float* const* in, unsigned char* ws, unsigned* ctr) {
    const int tid = threadIdx.x, lane = tid & 63, wave = __builtin_amdgcn_readfirstlane(tid >> 6);
    const int G = gridDim.x;
    {
        const float* c = in[1]; const float* w_ada = in[2]; const float* b_ada = in[3]; float* MOD = (float*)(ws + WS_MOD);
        LAS float* sc = (LAS float*)lds; LAS float* red = (LAS float*)(lds + 65536);
        if ((int)blockIdx.x < 192) {
            for (int idx = tid; idx < 16384; idx += 512) { const int b = idx & 15, k = idx >> 4; const float v = c[b * 1024 + k]; sc[k * 16 + b] = v / (1.0f + expf(-v)); }
            __syncthreads();
            for (int item = blockIdx.x; item < 192; item += G) {
                const int e = item * 32 + (lane & 31), kbase = wave * 128 + (lane >> 5) * 64;
                float acc[16];
#pragma unroll
                for (int b = 0; b < 16; ++b) acc[b] = 0.f;
                for (int kk0 = 0; kk0 < 64; kk0 += 16) {
                    float wv[16];
#pragma unroll
                    for (int i = 0; i < 16; ++i) wv[i] = w_ada[(size_t)(kbase + kk0 + i) * 6144 + e];
#pragma unroll
                    for (int i = 0; i < 16; ++i) { const int k = kbase + kk0 + i; const float w = wv[i];
                        const LAS f32x4* s = (const LAS f32x4*)(sc + k * 16);
#pragma unroll
                        for (int q = 0; q < 4; ++q) { const f32x4 sv = s[q]; acc[4 * q + 0] += sv[0] * w; acc[4 * q + 1] += sv[1] * w; acc[4 * q + 2] += sv[2] * w; acc[4 * q + 3] += sv[3] * w; } } }
#pragma unroll
                for (int b = 0; b < 16; ++b) { acc[b] += __shfl_xor(acc[b], 32); if (lane < 32) red[(wave * 16 + b) * 32 + lane] = acc[b]; }
                __syncthreads();
                { const int b = tid >> 5, col = tid & 31; float s = 0.f;
#pragma unroll
                  for (int w = 0; w < 8; ++w) s += red[(w * 16 + b) * 32 + col];
                  MOD[b * 6144 + item * 32 + col] = s + b_ada[item * 32 + col]; }
                __syncthreads();
            }
        }
        __syncthreads();
    }
    {
        const float* w_in = in[4]; const float* b_in = in[5]; float* WG = (float*)(ws + WS_WG); float* BG = (float*)(ws + WS_BG);
        for (int idx = blockIdx.x * 512 + tid; idx < 16384; idx += G * 512) { const int j = idx >> 10, k = idx & 1023;
            const int col = j < 8 ? 1536 + j : (j < 12 ? 3592 + (j - 8) : 3596 + (j - 12));
            WG[idx] = w_in[(size_t)k * DIN + col]; if (k == 0) BG[j] = b_in[col]; }
    }
    split_arrive(ctr);
    {
        LAS float* scr = (LAS float*)(lds + wave * 16384);
        const int gw = blockIdx.x * 8 + wave, NGW = G * 8;
        constexpr int NITEMS = 3328 + 128 + 256 + 512 + 512 + 2816 + 1408;
        for (int it = gw; it < NITEMS; it += NGW) {
            int r = it; const float* src; int ld, k0, c0, dstK, r0; bf16_t* dst;
            if (r < 3328) { const int kb = r / 208, nb = r % 208, n0 = nb * 32; src = in[4]; ld = DIN; k0 = kb * 64; c0 = n0 + (n0 >= 1536 ? 8 : 0) + (n0 >= 3584 ? 8 : 0); dst = (bf16_t*)(ws + WS_WT_IN); dstK = 1024; r0 = n0; }
            else if ((r -= 3328) < 128) { const int sj = r >> 4, q = r & 15, h = sj >> 1, which = sj & 1, kb = q >> 2, nb = q & 3; src = (which ? in[9] : in[8]) + (size_t)h * 256 * 128; ld = 128; k0 = kb * 64; c0 = nb * 32; dst = (bf16_t*)(ws + WS_WT_QK); dstK = 256; r0 = h * 256 + which * 128 + nb * 32; }
            else if ((r -= 128) < 256) { const int kb = r >> 5, nb = r & 31; src = in[11]; ld = 1024; k0 = kb * 64; c0 = nb * 32; dst = (bf16_t*)(ws + WS_WT_PA); dstK = 512; r0 = nb * 32; }
            else if ((r -= 256) < 512) { const int kb = r >> 5, nb = r & 31; src = in[12]; ld = 1024; k0 = kb * 64; c0 = nb * 32; dst = (bf16_t*)(ws + WS_WT_PB); dstK = 1024; r0 = nb * 32; }
            else if ((r -= 512) < 512) { const int kb = r >> 5, nb = r & 31; src = in[13]; ld = 1024; k0 = kb * 64; c0 = nb * 32; dst = (bf16_t*)(ws + WS_WT_OUT); dstK = 1024; r0 = nb * 32; }
            else if ((r -= 512) < 2816) { const int kb = r / 176, nb = r % 176, n0 = nb * 32, pn = n0 >> 8, hh = (n0 & 255) >> 7, j = n0 & 127; src = in[16]; ld = 2 * DFF; k0 = kb * 64; c0 = hh * DFF + 128 * pn + j; dst = (bf16_t*)(ws + WS_WT_FI); dstK = 1024; r0 = n0; }
            else { r -= 2816; const int kb = r >> 5, nb = r & 31; src = in[17]; ld = 1024; k0 = kb * 64; c0 = nb * 32; dst = (bf16_t*)(ws + WS_WT_FD); dstK = DFF; r0 = nb * 32; }
            tr_item(src, ld, k0, c0, dst, dstK, r0, scr, lane);
        }
    }
    split_wait(ctr, gridDim.x);
}

__device__ __forceinline__ void p1_ln_gates(LAS unsigned char* lds, const float* x, const float* MOD, const float* WG, const float* BG, bf16_t* H1, float* G16) {
    const int tid = threadIdx.x, lane = tid & 63, wave = __builtin_amdgcn_readfirstlane(tid >> 6);
    LAS f32x4* WGl = (LAS f32x4*)lds;
    for (int idx = tid; idx < 4096; idx += 512) WGl[idx] = ((const f32x4*)WG)[idx];
    __syncthreads();
    for (int rp = blockIdx.x * 8 + wave; rp < MT / 2; rp += gridDim.x * 8) {
        const int r0 = 2 * rp, b = r0 >> 11;
        f32x4 v[2][4], shv[4], scv[4];
#pragma unroll
        for (int r = 0; r < 2; ++r)
#pragma unroll
            for (int j = 0; j < 4; ++j) v[r][j] = __builtin_nontemporal_load((const f32x4*)(x + (size_t)(r0 + r) * DM + 4 * lane + 256 * j));
#pragma unroll
        for (int j = 0; j < 4; ++j) { shv[j] = *(const f32x4*)(MOD + (size_t)b * 6144 + 4 * lane + 256 * j); scv[j] = *(const f32x4*)(MOD + (size_t)b * 6144 + 1024 + 4 * lane + 256 * j) + 1.0f; }
        asm volatile("" ::: "memory");
#pragma unroll
        for (int r = 0; r < 2; ++r) {
            float s = 0.f;
#pragma unroll
            for (int j = 0; j < 4; ++j) s += (v[r][j][0] + v[r][j][1]) + (v[r][j][2] + v[r][j][3]);
            const float mean = wave_sum(s) * (1.f / DM); float s2 = 0.f;
#pragma unroll
            for (int j = 0; j < 4; ++j) { v[r][j] = v[r][j] - mean; s2 += (v[r][j][0] * v[r][j][0] + v[r][j][1] * v[r][j][1]) + (v[r][j][2] * v[r][j][2] + v[r][j][3] * v[r][j][3]); }
            const float rstd = 1.f / sqrtf(wave_sum(s2) * (1.f / DM) + LN_EPS);
#pragma unroll
            for (int j = 0; j < 4; ++j) {
                v[r][j] = v[r][j] * rstd * scv[j] + shv[j];
                u32x2 o; o.x = pk2(v[r][j][0], v[r][j][1]); o.y = pk2(v[r][j][2], v[r][j][3]);
                *(u32x2*)(H1 + (size_t)(r0 + r) * DM + 4 * lane + 256 * j) = o; }
        }
        float vals[32];
#pragma unroll
        for (int j16 = 0; j16 < 16; ++j16) { float p0 = 0.f, p1 = 0.f;
#pragma unroll
            for (int q = 0; q < 4; ++q) { const f32x4 w = WGl[j16 * 256 + lane + 64 * q];
                p0 += (v[0][q][0] * w[0] + v[0][q][1] * w[1]) + (v[0][q][2] * w[2] + v[0][q][3] * w[3]);
                p1 += (v[1][q][0] * w[0] + v[1][q][1] * w[1]) + (v[1][q][2] * w[2] + v[1][q][3] * w[3]); }
            vals[j16] = p0; vals[16 + j16] = p1; asm volatile("" ::: "memory"); }
#define BFLY(N, MASK) { const bool up = (lane & MASK) != 0; _Pragma("unroll") for (int i = 0; i < N; ++i) { const float lo = vals[i], hi = vals[i + N]; const float send = up ? lo : hi, keep = up ? hi : lo; vals[i] = keep + __shfl_xor(send, MASK); } }
        BFLY(16, 32) BFLY(8, 16) BFLY(4, 8) BFLY(2, 4) BFLY(1, 2)
#undef BFLY
        const float tot = vals[0] + __shfl_xor(vals[0], 1);
        const int idx = lane >> 1;
        if (!(lane & 1)) G16[(size_t)(r0 + (idx >> 4)) * 16 + (idx & 15)] = tot + BG[idx & 15];
    }
}

__device__ __forceinline__ void fscan(LAS unsigned char* lds, const float* G16, float* FCUM) {
    const int tid = threadIdx.x, lane = tid & 63, wave = __builtin_amdgcn_readfirstlane(tid >> 6);
    LAS float* wsum = (LAS float*)lds;
    for (int s = blockIdx.x; s < 128; s += gridDim.x) {
        const int b = s >> 3, hh = s & 7;
        float v[4];
#pragma unroll
        for (int i = 0; i < 4; ++i) v[i] = logsig(G16[(size_t)(b * SEQ + 4 * tid + i) * 16 + hh]) * LOG2E;
        v[1] += v[0]; v[2] += v[1]; v[3] += v[2];
        const float tot = v[3]; float sc = tot;
#pragma unroll
        for (int o = 1; o < 64; o <<= 1) { const float y = __shfl_up(sc, o); if (lane >= o) sc += y; }
        if (lane == 63) wsum[wave] = sc;
        __syncthreads();
        float off = 0.f;
        for (int w = 0; w < wave; ++w) off += wsum[w];
        const float excl = off + sc - tot;
#pragma unroll
        for (int i = 0; i < 4; ++i) FCUM[(size_t)s * SEQ + 4 * tid + i] = v[i] + excl;
        __syncthreads();
    }
}

__device__ __forceinline__ void conv_phase(const bf16_t* PROJ, const float* conv_w, const float* conv_b, bf16_t* U) {
    const int tid = threadIdx.x, lane = tid & 63, wave = __builtin_amdgcn_readfirstlane(tid >> 6);
    const int gw = blockIdx.x * 8 + wave, NGW = gridDim.x * 8;
    for (int it = gw; it < 4096; it += NGW) {
        const int rg = it >> 1, chf = it & 1, m0 = rg * 16, c = chf * 512 + lane * 8;
        float w[4][8], cb[8];
#pragma unroll
        for (int j = 0; j < 4; ++j) { const f32x4 a = *(const f32x4*)(conv_w + j * 1024 + c), bq = *(const f32x4*)(conv_w + j * 1024 + c + 4);
            w[j][0] = a[0]; w[j][1] = a[1]; w[j][2] = a[2]; w[j][3] = a[3]; w[j][4] = bq[0]; w[j][5] = bq[1]; w[j][6] = bq[2]; w[j][7] = bq[3]; }
        { const f32x4 a = *(const f32x4*)(conv_b + c), bq = *(const f32x4*)(conv_b + c + 4); cb[0] = a[0]; cb[1] = a[1]; cb[2] = a[2]; cb[3] = a[3]; cb[4] = bq[0]; cb[5] = bq[1]; cb[6] = bq[2]; cb[7] = bq[3]; }
        const bool has_prev = (m0 & (SEQ - 1)) != 0;
        u32x4 raw[19];
#pragma unroll
        for (int j = 0; j < 3; ++j) { raw[j] = (u32x4){0u, 0u, 0u, 0u}; if (has_prev) raw[j] = __builtin_nontemporal_load((const u32x4*)(PROJ + (size_t)(m0 - 3 + j) * NP + C_MU + c)); }
#pragma unroll
        for (int r = 0; r < 16; ++r) raw[3 + r] = __builtin_nontemporal_load((const u32x4*)(PROJ + (size_t)(m0 + r) * NP + C_MU + c));
#pragma unroll
        for (int r = 0; r < 16; ++r) {
            float x0[8], x1[8], x2[8], x3[8]; unpack8(raw[r], x0); unpack8(raw[r + 1], x1); unpack8(raw[r + 2], x2); unpack8(raw[r + 3], x3);
            float y[8];
#pragma unroll
            for (int e = 0; e < 8; ++e) { const float t = w[0][e] * x0[e] + w[1][e] * x1[e] + w[2][e] * x2[e] + w[3][e] * x3[e] + cb[e]; y[e] = t * sigmoidf_(t); }
            *(u32x4*)(U + (size_t)(m0 + r) * DM + c) = pack8(y);
        }
    }
}


namespace fox_attn {
using bf16=__hip_bfloat16;
using bf16x8=__attribute__((ext_vector_type(8)))short;
using s16x4=__attribute__((ext_vector_type(4)))short;
using f32x16=__attribute__((ext_vector_type(16)))float;
using u32x4=__attribute__((ext_vector_type(4)))unsigned;
using f32x4v=__attribute__((ext_vector_type(4)))float;
constexpr int BATCH=16,NHEAD=8,SEQ=2048,D=64,DM=6656,OP=512;
constexpr int NW=8,QBLK=32,QB=QBLK*NW,KVBLK=64,NQB=SEQ/QB;
constexpr int ATTN_UNIT_ROWS=QB;
__device__ __forceinline__ int crow(int r,int hi){return (r&3)+8*(r>>2)+4*hi;}
#define SBAR() __builtin_amdgcn_sched_barrier(0)
__device__ __forceinline__ void cmask(f32x16&p0,f32x16&p1,int jb,int qrel,int hi){
  const float NEG=-INFINITY; int kb=64*jb+4*hi;
  #pragma unroll
  for(int r=0;r<16;++r){int kv=kb+(r&3)+8*(r>>2); if(kv>qrel)p0[r]=NEG; if(kv+32>qrel)p1[r]=NEG;}
}

constexpr int NSLOT=3, SLOTB=8192;
constexpr int LDS_K=0, LDS_V=NSLOT*SLOTB, LDS_WS=2*NSLOT*SLOTB, LDS_OST=LDS_WS+NW*64*4, LDS_BYTES=LDS_OST+NW*4096;
constexpr float C2=0.125f*1.4426950408889634f;
__device__ __forceinline__ void glds16(const void*gsrc,unsigned lds_dst){unsigned keep;
  asm volatile("s_mov_b32 %0, m0\n\ts_mov_b32 m0, %2\n\ts_nop 0\n\tglobal_load_lds_dwordx4 %1, off\n\ts_mov_b32 m0, %0":"=&s"(keep):"v"(gsrc),"s"(lds_dst):"memory");}
__device__ __forceinline__ float max3f(float a,float b,float c){float r;asm("v_max3_f32 %0, %1, %2, %3":"=v"(r):"v"(a),"v"(b),"v"(c));return r;}
__device__ __forceinline__ float max2f(float a,float b){float r;asm("v_max_f32_e32 %0, %1, %2":"=v"(r):"v"(a),"v"(b));return r;}
__device__ __forceinline__ float fadd_s(float a,float b){float r;asm("v_add_f32_e32 %0, %1, %2":"=v"(r):"v"(a),"v"(b));return r;}
__device__ __forceinline__ float fsub_s(float a,float b){float r;asm("v_sub_f32_e32 %0, %1, %2":"=v"(r):"v"(a),"v"(b));return r;}
typedef float f32x2_t __attribute__((ext_vector_type(2))); typedef __bf16 bf16x2_t __attribute__((ext_vector_type(2)));
__device__ __forceinline__ unsigned cvtpk_s(float lo,float hi){f32x2_t v={lo,hi};bf16x2_t b=__builtin_convertvector(v,bf16x2_t);return __builtin_bit_cast(unsigned,b);}
#define WAIT_BAR(N) asm volatile("s_waitcnt vmcnt(" #N ") lgkmcnt(0)\n\ts_barrier":::"memory")

__device__ __forceinline__ void qkt(f32x16&p0,f32x16&p1,const char*Kslot,const bf16x8*qr,const f32x16&negm,int r32,int hi){
  const char*kb=Kslot+hi*1024+r32*16;
  #pragma unroll
  for(int d0=0;d0<4;++d0){
    const bf16x8 b0=*reinterpret_cast<const bf16x8*>(kb+d0*2048);
    const bf16x8 b1=*reinterpret_cast<const bf16x8*>(kb+d0*2048+512);
    if(d0==0){p0=__builtin_amdgcn_mfma_f32_32x32x16_bf16(b0,qr[0],negm,0,0,0);p1=__builtin_amdgcn_mfma_f32_32x32x16_bf16(b1,qr[0],negm,0,0,0);}
    else{p0=__builtin_amdgcn_mfma_f32_32x32x16_bf16(b0,qr[d0],p0,0,0,0);p1=__builtin_amdgcn_mfma_f32_32x32x16_bf16(b1,qr[d0],p1,0,0,0);}}
}
typedef __attribute__((address_space(3))) const char* lds_cptr;
typedef short v4i16_t __attribute__((ext_vector_type(4)));
__device__ __forceinline__ void kload8(bf16x8*kf,lds_cptr kp){
  kf[0]=*(const __attribute__((address_space(3))) bf16x8*)(kp);      kf[1]=*(const __attribute__((address_space(3))) bf16x8*)(kp+512);
  kf[2]=*(const __attribute__((address_space(3))) bf16x8*)(kp+2048); kf[3]=*(const __attribute__((address_space(3))) bf16x8*)(kp+2560);
  kf[4]=*(const __attribute__((address_space(3))) bf16x8*)(kp+4096); kf[5]=*(const __attribute__((address_space(3))) bf16x8*)(kp+4608);
  kf[6]=*(const __attribute__((address_space(3))) bf16x8*)(kp+6144); kf[7]=*(const __attribute__((address_space(3))) bf16x8*)(kp+6656);
}
__device__ __forceinline__ void kload2(bf16x8*kf,lds_cptr kp,int j){ kf[2*j]=*(const __attribute__((address_space(3))) bf16x8*)(kp+j*2048); kf[2*j+1]=*(const __attribute__((address_space(3))) bf16x8*)(kp+j*2048+512); }
__device__ __forceinline__ s16x4 vtr(lds_cptr p){ return __builtin_bit_cast(s16x4,__builtin_amdgcn_ds_read_tr16_b64_v4i16((__attribute__((address_space(3))) v4i16_t*)p)); }
__device__ __forceinline__ float rowmax(const f32x16&p0,const f32x16&p1){
  float a=max3f(p0[0],p0[1],p1[0]),b=max3f(p0[2],p0[3],p1[1]);a=max3f(a,p1[2],p1[3]);
  #pragma unroll
  for(int r=4;r<16;r+=4){a=max3f(a,p0[r],p0[r+1]);b=max3f(b,p0[r+2],p0[r+3]);a=max3f(a,p1[r],p1[r+1]);b=max3f(b,p1[r+2],p1[r+3]);}
  const float m=max2f(a,b);
  auto rr=__builtin_amdgcn_permlane32_swap(__float_as_uint(m),__float_as_uint(m),false,false);
  return max2f(__uint_as_float(rr[0]),__uint_as_float(rr[1]));
}
__device__ __forceinline__ void pv(f32x16*o,int vb,bf16x8 pa0,bf16x8 pa1,bf16x8 pa2,bf16x8 pa3){
  #pragma unroll
  for(int d0=0;d0<2;++d0){s16x4 lo[4],hi[4];
    #pragma unroll
    for(int ks=0;ks<4;++ks){
      asm volatile("ds_read_b64_tr_b16 %0,%1 offset:%c2":"=&v"(lo[ks]):"v"(vb),"i"(d0*4096+ks*1024):"memory");
      asm volatile("ds_read_b64_tr_b16 %0,%1 offset:%c2":"=&v"(hi[ks]):"v"(vb),"i"(d0*4096+ks*1024+512):"memory");}
    asm volatile("s_waitcnt lgkmcnt(0)":::"memory");SBAR();
    #define PK(k) (bf16x8){lo[k][0],lo[k][1],lo[k][2],lo[k][3],hi[k][0],hi[k][1],hi[k][2],hi[k][3]}
    o[d0]=__builtin_amdgcn_mfma_f32_32x32x16_bf16(pa0,PK(0),o[d0],0,0,0);
    o[d0]=__builtin_amdgcn_mfma_f32_32x32x16_bf16(pa1,PK(1),o[d0],0,0,0);
    o[d0]=__builtin_amdgcn_mfma_f32_32x32x16_bf16(pa2,PK(2),o[d0],0,0,0);
    o[d0]=__builtin_amdgcn_mfma_f32_32x32x16_bf16(pa3,PK(3),o[d0],0,0,0);
    #undef PK
  }
}

#ifndef ATTN_STORE16
#define ATTN_STORE16(p,v) (*(u32x4*)(p)=(v))
#endif
template<int THRL> __device__ __forceinline__ void attn_unit(int b,int h,int qb,const bf16*Q,const bf16*__restrict__ K,const bf16*__restrict__ V,bf16*O,const float*__restrict__ Frow,char*shm){
  int tid_=threadIdx.x; asm volatile("":"+v"(tid_));
  const int tid=tid_,lane=tid&63,r32=lane&31,hi=lane>>5; const int wid=__builtin_amdgcn_readfirstlane(tid>>6);
  const long rowbase=(long)b*SEQ; const int q0=qb*QB;
  const bf16*Qw=Q+(rowbase+q0+wid*QBLK)*DM+h*D;
  const bf16*Kh=K+rowbase*DM+h*D,*Vh=V+rowbase*DM+h*D;
  const unsigned lds0=(unsigned)(uintptr_t)shm;
  float*wsf=(float*)(shm+LDS_WS)+wid*64;
  const bf16*ksrc=Kh+(long)lane*DM+wid*8;
  const bf16*vsrc=Vh+(long)(16*(wid&3)+(lane>>2))*DM+(wid>>2)*32+(lane&3)*8;
  const unsigned kdst=lds0+LDS_K+wid*1024, vdst=lds0+LDS_V+wid*1024;
  #define DMA_K(t,slot) glds16(ksrc+(long)(t)*KVBLK*DM,(unsigned)__builtin_amdgcn_readfirstlane(kdst+(slot)))
  #define DMA_V(t,slot) glds16(vsrc+(long)(t)*KVBLK*DM,(unsigned)__builtin_amdgcn_readfirstlane(vdst+(slot)))
  const int vb0=(int)(lds0+LDS_V)+((lane>>4)&1)*32+(lane&3)*8+(4*hi+((lane&15)>>2))*64;
  const char*Kbase=shm+LDS_K; bf16x8 kf[8];
  const lds_cptr shm3=(lds_cptr)shm; const lds_cptr kp0=shm3+LDS_K+hi*1024+r32*16; const lds_cptr vp0=shm3+LDS_V+((lane>>4)&1)*32+(lane&3)*8+(4*hi+((lane&15)>>2))*64;
  const int NT=(q0+QB)/KVBLK;
  float*nfk=(float*)(shm+LDS_BYTES);
  for(int i=tid;i<NT*KVBLK;i+=512)nfk[i]=-Frow[i];
  asm volatile("s_waitcnt vmcnt(0) lgkmcnt(0)\n\ts_barrier":::"memory");
  #define BIAS(P0,P1,t) do{ const float*nb_=nfk+(t)*KVBLK+4*hi; const float mh_=mhat; _Pragma("unroll") for(int r_=0;r_<16;++r_){ P0[r_]+=nb_[(r_&3)+8*(r_>>2)]-mh_; } \
      _Pragma("unroll") for(int r_=0;r_<16;++r_){ P1[r_]+=nb_[(r_&3)+8*(r_>>2)+32]-mh_; } }while(0)
  DMA_K(0,0);DMA_V(0,0);DMA_K(1,SLOTB);
  bf16x8 qr[4];
  #pragma unroll
  for(int d0=0;d0<4;++d0){ const u32x4 qw_=*reinterpret_cast<const u32x4*>(&Qw[(long)r32*DM+d0*16+hi*8]); u32x4 qs_;
    #define QSC(w) cvtpk_s(__uint_as_float((w)<<16)*C2,__uint_as_float((w)&0xffff0000u)*C2)
    qs_.x=QSC(qw_.x);qs_.y=QSC(qw_.y);qs_.z=QSC(qw_.z);qs_.w=QSC(qw_.w);
    #undef QSC
    qr[d0]=__builtin_bit_cast(bf16x8,qs_); }
  float mhat=0.f,l_reg=0.f;f32x16 o[2];o[0]=f32x16{};o[1]=f32x16{};const f32x16 negm=f32x16{};
  const int qrel=wid*QBLK+r32;
  #define CMASK(P0,P1,t) do{int jb_=(t)-(NT-4); if(jb_>=0)cmask(P0,P1,jb_,qrel,hi);}while(0)
  bool resc=false;
  #define START(P0,P1) do{ const float rm=rowmax(P0,P1); resc=false; \
    { const float dl=rm; mhat=fadd_s(mhat,dl); \
      _Pragma("unroll") for(int r=0;r<16;++r){P0[r]=fsub_s(P0[r],dl);P1[r]=fsub_s(P1[r],dl);} \
        } \
    _Pragma("unroll") for(int r=0;r<16;++r)P0[r]=__builtin_amdgcn_exp2f(P0[r]); }while(0)
  #define RESC() do{ if(resc){ asm volatile("s_waitcnt lgkmcnt(0)":::"memory"); \
      _Pragma("unroll") for(int d_=0;d_<2;++d_) _Pragma("unroll") for(int r=0;r<16;++r)o[d_][r]*=wsf[crow(r,hi)]; } }while(0)
  f32x16 pA0,pA1,pB0,pB1;
  int sl_prev=0,sl_cur=0,sl_next=SLOTB;
  #define ROT() do{sl_prev=sl_cur;sl_cur=sl_next;sl_next=(sl_next==(NSLOT-1)*SLOTB)?0:sl_next+SLOTB;}while(0)
  DMA_K(2,2*SLOTB);
  WAIT_BAR(3);
  qkt(pA0,pA1,Kbase,qr,negm,r32,hi);asm volatile("s_nop 15\n\ts_nop 7":"+v"(pA0),"+v"(pA1));BIAS(pA0,pA1,0);CMASK(pA0,pA1,0);
  START(pA0,pA1);
  _Pragma("unroll") for(int r=0;r<16;++r)pA1[r]=__builtin_amdgcn_exp2f(pA1[r]);
  WAIT_BAR(0);
  DMA_K(3,0);DMA_V(1,SLOTB);
  ROT();
  kload8(kf,kp0+sl_cur);
  WAIT_BAR(2);
  s16x4 vlo[8],vhi[8]; u32x4 pw0,pw1,pw2,pw3;
  #define PKW(P,B) cvtpk_s(P[B],P[B+1])
  #define PAF(k) __builtin_bit_cast(bf16x8,pw##k)
  #define VFR(i) (bf16x8){vlo[i][0],vlo[i][1],vlo[i][2],vlo[i][3],vhi[i][0],vhi[i][1],vhi[i][2],vhi[i][3]}
  #define PIN(x) asm volatile("":"+v"(x))
  #define MX3(a,b,c) __builtin_fmaxf(__builtin_fmaxf((a),(b)),(c))
  #define GAPA(MF,A0,A1,A2,A3,W0,W1,PW) do{ MF; sacc+=A0; sacc+=A1; sacc+=A2; sacc+=A3; PIN(sacc); W0; W1; PIN(PW); SBAR(); }while(0)
  #define EX(v) __builtin_amdgcn_exp2f(v)
  #define GAPB(MF,X,B) do{ MF; X[B]=EX(X[B]); X[B+1]=EX(X[B+1]); X[B+2]=EX(X[B+2]); X[B+3]=EX(X[B+3]); PIN(X); SBAR(); }while(0)
  #define VRD(i) do{ vlo[i]=vtr(vp_+(((i)>>2)*4096+((i)&3)*1024)); vhi[i]=vtr(vp_+(((i)>>2)*4096+((i)&3)*1024+512)); }while(0)
  #define KRD(G,j) do{ if(G){ kload2(kf,kp0+sl_next,j); SBAR(); } }while(0)
  #define STEP(C0,C1,P0,P1,t,GK,GV,GL) do{ SBAR(); \
    const lds_cptr vp_=vp0+sl_prev; \
    VRD(0); SBAR(); float sacc=(P0[0]+P0[1]); \
    GAPA(C0=__builtin_amdgcn_mfma_f32_32x32x16_bf16(kf[0],qr[0],negm,0,0,0), P0[2],P0[3],P0[4],P0[5],     pw0[0]=PKW(P0,0), pw0[1]=PKW(P0,2), pw0); \
    VRD(4); SBAR(); GAPA(C1=__builtin_amdgcn_mfma_f32_32x32x16_bf16(kf[1],qr[0],negm,0,0,0), P0[6],P0[7],P0[8],P0[9],     pw0[2]=PKW(P0,4), pw0[3]=PKW(P0,6), pw0); \
    VRD(1); SBAR(); GAPA(C0=__builtin_amdgcn_mfma_f32_32x32x16_bf16(kf[2],qr[1],C0,0,0,0),   P0[10],P0[11],P0[12],P0[13], pw1[0]=PKW(P0,8), pw1[1]=PKW(P0,10), pw1); \
    VRD(5); SBAR(); GAPA(C1=__builtin_amdgcn_mfma_f32_32x32x16_bf16(kf[3],qr[1],C1,0,0,0),   P0[14],P0[15],P1[0],P1[1],   pw1[2]=PKW(P0,12),pw1[3]=PKW(P0,14), pw1); \
    VRD(2); SBAR(); GAPA(C0=__builtin_amdgcn_mfma_f32_32x32x16_bf16(kf[4],qr[2],C0,0,0,0),   P1[2],P1[3],P1[4],P1[5],     pw2[0]=PKW(P1,0), pw2[1]=PKW(P1,2), pw2); \
    VRD(6); SBAR(); GAPA(C1=__builtin_amdgcn_mfma_f32_32x32x16_bf16(kf[5],qr[2],C1,0,0,0),   P1[6],P1[7],P1[8],P1[9],     pw2[2]=PKW(P1,4), pw2[3]=PKW(P1,6), pw2); \
    VRD(3); SBAR(); GAPA(C0=__builtin_amdgcn_mfma_f32_32x32x16_bf16(kf[6],qr[3],C0,0,0,0),   P1[10],P1[11],P1[12],P1[13], pw3[0]=PKW(P1,8), pw3[1]=PKW(P1,10), pw3); \
    VRD(7); SBAR(); GAPA(C1=__builtin_amdgcn_mfma_f32_32x32x16_bf16(kf[7],qr[3],C1,0,0,0),   P1[14],P1[15],0.f,0.f,       pw3[2]=PKW(P1,12),pw3[3]=PKW(P1,14), pw3); \
    l_reg+=sacc; \
    if(GK){DMA_K((t)+3,sl_cur);} if(GV){DMA_V((t)+1,sl_next);} \
    BIAS(C0,C1,t); CMASK(C0,C1,t); \
    { float a=MX3(C0[0],C0[1],C1[0]),b=MX3(C0[2],C0[3],C1[1]); a=MX3(a,C1[2],C1[3]); \
      _Pragma("unroll") for(int r=4;r<16;r+=4){a=MX3(a,C0[r],C0[r+1]);b=MX3(b,C0[r+2],C0[r+3]);a=MX3(a,C1[r],C1[r+1]);b=MX3(b,C1[r+2],C1[r+3]);} \
      float rm=__builtin_fmaxf(a,b); { auto rr=__builtin_amdgcn_permlane32_swap(__float_as_uint(rm),__float_as_uint(rm),false,false); rm=__builtin_fmaxf(__uint_as_float(rr[0]),__uint_as_float(rr[1])); } \
      resc=false; \
      if(__builtin_expect(__any(rm>(float)THRL),0)){ const float dl=__builtin_fmaxf(rm,0.f); mhat+=dl; \
        _Pragma("unroll") for(int r=0;r<16;++r){C0[r]-=dl;C1[r]-=dl;} \
          \
        const float f=__builtin_amdgcn_exp2f(-dl); l_reg*=f; if(hi==0)wsf[r32]=f; resc=true; } } \
    SBAR(); \
    GAPB(o[0]=__builtin_amdgcn_mfma_f32_32x32x16_bf16(PAF(0),VFR(0),o[0],0,0,0), C0,0); \
    GAPB(o[1]=__builtin_amdgcn_mfma_f32_32x32x16_bf16(PAF(0),VFR(4),o[1],0,0,0), C0,4); \
    KRD(GL,0); GAPB(o[0]=__builtin_amdgcn_mfma_f32_32x32x16_bf16(PAF(1),VFR(1),o[0],0,0,0), C0,8); \
    KRD(GL,1); GAPB(o[1]=__builtin_amdgcn_mfma_f32_32x32x16_bf16(PAF(1),VFR(5),o[1],0,0,0), C0,12); \
    KRD(GL,2); GAPB(o[0]=__builtin_amdgcn_mfma_f32_32x32x16_bf16(PAF(2),VFR(2),o[0],0,0,0), C1,0); \
    KRD(GL,3); GAPB(o[1]=__builtin_amdgcn_mfma_f32_32x32x16_bf16(PAF(2),VFR(6),o[1],0,0,0), C1,4); \
    GAPB(o[0]=__builtin_amdgcn_mfma_f32_32x32x16_bf16(PAF(3),VFR(3),o[0],0,0,0), C1,8); \
    GAPB(o[1]=__builtin_amdgcn_mfma_f32_32x32x16_bf16(PAF(3),VFR(7),o[1],0,0,0), C1,12); \
    }while(0)
  int t=1;
  #undef CMASK
  #define CMASK(P0,P1,t) do{}while(0)
  for(;t+5<NT;t+=2){
    STEP(pB0,pB1,pA0,pA1,t,true,true,true);     WAIT_BAR(2); RESC(); ROT();
    STEP(pA0,pA1,pB0,pB1,t+1,true,true,true);   WAIT_BAR(2); RESC(); ROT();
  }
  #undef CMASK
  #define CMASK(P0,P1,t) do{int jb_=(t)-(NT-4); if(jb_>=0)cmask(P0,P1,jb_,qrel,hi);}while(0)
  #define ENDW(tt) do{ if((tt)+3<NT){WAIT_BAR(2);} else if((tt)+2<NT){WAIT_BAR(1);} else {WAIT_BAR(0);} }while(0)
  for(;t+1<NT;t+=2){
    STEP(pB0,pB1,pA0,pA1,t,(t+3<NT),(t+1<NT),(t+1<NT));       ENDW(t);   RESC(); ROT();
    STEP(pA0,pA1,pB0,pB1,t+1,(t+4<NT),(t+2<NT),(t+2<NT));     ENDW(t+1); RESC(); ROT();
  }
  STEP(pB0,pB1,pA0,pA1,NT-1,false,false,false); RESC();
  { float sacc=pB0[0]+pB0[1]; _Pragma("unroll") for(int r=2;r<16;++r)sacc+=pB0[r]; _Pragma("unroll") for(int r=0;r<16;++r)sacc+=pB1[r]; l_reg+=sacc;
    pw0=(u32x4){PKW(pB0,0),PKW(pB0,2),PKW(pB0,4),PKW(pB0,6)};pw1=(u32x4){PKW(pB0,8),PKW(pB0,10),PKW(pB0,12),PKW(pB0,14)};pw2=(u32x4){PKW(pB1,0),PKW(pB1,2),PKW(pB1,4),PKW(pB1,6)};pw3=(u32x4){PKW(pB1,8),PKW(pB1,10),PKW(pB1,12),PKW(pB1,14)};
    SBAR(); pv(o,vb0+sl_cur,PAF(0),PAF(1),PAF(2),PAF(3)); }
  #undef PKW
  #undef PAF
  #undef VFR
  #undef PIN
  #undef MX3
  #undef GAPA
  #undef GAPB
  #undef EX
  #undef VRD
  #undef KRD
  #undef STEP
  #undef ENDW
  {auto rr=__builtin_amdgcn_permlane32_swap(__float_as_uint(l_reg),__float_as_uint(l_reg),false,false);l_reg=__uint_as_float(rr[0])+__uint_as_float(rr[1]);}
  if(hi==0)wsf[32+r32]=l_reg;asm volatile("s_waitcnt lgkmcnt(0)":::"memory");
  float rli[16];
  #pragma unroll
  for(int r=0;r<16;++r)rli[r]=__builtin_amdgcn_rcpf(wsf[32+crow(r,hi)]);
  bf16*Ow=O+(rowbase+q0+wid*QBLK)*OP+h*D;
  { bf16*stg=(bf16*)(shm+LDS_OST)+wid*2048;
    #pragma unroll
    for(int r=0;r<16;++r){const int orow=crow(r,hi);
      #pragma unroll
      for(int d0=0;d0<2;++d0)stg[orow*64+d0*32+r32]=__float2bfloat16(o[d0][r]*rli[r]);}
    asm volatile("s_waitcnt lgkmcnt(0)":::"memory");
    #pragma unroll
    for(int i=0;i<4;++i){const int row=i*8+(lane>>3),ch=lane&7; const u32x4 v=*(const u32x4*)(stg+row*64+ch*8); ATTN_STORE16(Ow+(long)row*OP+ch*8,v);} }
  asm volatile("s_waitcnt lgkmcnt(0)\n\ts_barrier":::"memory");
  #undef BIAS
  #undef DMA_K
  #undef DMA_V
  #undef CMASK
  #undef START
  #undef RESC
  #undef ROT
}
constexpr int ATTN_LDS_BYTES=LDS_BYTES+8192;
#undef SBAR
#undef WAIT_BAR
}

__device__ __forceinline__ void attn_phase_ref(char* shm, const bf16_t* PROJ, const float* FCUM, bf16_t* ATT) {
    const int vblk = (gridDim.x % 8 == 0) ? (int)((blockIdx.x & 7) * (gridDim.x >> 3) + (blockIdx.x >> 3)) : (int)blockIdx.x;
    for (int uid = vblk; uid < 1024; uid += gridDim.x) {
        const int round = uid >> 8, v = uid & 255, bh = v >> 1, par = v & 1, b = bh >> 3, hh = bh & 7;
        const int qb = par ? (round == 0 ? 1 : round == 1 ? 6 : round == 2 ? 3 : 4) : (round == 0 ? 0 : round == 1 ? 7 : round == 2 ? 2 : 5);
        fox_attn::attn_unit<8>(b, hh, qb, (const fox_attn::bf16*)(PROJ + C_FQ), (const fox_attn::bf16*)(PROJ + C_FK), (const fox_attn::bf16*)(PROJ + C_FV), (fox_attn::bf16*)ATT, FCUM + (size_t)bh * SEQ, shm);
    }
}

__device__ __forceinline__ float xmax16(float m) { auto r = __builtin_amdgcn_permlane16_swap(__float_as_uint(m), __float_as_uint(m), false, false); return fmaxf(__uint_as_float(r[0]), __uint_as_float(r[1])); }
__device__ __forceinline__ float xmax32(float m) { auto r = __builtin_amdgcn_permlane32_swap(__float_as_uint(m), __float_as_uint(m), false, false); return fmaxf(__uint_as_float(r[0]), __uint_as_float(r[1])); }
__device__ __forceinline__ float xadd16(float m) { auto r = __builtin_amdgcn_permlane16_swap(__float_as_uint(m), __float_as_uint(m), false, false); return __uint_as_float(r[0]) + __uint_as_float(r[1]); }
__device__ __forceinline__ float xadd32(float m) { auto r = __builtin_amdgcn_permlane32_swap(__float_as_uint(m), __float_as_uint(m), false, false); return __uint_as_float(r[0]) + __uint_as_float(r[1]); }
template <bool MASK> struct BoolC { static constexpr bool value = MASK; };
__device__ __forceinline__ void attn_phase(LAS unsigned char* lds, const bf16_t* PROJ, const float* FCUM, bf16_t* ATT) {
    const int tid = threadIdx.x, lane = tid & 63, wave = __builtin_amdgcn_readfirstlane(tid >> 6);
    const int g = lane >> 4, c16 = lane & 15, q4 = (lane & 15) >> 2, p4 = lane & 3;
    LAS unsigned char* Ks = lds;
    constexpr float C1 = 0.125f * LOG2E;
    const int lrow = tid >> 3, lch = tid & 7;
    const int vblk = (gridDim.x % 8 == 0) ? (int)((blockIdx.x & 7) * (gridDim.x >> 3) + (blockIdx.x >> 3)) : (int)blockIdx.x;
    for (int uid = vblk; uid < 1024; uid += gridDim.x) {
        const int round = uid >> 8, v = uid & 255, bh = v >> 1, par = v & 1, b = bh >> 3, hh = bh & 7;
        const int qb = par ? (round == 0 ? 1 : round == 1 ? 6 : round == 2 ? 3 : 4) : (round == 0 ? 0 : round == 1 ? 7 : round == 2 ? 2 : 5);
        const int q0 = qb * 256, NT = 4 * (qb + 1);
        const size_t rowbase = (size_t)b * SEQ;
        bf16x8 qf[2][2]; float mrun[2], lrun[2]; f32x4 acc[2][4];
#pragma unroll
        for (int qt = 0; qt < 2; ++qt) { const int qr = q0 + 32 * wave + 16 * qt + c16;
#pragma unroll
            for (int kd = 0; kd < 2; ++kd) qf[qt][kd] = *(const bf16x8*)(PROJ + (rowbase + qr) * NP + C_FQ + hh * 64 + 32 * kd + 8 * g);
            mrun[qt] = -1e30f; lrun[qt] = 0.f;
#pragma unroll
            for (int dt = 0; dt < 4; ++dt) acc[qt][dt] = (f32x4){0.f, 0.f, 0.f, 0.f}; }
        u32x4 kreg[2], vreg[2]; float freg[2];
#define ATT_LOAD(tt, S) do { const size_t r_ = rowbase + (size_t)(tt) * 64 + lrow; \
            kreg[S] = *(const u32x4*)(PROJ + r_ * NP + C_FK + hh * 64 + lch * 8); vreg[S] = *(const u32x4*)(PROJ + r_ * NP + C_FV + hh * 64 + lch * 8); \
            freg[S] = FCUM[(size_t)bh * SEQ + (tt) * 64 + (tid & 63)]; } while (0)
#define ATT_STORE(tt, S) do { LAS unsigned char* kb_ = Ks + ((tt) & 1) * 18688; \
            *(LAS u32x4*)(kb_ + lrow * 128 + ((lch ^ ((lrow >> 1) & 7)) * 16)) = kreg[S]; *(LAS u32x4*)(kb_ + 9216 + lrow * 144 + lch * 16) = vreg[S]; if (tid < 64) ((LAS float*)(kb_ + 18432))[tid] = -freg[S]; } while (0)
        ATT_LOAD(0, 0); ATT_LOAD(1, 1);
        LBAR();
        ATT_STORE(0, 0);
        LBAR();
        auto tile = [&](const int t, auto maskc) {
            constexpr bool MASK = decltype(maskc)::value;
            const LAS unsigned char* Kb = Ks + (t & 1) * 18688; const LAS unsigned char* Vb = Kb + 9216; const LAS float* fb = (const LAS float*)(Kb + 18432);
            if (!MASK || 64 * t <= q0 + 32 * wave + 31) {
                f32x4 s[4][2];
#pragma unroll
                for (int kt = 0; kt < 4; ++kt) {
#pragma unroll
                    for (int kd = 0; kd < 2; ++kd) { const bf16x8 kf = *(const LAS bf16x8*)(Kb + (16 * kt + c16) * 128 + (((4 * kd + g) ^ ((c16 >> 1) & 7)) * 16));
#pragma unroll
                        for (int qt = 0; qt < 2; ++qt) s[kt][qt] = __builtin_amdgcn_mfma_f32_16x16x32_bf16(kf, qf[qt][kd], kd == 0 ? (f32x4){0.f, 0.f, 0.f, 0.f} : s[kt][qt], 0, 0, 0); } }
#pragma unroll
                for (int kt = 0; kt < 4; ++kt) { const f32x4 nfk = *(const LAS f32x4*)(fb + 16 * kt + 4 * g);
#pragma unroll
                    for (int qt = 0; qt < 2; ++qt) { s[kt][qt] = s[kt][qt] * C1 + nfk;
                        if (MASK) {
#pragma unroll
                            for (int i = 0; i < 4; ++i) { const int kv = 64 * t + 16 * kt + 4 * g + i, qq = q0 + 32 * wave + 16 * qt + c16; if (kv > qq) s[kt][qt][i] = -1e30f; } } } }
                bf16x8 pf[2][2];
#pragma unroll
                for (int qt = 0; qt < 2; ++qt) {
                    float m0 = fmaxf(fmaxf(s[0][qt][0], s[0][qt][1]), fmaxf(s[0][qt][2], s[0][qt][3]));
#pragma unroll
                    for (int kt = 1; kt < 4; ++kt) { m0 = fmaxf(fmaxf(m0, s[kt][qt][0]), s[kt][qt][1]); m0 = fmaxf(fmaxf(m0, s[kt][qt][2]), s[kt][qt][3]); }
                    m0 = xmax32(xmax16(m0));
                    const float mnew = fmaxf(mrun[qt], m0), corr = __builtin_amdgcn_exp2f(mrun[qt] - mnew);
                    mrun[qt] = mnew;
#pragma unroll
                    for (int dt = 0; dt < 4; ++dt) acc[qt][dt] = acc[qt][dt] * corr;
                    f32x4 ps = (f32x4){0.f, 0.f, 0.f, 0.f};
#pragma unroll
                    for (int kt = 0; kt < 4; ++kt) { const f32x4 d = s[kt][qt] - mnew; f32x4 p;
                        p[0] = __builtin_amdgcn_exp2f(d[0]); p[1] = __builtin_amdgcn_exp2f(d[1]); p[2] = __builtin_amdgcn_exp2f(d[2]); p[3] = __builtin_amdgcn_exp2f(d[3]);
                        ps = ps + p; s[kt][qt] = p; }
                    lrun[qt] = lrun[qt] * corr + ((ps[0] + ps[1]) + (ps[2] + ps[3]));
#pragma unroll
                    for (int ks = 0; ks < 2; ++ks) { u32x4 w; w.x = pk2(s[2 * ks][qt][0], s[2 * ks][qt][1]); w.y = pk2(s[2 * ks][qt][2], s[2 * ks][qt][3]);
                        w.z = pk2(s[2 * ks + 1][qt][0], s[2 * ks + 1][qt][1]); w.w = pk2(s[2 * ks + 1][qt][2], s[2 * ks + 1][qt][3]); pf[qt][ks] = __builtin_bit_cast(bf16x8, w); }
                }
#pragma unroll
                for (int dt = 0; dt < 4; ++dt)
#pragma unroll
                    for (int ks = 0; ks < 2; ++ks) {
                        const s16x4 lo = vtr(Vb + (32 * ks + 4 * g + q4) * 144 + (16 * dt + 4 * p4) * 2), hi = vtr(Vb + (32 * ks + 16 + 4 * g + q4) * 144 + (16 * dt + 4 * p4) * 2);
                        const bf16x8 vf = (bf16x8){lo[0], lo[1], lo[2], lo[3], hi[0], hi[1], hi[2], hi[3]};
#pragma unroll
                        for (int qt = 0; qt < 2; ++qt) acc[qt][dt] = __builtin_amdgcn_mfma_f32_16x16x32_bf16(vf, pf[qt][ks], acc[qt][dt], 0, 0, 0);
                    }
            }
        };
        for (int t0 = 0; t0 < NT; t0 += 2) {
            const bool diag = (t0 >= NT - 4);
            ATT_LOAD(t0 + 2 < NT ? t0 + 2 : NT - 1, 0);
            if (diag) tile(t0, BoolC<true>{}); else tile(t0, BoolC<false>{});
            ATT_STORE(t0 + 1, 1); LBAR();
            ATT_LOAD(t0 + 3 < NT ? t0 + 3 : NT - 1, 1);
            if (diag) tile(t0 + 1, BoolC<true>{}); else tile(t0 + 1, BoolC<false>{});
            if (t0 + 2 < NT) ATT_STORE(t0 + 2, 0);
            LBAR();
        }
#undef ATT_LOAD
#undef ATT_STORE
#pragma unroll
        for (int qt = 0; qt < 2; ++qt) { float lt = xadd32(xadd16(lrun[qt])); const float inv = 1.0f / lt;
            const size_t qr = rowbase + q0 + 32 * wave + 16 * qt + c16;
#pragma unroll
            for (int dt = 0; dt < 4; ++dt) { const f32x4 o = acc[qt][dt] * inv; u32x2 w; w.x = pk2(o[0], o[1]); w.y = pk2(o[2], o[3]);
                *(u32x2*)(ATT + qr * 512 + hh * 64 + 16 * dt + 4 * g) = w; } }
    }
    LBAR();
}

__device__ __forceinline__ void mlstm_phase(LAS unsigned char* lds, const bf16_t* PROJ, const bf16_t* MQK, const float* G16, bf16_t* HRAW) {
    const int tid = threadIdx.x, lane = tid & 63, wave = __builtin_amdgcn_readfirstlane(tid >> 6);
    const int g = lane >> 4, c16 = lane & 15, q4 = (lane & 15) >> 2, p4 = lane & 3;
    LAS unsigned char* Qs = lds; LAS unsigned char* Ks = lds + 17408; LAS unsigned char* Vs = lds + 34816; LAS unsigned char* Vw = lds + 44032; LAS unsigned char* Cbt = lds + 53248;
    LAS float* bb = (LAS float*)(lds + 70656); LAS float* ee = (LAS float*)(lds + 78848); LAS float* cm = (LAS float*)(lds + 87040);
    LAS float* nbuf = (LAS float*)(lds + 95232); LAS float* wl = (LAS float*)(lds + 96256); LAS float* gch = (LAS float*)(lds + 96512);
    LAS float* amax = (LAS float*)(lds + 96640); LAS float* mprev = (LAS float*)(lds + 96768); LAS unsigned char* Hs = lds + 97280;
    constexpr float QSCALE = 0.08838834764831845f;
    const int vblk = (gridDim.x % 8 == 0) ? (int)((blockIdx.x & 7) * (gridDim.x >> 3) + (blockIdx.x >> 3)) : (int)blockIdx.x;
    for (int item = vblk; item < 256; item += gridDim.x) {
        const int bhid = item >> 2, vs = item & 3, b = bhid >> 2, h = bhid & 3;
        const size_t rowbase = (size_t)b * SEQ;
        {
            float lf[4], ig[4];
#pragma unroll
            for (int i = 0; i < 4; ++i) { const float* gp = G16 + (rowbase + 4 * tid + i) * 16; lf[i] = logsig(gp[12 + h]); ig[i] = gp[8 + h]; }
            lf[1] += lf[0]; lf[2] += lf[1]; lf[3] += lf[2];
            const float tot = lf[3]; float sc = tot;
#pragma unroll
            for (int o = 1; o < 16; o <<= 1) { const float y = __shfl_up(sc, o, 16); if (c16 >= o) sc += y; }
            const float excl = sc - tot;
            float bi[4], ei[4], pm[4];
#pragma unroll
            for (int i = 0; i < 4; ++i) { bi[i] = lf[i] + excl; ei[i] = ig[i] - bi[i]; }
            pm[0] = ei[0]; pm[1] = fmaxf(pm[0], ei[1]); pm[2] = fmaxf(pm[1], ei[2]); pm[3] = fmaxf(pm[2], ei[3]);
            float scm = pm[3];
#pragma unroll
            for (int o = 1; o < 16; o <<= 1) { const float y = __shfl_up(scm, o, 16); if (c16 >= o) scm = fmaxf(scm, y); }
            float exm = __shfl_up(scm, 1, 16); if (c16 == 0) exm = -1e30f;
#pragma unroll
            for (int i = 0; i < 4; ++i) { bb[4 * tid + i] = bi[i]; ee[4 * tid + i] = ei[i]; cm[4 * tid + i] = fmaxf(pm[i], exm); }
            if (c16 == 15) { gch[tid >> 4] = bi[3]; amax[tid >> 4] = bi[3] + fmaxf(pm[3], exm); }
            if (tid < 128) nbuf[tid] = 0.f;
            for (int i = tid; i < 17408 / 4; i += 512) ((LAS unsigned*)Cbt)[i] = 0u;
        }
        LBAR();
        if (tid == 0) { float m = 0.f; for (int c = 0; c < 32; ++c) { mprev[c] = m; m = fmaxf(gch[c] + m, amax[c]); } mprev[32] = m; }
        LBAR();
        f32x4 Cst[2][4], Cn[2];
#pragma unroll
        for (int dd = 0; dd < 2; ++dd) { Cn[dd] = (f32x4){0.f, 0.f, 0.f, 0.f};
#pragma unroll
            for (int vt = 0; vt < 4; ++vt) Cst[dd][vt] = (f32x4){0.f, 0.f, 0.f, 0.f}; }
        const int vrow = tid >> 3, vch = tid & 7;
#define MLOAD(cc, Q, K, V) do { _Pragma("unroll") for (int i_ = 0; i_ < 2; ++i_) { const int p_ = tid + 512 * i_, row_ = p_ >> 4, ch_ = p_ & 15; const size_t r_ = rowbase + (size_t)(cc) * 64 + row_; \
            Q[i_] = *(const u32x4*)(MQK + r_ * DM + h * 256 + ch_ * 8); K[i_] = *(const u32x4*)(MQK + r_ * DM + h * 256 + 128 + ch_ * 8); } \
            V = *(const u32x4*)(PROJ + (rowbase + (size_t)(cc) * 64 + vrow) * NP + C_MV + h * 256 + vs * 64 + vch * 8); } while (0)
        u32x4 qA[2], kA[2], vA, qB[2], kB[2], vB;
        MLOAD(0, qA, kA, vA); MLOAD(1, qB, kB, vB);
        auto chunk = [&](const int c, u32x4 (&qreg)[2], u32x4 (&kreg)[2], u32x4& vreg) {
            const float mp = mprev[c], mn = mprev[c + 1], gc = gch[c];
#pragma unroll
            for (int i = 0; i < 2; ++i) { const int p = tid + 512 * i, row = p >> 4, ch = p & 15;
                *(LAS u32x4*)(Qs + row * 272 + ch * 16) = qreg[i]; *(LAS u32x4*)(Ks + row * 272 + ch * 16) = kreg[i]; }
            *(LAS u32x4*)(Vs + vrow * 144 + vch * 16) = vreg;
            { const float wv = __expf(gc + ee[64 * c + vrow] - mn); u32x4 o;
              o.x = pk2(bflo(vreg.x) * wv, bfhi(vreg.x) * wv); o.y = pk2(bflo(vreg.y) * wv, bfhi(vreg.y) * wv); o.z = pk2(bflo(vreg.z) * wv, bfhi(vreg.z) * wv); o.w = pk2(bflo(vreg.w) * wv, bfhi(vreg.w) * wv);
              *(LAS u32x4*)(Vw + vrow * 144 + vch * 16) = o; }
            if (tid < 64) wl[tid] = __expf(gc + ee[64 * c + tid] - mn);
            LBAR();
            MLOAD(c + 2 < 32 ? c + 2 : 31, qreg, kreg, vreg);
            const float decay = __expf(gc + mp - mn);
            if (wave < 4) {
                const int lt = wave, l = 16 * lt + c16;
                const float mx_l = fmaxf(mp, cm[64 * c + l]), winter = __expf(mp - mx_l);
                const LAS float* nb_ = nbuf + (c & 1) * 128;
                bf16x8 qf[4]; f32x4 n0[4], n1[4], e4[4];
#pragma unroll
                for (int kd = 0; kd < 4; ++kd) { qf[kd] = *(const LAS bf16x8*)(Qs + l * 272 + (32 * kd + 8 * g) * 2); n0[kd] = *(const LAS f32x4*)(nb_ + 32 * kd + 8 * g); n1[kd] = *(const LAS f32x4*)(nb_ + 32 * kd + 8 * g + 4); }
#pragma unroll
                for (int st = 0; st < 4; ++st) e4[st] = *(const LAS f32x4*)(ee + 64 * c + 16 * st + 4 * g);
                f32x4 sT[4], acc[4];
#pragma unroll
                for (int h2 = 0; h2 < 2; ++h2) {
                    bf16x8 kf[2][4];
#pragma unroll
                    for (int s2 = 0; s2 < 2; ++s2)
#pragma unroll
                        for (int kd = 0; kd < 4; ++kd) kf[s2][kd] = *(const LAS bf16x8*)(Ks + (16 * (2 * h2 + s2) + c16) * 272 + (32 * kd + 8 * g) * 2);
#pragma unroll
                    for (int s2 = 0; s2 < 2; ++s2) { sT[2 * h2 + s2] = (f32x4){0.f, 0.f, 0.f, 0.f};
#pragma unroll
                        for (int kd = 0; kd < 4; ++kd) sT[2 * h2 + s2] = __builtin_amdgcn_mfma_f32_16x16x32_bf16(kf[s2][kd], qf[kd], sT[2 * h2 + s2], 0, 0, 0); }
                    asm volatile("" ::: "memory");
                }
                float qn = 0.f;
#pragma unroll
                for (int kd = 0; kd < 4; ++kd) { const u32x4 qw = __builtin_bit_cast(u32x4, qf[kd]);
                    qn += bflo(qw.x) * n0[kd][0] + bfhi(qw.x) * n0[kd][1] + bflo(qw.y) * n0[kd][2] + bfhi(qw.y) * n0[kd][3] + bflo(qw.z) * n1[kd][0] + bfhi(qw.z) * n1[kd][1] + bflo(qw.w) * n1[kd][2] + bfhi(qw.w) * n1[kd][3]; }
                qn = xadd32(xadd16(qn));
#pragma unroll
                for (int h2 = 0; h2 < 2; ++h2) {
                    bf16x8 cf[2][4];
#pragma unroll
                    for (int j2 = 0; j2 < 2; ++j2)
#pragma unroll
                        for (int kd = 0; kd < 4; ++kd) cf[j2][kd] = *(const LAS bf16x8*)(Cbt + (16 * (2 * h2 + j2) + c16) * 272 + (32 * kd + 8 * g) * 2);
#pragma unroll
                    for (int j2 = 0; j2 < 2; ++j2) { acc[2 * h2 + j2] = (f32x4){0.f, 0.f, 0.f, 0.f};
#pragma unroll
                        for (int kd = 0; kd < 4; ++kd) acc[2 * h2 + j2] = __builtin_amdgcn_mfma_f32_16x16x32_bf16(cf[j2][kd], qf[kd], acc[2 * h2 + j2], 0, 0, 0); }
                    asm volatile("" ::: "memory");
                }
                bf16x8 vf[2][4];
#pragma unroll
                for (int ks = 0; ks < 2; ++ks)
#pragma unroll
                    for (int j = 0; j < 4; ++j) {
                        const s16x4 lo = vtr(Vs + (32 * ks + 4 * g + q4) * 144 + (16 * j + 4 * p4) * 2), hi = vtr(Vs + (32 * ks + 16 + 4 * g + q4) * 144 + (16 * j + 4 * p4) * 2);
                        vf[ks][j] = (bf16x8){lo[0], lo[1], lo[2], lo[3], hi[0], hi[1], hi[2], hi[3]}; }
                float psum = 0.f;
#pragma unroll
                for (int st = 0; st < 4; ++st)
#pragma unroll
                    for (int i = 0; i < 4; ++i) { const int sidx = 16 * st + 4 * g + i; float val = sT[st][i] * QSCALE * __expf(e4[st][i] - mx_l); if (sidx > l) val = 0.f; psum += val; sT[st][i] = val; }
                const float wis = winter * QSCALE;
#pragma unroll
                for (int j = 0; j < 4; ++j) acc[j] = acc[j] * wis;
#pragma unroll
                for (int ks = 0; ks < 2; ++ks) {
                    u32x4 w; w.x = pk2(sT[2 * ks][0], sT[2 * ks][1]); w.y = pk2(sT[2 * ks][2], sT[2 * ks][3]); w.z = pk2(sT[2 * ks + 1][0], sT[2 * ks + 1][1]); w.w = pk2(sT[2 * ks + 1][2], sT[2 * ks + 1][3]);
                    const bf16x8 pf = __builtin_bit_cast(bf16x8, w);
#pragma unroll
                    for (int j = 0; j < 4; ++j) acc[j] = __builtin_amdgcn_mfma_f32_16x16x32_bf16(vf[ks][j], pf, acc[j], 0, 0, 0);
                }
                psum = xadd32(xadd16(psum));
                const float den = wis * qn + psum, mt = bb[64 * c + l] + mx_l;
                const float inv = 1.0f / fmaxf(fabsf(den), __expf(-mt));
#pragma unroll
                for (int j = 0; j < 4; ++j) { const f32x4 o = acc[j] * inv; u32x2 w; w.x = pk2(o[0], o[1]); w.y = pk2(o[2], o[3]);
                    *(LAS u32x2*)(Hs + l * 144 + (16 * j + 4 * g) * 2) = w; }
            } else {
                const int dt0 = 2 * (wave - 4);
                bf16x8 vb[2][4], ka[2][2]; f32x4 w0[2], w1[2];
#pragma unroll
                for (int kl = 0; kl < 2; ++kl) {
                    w0[kl] = *(const LAS f32x4*)(wl + 32 * kl + 8 * g); w1[kl] = *(const LAS f32x4*)(wl + 32 * kl + 8 * g + 4);
#pragma unroll
                    for (int dd = 0; dd < 2; ++dd) {
                        const s16x4 alo = vtr(Ks + (32 * kl + 8 * g + q4) * 272 + (16 * (dt0 + dd) + 4 * p4) * 2), ahi = vtr(Ks + (32 * kl + 8 * g + 4 + q4) * 272 + (16 * (dt0 + dd) + 4 * p4) * 2);
                        ka[kl][dd] = (bf16x8){alo[0], alo[1], alo[2], alo[3], ahi[0], ahi[1], ahi[2], ahi[3]}; }
#pragma unroll
                    for (int vt = 0; vt < 4; ++vt) {
                        const s16x4 blo = vtr(Vw + (32 * kl + 8 * g + q4) * 144 + (16 * vt + 4 * p4) * 2), bhi = vtr(Vw + (32 * kl + 8 * g + 4 + q4) * 144 + (16 * vt + 4 * p4) * 2);
                        vb[kl][vt] = (bf16x8){blo[0], blo[1], blo[2], blo[3], bhi[0], bhi[1], bhi[2], bhi[3]}; }
                }
#pragma unroll
                for (int dd = 0; dd < 2; ++dd) { Cn[dd] = Cn[dd] * decay;
#pragma unroll
                    for (int vt = 0; vt < 4; ++vt) Cst[dd][vt] = Cst[dd][vt] * decay; }
#pragma unroll
                for (int kl = 0; kl < 2; ++kl) {
                    u32x4 wa; wa.x = pk2(w0[kl][0], w0[kl][1]); wa.y = pk2(w0[kl][2], w0[kl][3]); wa.z = pk2(w1[kl][0], w1[kl][1]); wa.w = pk2(w1[kl][2], w1[kl][3]);
                    if (c16 != 0) wa = (u32x4){0u, 0u, 0u, 0u};
#pragma unroll
                    for (int dd = 0; dd < 2; ++dd) {
                        Cn[dd] = __builtin_amdgcn_mfma_f32_16x16x32_bf16(ka[kl][dd], __builtin_bit_cast(bf16x8, wa), Cn[dd], 0, 0, 0);
#pragma unroll
                        for (int vt = 0; vt < 4; ++vt) Cst[dd][vt] = __builtin_amdgcn_mfma_f32_16x16x32_bf16(ka[kl][dd], vb[kl][vt], Cst[dd][vt], 0, 0, 0);
                    }
                }
                if (c16 == 0) {
#pragma unroll
                    for (int dd = 0; dd < 2; ++dd) *(LAS f32x4*)(nbuf + ((c + 1) & 1) * 128 + 16 * (dt0 + dd) + 4 * g) = Cn[dd]; }
            }
            LBAR();
            *(u32x4*)(HRAW + (rowbase + (size_t)c * 64 + vrow) * DM + h * 256 + vs * 64 + vch * 8) = *(const LAS u32x4*)(Hs + vrow * 144 + vch * 16);
            if (wave >= 4) {
                const int dt0 = 2 * (wave - 4);
#pragma unroll
                for (int dd = 0; dd < 2; ++dd)
#pragma unroll
                    for (int vt = 0; vt < 4; ++vt) { u32x2 w; w.x = pk2(Cst[dd][vt][0], Cst[dd][vt][1]); w.y = pk2(Cst[dd][vt][2], Cst[dd][vt][3]);
                        *(LAS u32x2*)(Cbt + (16 * vt + c16) * 272 + (16 * (dt0 + dd) + 4 * g) * 2) = w; }
            }
        };
        for (int c0 = 0; c0 < 32; c0 += 2) { chunk(c0, qA, kA, vA); chunk(c0 + 1, qB, kB, vB); }
#undef MLOAD
        LBAR();
    }
}

__device__ __forceinline__ void headnorm_phase(const bf16_t* PROJ, const float* gnorm, bf16_t* HM) {
    const int tid = threadIdx.x, lane = tid & 63, wave = __builtin_amdgcn_readfirstlane(tid >> 6);
    float gq[16]; { float t0[8], t1[8]; ld8f(gnorm + 16 * lane, t0); ld8f(gnorm + 16 * lane + 8, t1);
#pragma unroll
        for (int e = 0; e < 8; ++e) { gq[e] = t0[e]; gq[8 + e] = t1[e]; } }
    for (int m0 = (blockIdx.x * 8 + wave) * 4; m0 < MT; m0 += gridDim.x * 32) {
        u32x4 hr[4][2], mr[4][2];
#pragma unroll
        for (int r = 0; r < 4; ++r) { const bf16_t* hp = HM + (size_t)(m0 + r) * DM + 16 * lane; const bf16_t* mo = PROJ + (size_t)(m0 + r) * NP + C_MO + 16 * lane;
            hr[r][0] = __builtin_nontemporal_load((const u32x4*)hp); hr[r][1] = __builtin_nontemporal_load((const u32x4*)(hp + 8)); mr[r][0] = __builtin_nontemporal_load((const u32x4*)mo); mr[r][1] = __builtin_nontemporal_load((const u32x4*)(mo + 8)); }
#pragma unroll
        for (int r = 0; r < 4; ++r) {
            float v[16], og[16];
            { float t0[8], t1[8]; unpack8(hr[r][0], t0); unpack8(hr[r][1], t1);
#pragma unroll
              for (int e = 0; e < 8; ++e) { v[e] = t0[e]; v[8 + e] = t1[e]; }
              unpack8(mr[r][0], t0); unpack8(mr[r][1], t1);
#pragma unroll
              for (int e = 0; e < 8; ++e) { og[e] = t0[e]; og[8 + e] = t1[e]; } }
            float s = 0.f;
#pragma unroll
            for (int i = 0; i < 16; ++i) s += v[i];
#pragma unroll
            for (int o = 1; o < 16; o <<= 1) s += __shfl_xor(s, o);
            const float mean = s * (1.f / 256.f); float s2 = 0.f;
#pragma unroll
            for (int i = 0; i < 16; ++i) { v[i] -= mean; s2 += v[i] * v[i]; }
#pragma unroll
            for (int o = 1; o < 16; o <<= 1) s2 += __shfl_xor(s2, o);
            const float rstd = 1.f / sqrtf(s2 * (1.f / 256.f) + LN_EPS);
            float r0[8], r1[8];
#pragma unroll
            for (int e = 0; e < 8; ++e) { r0[e] = v[e] * rstd * gq[e] * sigmoidf_(og[e]); r1[e] = v[8 + e] * rstd * gq[8 + e] * sigmoidf_(og[8 + e]); }
            bf16_t* hp = HM + (size_t)(m0 + r) * DM + 16 * lane;
            *(u32x4*)hp = pack8(r0); *(u32x4*)(hp + 8) = pack8(r1);
        }
    }
}

__device__ __forceinline__ void ln16(float (&v)[2][8]) {
    float s = 0.f;
#pragma unroll
    for (int j = 0; j < 2; ++j)
#pragma unroll
        for (int e = 0; e < 8; ++e) s += v[j][e];
    const float mean = wave_sum(s) * (1.f / DM); float s2 = 0.f;
#pragma unroll
    for (int j = 0; j < 2; ++j)
#pragma unroll
        for (int e = 0; e < 8; ++e) { v[j][e] -= mean; s2 += v[j][e] * v[j][e]; }
    const float rstd = 1.f / sqrtf(wave_sum(s2) * (1.f / DM) + LN_EPS);
#pragma unroll
    for (int j = 0; j < 2; ++j)
#pragma unroll
        for (int e = 0; e < 8; ++e) v[j][e] *= rstd;
}
__device__ __forceinline__ void ln_mid_phase(const bf16_t* Z, const float* lg, const float* lb, const float* MOD, bf16_t* X1, bf16_t* H2) {
    const int tid = threadIdx.x, lane = tid & 63, wave = __builtin_amdgcn_readfirstlane(tid >> 6);
    float gg[2][8], bq[2][8];
#pragma unroll
    for (int j = 0; j < 2; ++j) { ld8f(lg + 8 * lane + 512 * j, gg[j]); ld8f(lb + 8 * lane + 512 * j, bq[j]); }
    for (int m0 = (blockIdx.x * 8 + wave) * 4; m0 < MT; m0 += gridDim.x * 32) {
        const int b = m0 >> 11;
        u32x4 raw[4][2]; float sh[2][8], sc[2][8];
#pragma unroll
        for (int r = 0; r < 4; ++r)
#pragma unroll
            for (int j = 0; j < 2; ++j) raw[r][j] = __builtin_nontemporal_load((const u32x4*)(Z + (size_t)(m0 + r) * DM + 8 * lane + 512 * j));
#pragma unroll
        for (int j = 0; j < 2; ++j) { ld8f(MOD + (size_t)b * 6144 + 3072 + 8 * lane + 512 * j, sh[j]); ld8f(MOD + (size_t)b * 6144 + 4096 + 8 * lane + 512 * j, sc[j]); }
        asm volatile("" ::: "memory");
#pragma unroll
        for (int r = 0; r < 4; ++r) {
            float v[2][8]; unpack8(raw[r][0], v[0]); unpack8(raw[r][1], v[1]);
            ln16(v);
#pragma unroll
            for (int j = 0; j < 2; ++j) {
#pragma unroll
                for (int e = 0; e < 8; ++e) v[j][e] = v[j][e] * gg[j][e] + bq[j][e];
                *(u32x4*)(X1 + (size_t)(m0 + r) * DM + 8 * lane + 512 * j) = pack8(v[j]); }
            ln16(v);
#pragma unroll
            for (int j = 0; j < 2; ++j) {
#pragma unroll
                for (int e = 0; e < 8; ++e) v[j][e] = v[j][e] * (sc[j][e] + 1.0f) + sh[j][e];
                *(u32x4*)(H2 + (size_t)(m0 + r) * DM + 8 * lane + 512 * j) = pack8(v[j]); }
        }
    }
}
__device__ __forceinline__ void ln_out_phase(const bf16_t* Z, const float* lg, const float* lb, float* OUT) {
    const int tid = threadIdx.x, lane = tid & 63, wave = __builtin_amdgcn_readfirstlane(tid >> 6);
    float gg[2][8], bq[2][8];
#pragma unroll
    for (int j = 0; j < 2; ++j) { ld8f(lg + 8 * lane + 512 * j, gg[j]); ld8f(lb + 8 * lane + 512 * j, bq[j]); }
    for (int m0 = (blockIdx.x * 8 + wave) * 4; m0 < MT; m0 += gridDim.x * 32) {
        u32x4 raw[4][2];
#pragma unroll
        for (int r = 0; r < 4; ++r)
#pragma unroll
            for (int j = 0; j < 2; ++j) raw[r][j] = *(const u32x4*)(Z + (size_t)(m0 + r) * DM + 8 * lane + 512 * j);
#pragma unroll
        for (int r = 0; r < 4; ++r) {
            float v[2][8]; unpack8(raw[r][0], v[0]); unpack8(raw[r][1], v[1]);
            ln16(v);
#pragma unroll
            for (int j = 0; j < 2; ++j) { float* op = OUT + (size_t)(m0 + r) * DM + 8 * lane + 512 * j;
                *(f32x4*)op = (f32x4){v[j][0] * gg[j][0] + bq[j][0], v[j][1] * gg[j][1] + bq[j][1], v[j][2] * gg[j][2] + bq[j][2], v[j][3] * gg[j][3] + bq[j][3]};
                *(f32x4*)(op + 4) = (f32x4){v[j][4] * gg[j][4] + bq[j][4], v[j][5] * gg[j][5] + bq[j][5], v[j][6] * gg[j][6] + bq[j][6], v[j][7] * gg[j][7] + bq[j][7]}; }
        }
    }
}

#define XB_TMO      128
#define XB_XCNT(j)  (256  + 64 * (j))
#define XB_XSUB(j)  (1280 + 64 * (j))
#define XB_XGEN(j)  (2304 + 64 * (j))
#define XB_TOP      3328
#define XB_TOPGEN   3392
#define XCD_BAR_WORDS 3456
#define XB_SPIN_CAP (1u << 22)
__device__ __forceinline__ unsigned xb_ld(unsigned* p)              { return __hip_atomic_load(p, __ATOMIC_RELAXED, __HIP_MEMORY_SCOPE_AGENT); }
__device__ __forceinline__ unsigned xb_add(unsigned* p, unsigned v) { return __hip_atomic_fetch_add(p, v, __ATOMIC_RELAXED, __HIP_MEMORY_SCOPE_AGENT); }
__device__ __forceinline__ unsigned xb_xcc_id() { return (unsigned)__builtin_amdgcn_s_getreg((3 << 11) | 20) & 0xFu; }
#define XB_SPIN(cond, bar) do { unsigned _sp = 0; while (cond) { __builtin_amdgcn_s_sleep(1); \
    if ((++_sp & 255u) == 0u) { if (xb_ld(&(bar)[XB_TMO])) break; if (_sp > XB_SPIN_CAP) { atomicAdd(&(bar)[XB_TMO], 1u); break; } } } } while (0)
struct XcdBarrier { unsigned* bar; unsigned x; volatile LAS unsigned* st; };
__device__ __forceinline__ XcdBarrier xcd_barrier_post(unsigned* bar, volatile LAS unsigned* st) {
    XcdBarrier b; b.bar = bar; b.x = xb_xcc_id(); b.st = st;
    if (threadIdx.x == 0) (void)xb_add(&bar[XB_XCNT(b.x)], 1u);
    return b;
}
__device__ __forceinline__ void xcd_barrier_complete(unsigned* bar, unsigned x, unsigned& nloc, unsigned& nx) {
    const unsigned G = gridDim.x * gridDim.y * gridDim.z;
    unsigned sum, cnt, mine, sp = 0u;
    for (;;) {
        sum = 0u; cnt = 0u; mine = 0u;
#pragma unroll
        for (unsigned j = 0; j < 16; ++j) { const unsigned c = xb_ld(&bar[XB_XCNT(j)]); sum += c; cnt += (c > 0u) ? 1u : 0u; mine = (j == x) ? c : mine; }
        if (sum == G) break;
        __builtin_amdgcn_s_sleep(1);
        if ((++sp & 255u) == 0u) { if (xb_ld(&bar[XB_TMO])) break; if (sp > XB_SPIN_CAP) { atomicAdd(&bar[XB_TMO], 1u); break; } }
    }
    nloc = mine > 0u ? mine : 1u; nx = cnt > 0u ? cnt : 1u;
}
__device__ __forceinline__ void xcd_barrier(const XcdBarrier& b) {
    asm volatile("s_waitcnt vmcnt(0)" ::: "memory");
    __syncthreads();
    if (threadIdx.x == 0) {
        unsigned* bar = b.bar;
        __builtin_amdgcn_s_waitcnt(0);
        unsigned nloc = b.st[0], nx = b.st[1];
        if (nloc == 0u) { xcd_barrier_complete(bar, b.x, nloc, nx); b.st[0] = nloc; b.st[1] = nx; }
        const unsigned old = xb_add(&bar[XB_XSUB(b.x)], 1u);
        const unsigned gen = old / nloc;
        if (old + 1u == (gen + 1u) * nloc) {
            __builtin_amdgcn_fence(__ATOMIC_RELEASE, "agent");
            asm volatile("s_waitcnt vmcnt(0)" ::: "memory");
            const unsigned og = xb_add(&bar[XB_TOP], 1u);
            const unsigned tg = og / nx;
            if (og + 1u == (tg + 1u) * nx) xb_add(&bar[XB_TOPGEN], 1u);
            else XB_SPIN(xb_ld(&bar[XB_TOPGEN]) == tg, bar);
            __builtin_amdgcn_fence(__ATOMIC_ACQUIRE, "agent");
            xb_add(&bar[XB_XGEN(b.x)], 1u);
            asm volatile("s_waitcnt vmcnt(0)" ::: "memory");
        } else {
            XB_SPIN(xb_ld(&bar[XB_XGEN(b.x)]) == gen, bar);
            __builtin_amdgcn_fence(__ATOMIC_ACQUIRE, "agent");
            asm volatile("s_waitcnt vmcnt(0)" ::: "memory");
        }
    }
    __syncthreads();
}

__device__ __forceinline__ void split_arrive(unsigned* ctr) {
    asm volatile("s_waitcnt vmcnt(0)" ::: "memory");
    __syncthreads();
    if (threadIdx.x == 0) { __builtin_amdgcn_fence(__ATOMIC_RELEASE, "agent"); asm volatile("s_waitcnt vmcnt(0)" ::: "memory"); (void)xb_add(ctr, 1u); }
}
__device__ __forceinline__ void split_wait(unsigned* ctr, unsigned want) {
    if (threadIdx.x == 0) { unsigned sp = 0; while (xb_ld(ctr) < want) { __builtin_amdgcn_s_sleep(2); if (++sp > (1u << 24)) break; }
        __builtin_amdgcn_fence(__ATOMIC_ACQUIRE, "agent"); asm volatile("s_waitcnt vmcnt(0)" ::: "memory"); }
    __syncthreads();
}

constexpr int N_PHASES = 12;
struct Args { const float* in[20]; float* out; unsigned char* ws; int ph_lo, ph_hi; };

__global__ void __launch_bounds__(512, 2) fwd_megakernel(Args a) {
    extern __shared__ __attribute__((aligned(16))) unsigned char lds_raw[];
    LAS unsigned char* lds = (LAS unsigned char*)lds_raw;
    cg::grid_group grid = cg::this_grid();
    unsigned char* ws = a.ws; unsigned char* dob = (unsigned char*)a.out;
    const int lo = a.ph_lo, hi = a.ph_hi, G = gridDim.x;
#ifndef REP_ID
#define REP_ID 0
#endif
#ifndef PH_MASK
#define PH_MASK 0x1ff
#endif
#define IN(k) (((PH_MASK >> (k)) & 1) && lo <= (k) && (k) < hi)
#define SEAM(k) do { if (IN(k) && IN((k) + 1)) { xcd_barrier(xbar); } } while (0)
    volatile LAS unsigned* MISC = (volatile LAS unsigned*)(lds + 131072 + 320);
    if (threadIdx.x < 32) MISC[threadIdx.x] = 0u;
    __syncthreads();
    XcdBarrier xbar = xcd_barrier_post((unsigned*)ws, MISC + 8);
    float* MOD = (float*)(ws + WS_MOD); float* G16 = (float*)(ws + WS_G16); float* FCUM = (float*)(ws + WS_FCUM);
    bf16_t* PROJ = (bf16_t*)(ws + WS_PROJ); bf16_t* ATT = (bf16_t*)(ws + WS_ATT);
    bf16_t* BUFA = (bf16_t*)(dob + DO_A); bf16_t* BUFB = (bf16_t*)(dob + DO_B);

    unsigned* SC = (unsigned*)(ws + WS_CNT + 98304);
    if (lo > 1000) grid.sync();
    if (IN(0)) {
        p0_prologue(lds, a.in, ws, SC);
        p1_ln_gates(lds, a.in[0], MOD, (const float*)(ws + WS_WG), (const float*)(ws + WS_BG), BUFA, G16);
    }
    SEAM(0);
    if (IN(1)) {
        fscan(lds, G16, FCUM);
        pg8::Gemm g{BUFA, (const bf16_t*)(ws + WS_WT_IN), MT, NP, 1024, 1024, 1024, 0}; pg8::StaticOrder S; S.init(MT, NP, G, (int)blockIdx.x);
        pg8::EpiProj E{PROJ, NP, a.in[5], 1};
        pg8::gemm_phase(lds, g, S, E);
    }
    SEAM(1);
    if (IN(2)) {
        conv_phase(PROJ, a.in[6], a.in[7], BUFA);
        split_arrive(SC + 64);
#if FOX_REF_ATTN
        attn_phase_ref((char*)lds_raw, PROJ, FCUM, ATT);
#else
        attn_phase(lds, PROJ, FCUM, ATT);
#endif
        split_wait(SC + 64, G);
        pg8::Gemm g{BUFA, (const bf16_t*)(ws + WS_WT_QK), MT, 1024, 256, 1024, 256, 512}; pg8::StaticOrder S; S.init(MT, 1024, G, (int)blockIdx.x);
        pg8::EpiProj E{BUFB, 1024, nullptr, 0};
        pg8::gemm_phase(lds, g, S, E);
    }
    SEAM(2);
    if (IN(3)) mlstm_phase(lds, PROJ, BUFB, G16, BUFA);
    SEAM(3);
    if (IN(4)) {
        headnorm_phase(PROJ, a.in[10], BUFA);
        split_arrive(SC + 128);
        { pg8::Gemm g{ATT, (const bf16_t*)(ws + WS_WT_PA), MT, 1024, 512, 512, 512, 0}; pg8::StaticOrder S; S.init(MT, 1024, G, (int)blockIdx.x);
          pg8::EpiY<0> E{BUFB, PROJ + C_GA};
          pg8::gemm_phase(lds, g, S, E); }
        split_wait(SC + 128, G);
        { pg8::Gemm g{BUFA, (const bf16_t*)(ws + WS_WT_PB), MT, 1024, 1024, 1024, 1024, 0}; pg8::StaticOrder S; S.init(MT, 1024, G, (int)blockIdx.x);
          pg8::EpiY<1> E{BUFB, PROJ + C_GB};
          pg8::gemm_phase(lds, g, S, E); }
    }
    SEAM(4);
    if (IN(5)) {
        pg8::Gemm g{BUFB, (const bf16_t*)(ws + WS_WT_OUT), MT, 1024, 1024, 1024, 1024, 0}; pg8::StaticOrder S; S.init(MT, 1024, G, (int)blockIdx.x);
        pg8::EpiRes<0> E{(const void*)a.in[0], MOD + 2048, (bf16_t*)(ws + WS_Z)};
        pg8::gemm_phase(lds, g, S, E);
    }
    SEAM(5);
    if (IN(6)) ln_mid_phase((const bf16_t*)(ws + WS_Z), a.in[14], a.in[15], MOD, (bf16_t*)(ws + WS_X1), BUFA);
    SEAM(6);
    if (IN(7)) {
        pg8::Gemm g{BUFA, (const bf16_t*)(ws + WS_WT_FI), MT, 2 * DFF, 1024, 1024, 1024, 0}; pg8::StaticOrder S; S.init(MT, 2 * DFF, G, (int)blockIdx.x);
        pg8::EpiSwiglu E{(bf16_t*)(ws + WS_ACT)};
        pg8::gemm_phase(lds, g, S, E);
    }
    SEAM(7);
    if (IN(8)) {
        pg8::Gemm g{(const bf16_t*)(ws + WS_ACT), (const bf16_t*)(ws + WS_WT_FD), MT, 1024, DFF, DFF, DFF, 0}; pg8::StaticOrder S; S.init(MT, 1024, G, (int)blockIdx.x);
        pg8::PanelStats st{(unsigned long long*)(ws + WS_XB3), (unsigned*)(ws + WS_CNT + 65536), lds + 132096};
        pg8::EpiLnOut E{(const bf16_t*)(ws + WS_X1), MOD + 5120, a.in[18], a.in[19], a.out, st};
        pg8::gemm_phase(lds, g, S, E);
    }
#undef IN
#undef SEAM
}

extern "C" void kernel_launch(void* const* d_in, const int* in_sizes, int n_in, void* d_out, int out_size, void* d_ws, size_t ws_size, hipStream_t stream) {
    static int grid = 0;
    if (grid == 0) {
        int dev = 0, cus = 0, per_cu = 0;
        hipGetDevice(&dev);
        hipDeviceGetAttribute(&cus, hipDeviceAttributeMultiprocessorCount, dev);
        if (hipFuncSetAttribute((const void*)fwd_megakernel, hipFuncAttributeMaxDynamicSharedMemorySize, LDS_BYTES) != hipSuccess) fprintf(stderr, "kernel_launch: hipFuncSetAttribute failed\n");
        if (hipOccupancyMaxActiveBlocksPerMultiprocessor(&per_cu, (const void*)fwd_megakernel, 512, LDS_BYTES) != hipSuccess || per_cu < 1) per_cu = 1;
        (void)hipGetLastError();
        grid = cus * per_cu; if (grid <= 0) grid = 256;
    }
    (void)hipMemsetAsync(d_ws, 0, 262144, stream);
    Args a{};
    for (int i = 0; i < 20; ++i) a.in[i] = (const float*)d_in[i];
    a.out = (float*)d_out; a.ws = (unsigned char*)d_ws;
    constexpr int NPH = 9;
    const int nl = MK_N_LAUNCHES;
    for (int li = 0; li < nl; ++li) {
        a.ph_lo = (nl == 1) ? 0 : li; a.ph_hi = (nl == 1) ? NPH : li + 1;
        void* args[] = {&a};
        hipError_t e = hipLaunchCooperativeKernel((const void*)fwd_megakernel, dim3(grid), dim3(512), args, LDS_BYTES, stream);
        if (e != hipSuccess) { fprintf(stderr, "cooperative launch failed: %s (grid %d)\n", hipGetErrorString(e), grid); break; }
    }
}
```

```cpp
#include <hip/hip_runtime.h>
#include <hip/hip_cooperative_groups.h>
#include <hip/hip_bf16.h>
#include <cmath>
#include <cstdio>
#include <cstdint>
namespace cg = cooperative_groups;

#ifndef FOX_REF_ATTN
#define FOX_REF_ATTN 1
#endif
#ifndef MK_N_LAUNCHES
#define MK_N_LAUNCHES 1
#endif

#define LAS __attribute__((address_space(3)))
typedef unsigned short bf16_t;
typedef short bf16x8 __attribute__((ext_vector_type(8)));
typedef short s16x4 __attribute__((ext_vector_type(4)));
typedef short v4i16_t __attribute__((ext_vector_type(4)));
typedef float f32x4 __attribute__((ext_vector_type(4)));
typedef float f32x2 __attribute__((ext_vector_type(2)));
typedef unsigned u32x4 __attribute__((ext_vector_type(4)));
typedef unsigned u32x2 __attribute__((ext_vector_type(2)));
typedef __bf16 bf16x2_t __attribute__((ext_vector_type(2)));

constexpr int BATCH = 16, SEQ = 2048, DM = 1024, MT = BATCH * SEQ;
constexpr int DIN = 6672, NP = 6656, DFF = 2816;
constexpr int C_FQ = 0, C_FK = 512, C_FV = 1024, C_MU = 1536, C_MV = 2560, C_MO = 3584, C_GA = 4608, C_GB = 5632;
constexpr float LN_EPS = 1e-5f, ALPHA = 1.189207115002721f, LOG2E = 1.4426950408889634f;
constexpr int LDS_BYTES = 147456;

constexpr size_t MiB = 1u << 20;
constexpr size_t WS_MOD = 1 * MiB, WS_WG = 2 * MiB, WS_BG = 2 * MiB + 65536, WS_FCUM = 3 * MiB, WS_G16 = 4 * MiB;
constexpr size_t WS_WT_IN = 8 * MiB, WS_WT_QK = 21 * MiB, WS_WT_PA = 22 * MiB, WS_WT_PB = 23 * MiB, WS_WT_OUT = 25 * MiB, WS_WT_FI = 27 * MiB, WS_WT_FD = 38 * MiB;
constexpr size_t WS_XB1 = 44 * MiB, WS_XB2 = 45 * MiB, WS_XB3 = 46 * MiB;
constexpr size_t WS_CNT = 65536;
constexpr size_t WS_PROJ = 48 * MiB;
constexpr size_t WS_ATT = 464 * MiB;
constexpr size_t WS_Z = 48 * MiB;
constexpr size_t WS_X1 = 176 * MiB;
constexpr size_t WS_ACT = 304 * MiB;
constexpr size_t WS_Z2 = 48 * MiB;
constexpr size_t DO_A = 0, DO_B = 64 * MiB;

__device__ __forceinline__ unsigned pk2(float lo, float hi) { f32x2 v = {lo, hi}; bf16x2_t b = __builtin_convertvector(v, bf16x2_t); return __builtin_bit_cast(unsigned, b); }
__device__ __forceinline__ float bflo(unsigned w) { return __uint_as_float(w << 16); }
__device__ __forceinline__ float bfhi(unsigned w) { return __uint_as_float(w & 0xffff0000u); }
__device__ __forceinline__ float sigmoidf_(float x) { return __builtin_amdgcn_rcpf(1.0f + __expf(-x)); }
__device__ __forceinline__ float logsig(float x) { return fminf(x, 0.f) - log1pf(expf(-fabsf(x))); }
__device__ __forceinline__ float wave_sum(float v) {
#pragma unroll
    for (int o = 1; o < 64; o <<= 1) v += __shfl_xor(v, o);
    return v;
}
__device__ __forceinline__ s16x4 vtr(const LAS unsigned char* p) { return __builtin_bit_cast(s16x4, __builtin_amdgcn_ds_read_tr16_b64_v4i16((LAS v4i16_t*)p)); }
#define LDS_WAIT() asm volatile("s_waitcnt lgkmcnt(0)" ::: "memory")
#define LBAR() do { asm volatile("s_waitcnt lgkmcnt(0)" ::: "memory"); __builtin_amdgcn_s_barrier(); asm volatile("" ::: "memory"); } while (0)

__device__ __forceinline__ void unpack8(const u32x4 w, float (&v)[8]) { v[0] = bflo(w.x); v[1] = bfhi(w.x); v[2] = bflo(w.y); v[3] = bfhi(w.y); v[4] = bflo(w.z); v[5] = bfhi(w.z); v[6] = bflo(w.w); v[7] = bfhi(w.w); }
__device__ __forceinline__ u32x4 pack8(const float (&v)[8]) { u32x4 w; w.x = pk2(v[0], v[1]); w.y = pk2(v[2], v[3]); w.z = pk2(v[4], v[5]); w.w = pk2(v[6], v[7]); return w; }
__device__ __forceinline__ void ld8f(const float* p, float (&v)[8]) { const f32x4 a = *(const f32x4*)p, b = *(const f32x4*)(p + 4); v[0] = a[0]; v[1] = a[1]; v[2] = a[2]; v[3] = a[3]; v[4] = b[0]; v[5] = b[1]; v[6] = b[2]; v[7] = b[3]; }

namespace pg8 {
constexpr int BM = 256, BK = 64, HALF = 128, HTB = HALF * BK * 2, STAGE_BYTES = 8 * HTB, NXCD = 8, WGM = 8;
__host__ __device__ __forceinline__ int lds_byte(int r, int c) { const int st = (r >> 4) * 2 + (c >> 5), rr = r & 15, cc = c & 31, ob = rr * 64 + cc * 2; return st * 1024 + (ob ^ (((ob >> 9) & 1) << 5)); }
__host__ __device__ __forceinline__ void stage_rc(int b, int& R, int& C) { const int st = b / 1024, sb = b % 1024, swz = sb ^ (((sb >> 9) & 1) << 5); R = (st >> 1) * 16 + swz / 64; C = (st & 1) * 32 + (swz % 64) / 2; }
__host__ __device__ __forceinline__ int perm32(int rho) { const int n = rho >> 4, i = rho & 15; return 8 * (i >> 2) + 4 * n + (i & 3); }

struct Unit { int pm, pn; };
struct Gemm { const bf16_t* A; const bf16_t* Bt; int M, N, K, lda, ldb, aoffN; };

struct StaticOrder {
    int nM, nN, nwg, G, c;
    __device__ void init(int M, int N, int G_, int c_) { nM = M / BM; nN = N / BM; nwg = nM * nN; G = G_; c = c_; }
    __device__ bool next(int i, Unit& u) const {
        const long L = (long)i * G + c; if (L >= nwg) return false;
        int wgid = (int)L; { const int q = nwg / NXCD, r = nwg % NXCD, xcd = wgid % NXCD, off = wgid / NXCD; wgid = (xcd < r ? xcd * (q + 1) : r * (q + 1) + (xcd - r) * q) + off; }
        const int nig = WGM * nN, gid = wgid / nig, fm = gid * WGM, gsz = (nM - fm) < WGM ? (nM - fm) : WGM;
        u.pm = fm + ((wgid % nig) % gsz); u.pn = (wgid % nig) / gsz; return true;
    }
};
template <class Epi, class Sched>
__device__ __forceinline__ void gemm_phase(LAS unsigned char* lds, const Gemm g, const Sched& S, const Epi& E) {
    const int tid = threadIdx.x, wid = __builtin_amdgcn_readfirstlane(tid >> 6), lane = tid & 63, wr = wid >> 2, wc = wid & 3, fr = lane & 15, fq = lane >> 4;
    const int K = g.K, nt = K / BK;
    unsigned voffA[2], voffB[2];
#pragma unroll
    for (int i = 0; i < 2; ++i) { int R, C; stage_rc(tid * 16 + i * 8192, R, C); const int Rb = Epi::PERM ? ((R & ~31) + perm32(R & 31)) : R;
        voffA[i] = (unsigned)(R * g.lda + C) * 2u; voffB[i] = (unsigned)(Rb * g.ldb + C) * 2u; }
    const size_t kstep = (size_t)(BK * 2);
    const size_t hstepA = (size_t)HALF * g.lda * 2, hstepB = (size_t)HALF * g.ldb * 2;
    const size_t tstepA = 2 * hstepA, tstepB = 2 * hstepB;
    const unsigned ldsw = (unsigned)wid * 1024u;
    const int aoff = lds_byte(wr * 64 + fr, fq * 8), boff = lds_byte(wc * 32 + fr, fq * 8);
#define PG8_SA(b, h) (((b) * 2 + (h)) * HTB)
#define PG8_SB(b, h) ((4 + (b) * 2 + (h)) * HTB)
#define PG8_STAGE(bufoff, gbase, voff) do { _Pragma("unroll") for (int _i = 0; _i < 2; ++_i) \
        __builtin_amdgcn_global_load_lds((const unsigned*)((const char*)(gbase) + (voff)[_i]), (LAS unsigned*)(lds + (bufoff) + ldsw + _i * 8192), 16, 0, 0); } while (0)
#define PG8_LDA(dst, b, h) do { _Pragma("unroll") for (int m = 0; m < 4; ++m) _Pragma("unroll") for (int k = 0; k < 2; ++k) dst[m][k] = *(const LAS bf16x8*)(lds + PG8_SA(b, h) + aoff + m * 2048 + k * 1024); } while (0)
#define PG8_LDB(dst, b, h) do { _Pragma("unroll") for (int n = 0; n < 2; ++n) _Pragma("unroll") for (int k = 0; k < 2; ++k) dst[n][k] = *(const LAS bf16x8*)(lds + PG8_SB(b, h) + boff + n * 2048 + k * 1024); } while (0)
#define PG8_MMA(ai, bj, At, Bt) do { __builtin_amdgcn_s_setprio(1); _Pragma("unroll") for (int m = 0; m < 4; ++m) _Pragma("unroll") for (int n = 0; n < 2; ++n) _Pragma("unroll") for (int k = 0; k < 2; ++k) \
        acc[ai][bj][m][n] = __builtin_amdgcn_mfma_f32_16x16x32_bf16(Bt[n][k], At[m][k], acc[ai][bj][m][n], 0, 0, 0); __builtin_amdgcn_s_setprio(0); } while (0)
#define PG8_WAIT_V(n) asm volatile("s_waitcnt vmcnt(" #n ")" ::: "memory")
#define PG8_WAIT_L(n) asm volatile("s_waitcnt lgkmcnt(" #n ")" ::: "memory")
#define PG8_BAR __builtin_amdgcn_s_barrier()
#define PG8_SCHED __builtin_amdgcn_sched_barrier(0)
    Unit cur, nxt; int ui = 0;
    if (!S.next(0, cur)) return;
    f32x4 acc[2][2][4][2];
#pragma unroll
    for (int a = 0; a < 2; ++a)
#pragma unroll
        for (int b = 0; b < 2; ++b)
#pragma unroll
            for (int m = 0; m < 4; ++m)
#pragma unroll
                for (int n = 0; n < 2; ++n) acc[a][b][m][n] = (f32x4){0.f, 0.f, 0.f, 0.f};
    bf16x8 At[4][2], B0[2][2], B1[2][2];
    const char* cA = (const char*)g.A + (size_t)cur.pm * tstepA + (size_t)cur.pn * g.aoffN; const char* cB = (const char*)g.Bt + (size_t)cur.pn * tstepB;
    PG8_STAGE(PG8_SB(0, 0), cB, voffB); PG8_STAGE(PG8_SB(0, 1), cB + hstepB, voffB); PG8_STAGE(PG8_SA(0, 0), cA, voffA); PG8_STAGE(PG8_SA(0, 1), cA + hstepA, voffA);
    if (wr == 1) PG8_BAR;
    PG8_WAIT_V(2); PG8_BAR;
    PG8_STAGE(PG8_SB(1, 0), cB + kstep, voffB); PG8_STAGE(PG8_SA(1, 0), cA + kstep, voffA); PG8_STAGE(PG8_SB(1, 1), cB + hstepB + kstep, voffB);
    PG8_WAIT_V(6); PG8_BAR;
    for (;;) {
        const bool has_next = S.next(ui + 1, nxt);
        const char* nA = has_next ? (const char*)g.A + (size_t)nxt.pm * tstepA + (size_t)nxt.pn * g.aoffN : cA; const char* nB = has_next ? (const char*)g.Bt + (size_t)nxt.pn * tstepB : cB;
        for (int t = 0; t < nt; t += 2) {
            const bool last = (t == nt - 2);
            const char* a1 = cA + (size_t)(t + 1) * kstep;
            const char* a2 = last ? nA : cA + (size_t)(t + 2) * kstep; const char* b2 = last ? nB : cB + (size_t)(t + 2) * kstep;
            const char* a3 = a2 + kstep; const char* b3 = b2 + kstep;
            PG8_LDB(B0, 0, 0); PG8_LDB(B1, 0, 1); PG8_SCHED; PG8_LDA(At, 0, 0); PG8_STAGE(PG8_SA(1, 1), a1 + hstepA, voffA);
            PG8_WAIT_V(8); PG8_WAIT_L(0); PG8_BAR; PG8_MMA(0, 0, At, B0); PG8_MMA(0, 1, At, B1); PG8_BAR; PG8_SCHED;
            PG8_LDA(At, 0, 1); PG8_STAGE(PG8_SB(0, 0), b2, voffB); PG8_STAGE(PG8_SB(0, 1), b2 + hstepB, voffB); PG8_STAGE(PG8_SA(0, 0), a2, voffA);
            PG8_WAIT_V(8); PG8_WAIT_L(0); PG8_BAR; PG8_MMA(1, 0, At, B0); PG8_MMA(1, 1, At, B1); PG8_BAR; PG8_SCHED;
            PG8_LDB(B0, 1, 0); PG8_LDB(B1, 1, 1); PG8_SCHED; PG8_LDA(At, 1, 0); PG8_STAGE(PG8_SA(0, 1), a2 + hstepA, voffA);
            PG8_WAIT_V(8); PG8_WAIT_L(0); PG8_BAR; PG8_MMA(0, 0, At, B0); PG8_MMA(0, 1, At, B1); PG8_BAR; PG8_SCHED;
            PG8_LDA(At, 1, 1); PG8_STAGE(PG8_SB(1, 0), b3, voffB); PG8_STAGE(PG8_SB(1, 1), b3 + hstepB, voffB); PG8_STAGE(PG8_SA(1, 0), a3, voffA);
            PG8_WAIT_V(8); PG8_WAIT_L(0); PG8_BAR; PG8_MMA(1, 0, At, B0); PG8_MMA(1, 1, At, B1); PG8_BAR; PG8_SCHED;
        }
        if (wr == 0) PG8_BAR;
        asm volatile("" ::: "memory"); PG8_SCHED;
        E(acc, cur, wr, wc, fr, fq);
        if (!has_next) break;
#pragma unroll
        for (int a = 0; a < 2; ++a)
#pragma unroll
            for (int b = 0; b < 2; ++b)
#pragma unroll
                for (int m = 0; m < 4; ++m)
#pragma unroll
                    for (int n = 0; n < 2; ++n) acc[a][b][m][n] = (f32x4){0.f, 0.f, 0.f, 0.f};
        cur = nxt; cA = nA; cB = nB; ++ui;
        if (wr == 1) PG8_BAR;
    }
    PG8_WAIT_V(0);
    PG8_BAR;
#undef PG8_SA
#undef PG8_SB
#undef PG8_STAGE
#undef PG8_LDA
#undef PG8_LDB
#undef PG8_MMA
#undef PG8_WAIT_V
#undef PG8_WAIT_L
#undef PG8_BAR
#undef PG8_SCHED
}

struct EpiProj {
    static constexpr bool PERM = true;
    bf16_t* O; int ldc; const float* bias; int has_shift;
    __device__ __forceinline__ void operator()(f32x4 (&acc)[2][2][4][2], const Unit& u, int wr, int wc, int fr, int fq) const {
        const int row0 = u.pm * BM + wr * 64 + fr; const int colt = u.pn * BM; const int col0 = colt + wc * 32 + 8 * fq;
        int shift = 0; if (has_shift) shift = (colt >= 1536 ? 8 : 0) + (colt >= 3584 ? 8 : 0);
        f32x4 bv[2][2];
#pragma unroll
        for (int bj = 0; bj < 2; ++bj)
#pragma unroll
            for (int n = 0; n < 2; ++n) bv[bj][n] = bias ? *(const f32x4*)(bias + col0 + shift + bj * HALF + 4 * n) : (f32x4){0.f, 0.f, 0.f, 0.f};
#pragma unroll
        for (int ai = 0; ai < 2; ++ai)
#pragma unroll
            for (int m = 0; m < 4; ++m) { bf16_t* rowp = O + (size_t)(row0 + ai * HALF + m * 16) * ldc + col0;
#pragma unroll
                for (int bj = 0; bj < 2; ++bj) { const f32x4 v0 = acc[ai][bj][m][0] + bv[bj][0], v1 = acc[ai][bj][m][1] + bv[bj][1];
                    u32x4 w; w.x = pk2(v0[0], v0[1]); w.y = pk2(v0[2], v0[3]); w.z = pk2(v1[0], v1[1]); w.w = pk2(v1[2], v1[3]);
                    __builtin_nontemporal_store(w, (u32x4*)(rowp + bj * HALF)); } }
    }
};
template <int MODE> struct EpiY {
    static constexpr bool PERM = true;
    bf16_t* Y; const bf16_t* G;
    __device__ __forceinline__ void operator()(f32x4 (&acc)[2][2][4][2], const Unit& u, int wr, int wc, int fr, int fq) const {
        const int row0 = u.pm * BM + wr * 64 + fr; const int col0 = u.pn * BM + wc * 32 + 8 * fq;
#pragma unroll
        for (int ai = 0; ai < 2; ++ai) {
            u32x4 gv[4][2], yo[4][2];
#pragma unroll
            for (int m = 0; m < 4; ++m)
#pragma unroll
                for (int bj = 0; bj < 2; ++bj) { const size_t row = (size_t)(row0 + ai * HALF + m * 16); const int col = col0 + bj * HALF;
                    gv[m][bj] = __builtin_nontemporal_load((const u32x4*)(G + row * NP + col)); if (MODE == 1) yo[m][bj] = *(const u32x4*)(Y + row * DM + col); }
            asm volatile("" ::: "memory");
#pragma unroll
            for (int m = 0; m < 4; ++m)
#pragma unroll
                for (int bj = 0; bj < 2; ++bj) { const size_t row = (size_t)(row0 + ai * HALF + m * 16); const int col = col0 + bj * HALF;
                    const f32x4 a0 = acc[ai][bj][m][0], a1 = acc[ai][bj][m][1]; float gsg[8], r[8]; unpack8(gv[m][bj], gsg);
#pragma unroll
                    for (int e = 0; e < 4; ++e) { r[e] = sigmoidf_(gsg[e]) * a0[e]; r[4 + e] = sigmoidf_(gsg[4 + e]) * a1[e]; }
                    if (MODE == 1) { float yv[8]; unpack8(yo[m][bj], yv);
#pragma unroll
                        for (int e = 0; e < 8; ++e) r[e] += yv[e]; }
                    *(u32x4*)(Y + row * DM + col) = pack8(r); }
            asm volatile("" ::: "memory");
        }
    }
};
template <int XBF> struct EpiRes {
    static constexpr bool PERM = true;
    const void* X; const float* gmod; bf16_t* Z;
    __device__ __forceinline__ void operator()(f32x4 (&acc)[2][2][4][2], const Unit& u, int wr, int wc, int fr, int fq) const {
        const int row0 = u.pm * BM + wr * 64 + fr; const int col0 = u.pn * BM + wc * 32 + 8 * fq; const int b = (u.pm * BM) >> 11;
        f32x4 gv[2][2];
#pragma unroll
        for (int bj = 0; bj < 2; ++bj)
#pragma unroll
            for (int n = 0; n < 2; ++n) gv[bj][n] = *(const f32x4*)(gmod + (size_t)b * 6144 + col0 + bj * HALF + n * 4);
#pragma unroll
        for (int ai = 0; ai < 2; ++ai) {
            f32x4 xv[4][2][2];
#pragma unroll
            for (int m = 0; m < 4; ++m)
#pragma unroll
                for (int bj = 0; bj < 2; ++bj) { const size_t off = (size_t)(row0 + ai * HALF + m * 16) * DM + col0 + bj * HALF;
                    if (XBF) { const u32x4 w = *(const u32x4*)((const bf16_t*)X + off); xv[m][bj][0] = (f32x4){bflo(w.x), bfhi(w.x), bflo(w.y), bfhi(w.y)}; xv[m][bj][1] = (f32x4){bflo(w.z), bfhi(w.z), bflo(w.w), bfhi(w.w)}; }
                    else { xv[m][bj][0] = __builtin_nontemporal_load((const f32x4*)((const float*)X + off)); xv[m][bj][1] = __builtin_nontemporal_load((const f32x4*)((const float*)X + off + 4)); } }
            asm volatile("" ::: "memory");
#pragma unroll
            for (int m = 0; m < 4; ++m)
#pragma unroll
                for (int bj = 0; bj < 2; ++bj) { const size_t off = (size_t)(row0 + ai * HALF + m * 16) * DM + col0 + bj * HALF;
                    const f32x4 o0 = xv[m][bj][0] * ALPHA + gv[bj][0] * acc[ai][bj][m][0], o1 = xv[m][bj][1] * ALPHA + gv[bj][1] * acc[ai][bj][m][1];
                    u32x4 w; w.x = pk2(o0[0], o0[1]); w.y = pk2(o0[2], o0[3]); w.z = pk2(o1[0], o1[1]); w.w = pk2(o1[2], o1[3]);
                    *(u32x4*)(Z + off) = w; }
            asm volatile("" ::: "memory");
        }
    }
};
struct EpiSwiglu {
    static constexpr bool PERM = true;
    bf16_t* O;
    __device__ __forceinline__ void operator()(f32x4 (&acc)[2][2][4][2], const Unit& u, int wr, int wc, int fr, int fq) const {
        const int row0 = u.pm * BM + wr * 64 + fr; const int col0 = u.pn * HALF + wc * 32 + 8 * fq;
#pragma unroll
        for (int ai = 0; ai < 2; ++ai)
#pragma unroll
            for (int m = 0; m < 4; ++m) { bf16_t* rowp = O + (size_t)(row0 + ai * HALF + m * 16) * DFF + col0;
                const f32x4 g0 = acc[ai][0][m][0], g1 = acc[ai][0][m][1], u0 = acc[ai][1][m][0], u1 = acc[ai][1][m][1];
                float r[8];
#pragma unroll
                for (int e = 0; e < 4; ++e) { r[e] = g0[e] * sigmoidf_(g0[e]) * u0[e]; r[4 + e] = g1[e] * sigmoidf_(g1[e]) * u1[e]; }
                u32x4 w; w.x = pk2(r[0], r[1]); w.y = pk2(r[2], r[3]); w.z = pk2(r[4], r[5]); w.w = pk2(r[6], r[7]);
                __builtin_nontemporal_store(w, (u32x4*)rowp); }
    }
};

struct PanelStats {
    unsigned long long* xbuf;
    unsigned* cnt;
    LAS unsigned char* scr;
    __device__ __forceinline__ void run(const f32x4 (&v)[2][2][4][2], const Unit& u, int wr, int wc, int fr, int fq) const {
        const int lane = threadIdx.x & 63, wid = __builtin_amdgcn_readfirstlane(threadIdx.x >> 6);
        LAS f32x2* P = (LAS f32x2*)scr;
        LAS f32x2* S = (LAS f32x2*)(scr + 8192);
#pragma unroll
        for (int ai = 0; ai < 2; ++ai)
#pragma unroll
            for (int m = 0; m < 4; ++m) {
                float s = 0.f;
#pragma unroll
                for (int bj = 0; bj < 2; ++bj)
#pragma unroll
                    for (int n = 0; n < 2; ++n) { const f32x4 x = v[ai][bj][m][n]; s += (x[0] + x[1]) + (x[2] + x[3]); }
                s += __shfl_xor(s, 16); s += __shfl_xor(s, 32);
                const float mw = s * (1.0f / 64.0f); float q = 0.f;
#pragma unroll
                for (int bj = 0; bj < 2; ++bj)
#pragma unroll
                    for (int n = 0; n < 2; ++n) { const f32x4 d = v[ai][bj][m][n] - mw; q += (d[0] * d[0] + d[1] * d[1]) + (d[2] * d[2] + d[3] * d[3]); }
                q += __shfl_xor(q, 16); q += __shfl_xor(q, 32);
                if (fq == 0) P[(ai * HALF + wr * 64 + m * 16 + fr) * 4 + wc] = (f32x2){mw, q};
            }
        asm volatile("s_waitcnt lgkmcnt(0)" ::: "memory"); __builtin_amdgcn_s_barrier(); asm volatile("" ::: "memory");
        const int row = wid * 32 + (lane & 31);
        if (lane < 32) {
            const f32x2 a = P[row * 4 + 0], b = P[row * 4 + 1], c = P[row * 4 + 2], d = P[row * 4 + 3];
            const float mt = (a.x + b.x + c.x + d.x) * 0.25f;
            const float da = a.x - mt, db = b.x - mt, dc = c.x - mt, dd = d.x - mt;
            const float m2 = (a.y + b.y) + (c.y + d.y) + 64.0f * ((da * da + db * db) + (dc * dc + dd * dd));
            unsigned long long* slot = xbuf + ((size_t)(u.pm * BM + row) * 4 + u.pn);
            __hip_atomic_store(slot, ((unsigned long long)__float_as_uint(m2) << 32) | __float_as_uint(mt), __ATOMIC_RELAXED, __HIP_MEMORY_SCOPE_AGENT);
        }
        asm volatile("s_waitcnt vmcnt(0)" ::: "memory");
        if (lane == 0) __hip_atomic_fetch_add(cnt + 64 * u.pm, 1u, __ATOMIC_RELAXED, __HIP_MEMORY_SCOPE_AGENT);
        if (wid == 0) {
            unsigned sp = 0;
            for (;;) {
                if ((unsigned)__builtin_amdgcn_readfirstlane(__hip_atomic_load(cnt + 64 * u.pm, __ATOMIC_RELAXED, __HIP_MEMORY_SCOPE_AGENT)) >= 32u) break;
                if (++sp > (1u << 24)) break;
                __builtin_amdgcn_s_sleep(2);
            }
            __builtin_amdgcn_fence(__ATOMIC_ACQUIRE, "agent");
        }
        asm volatile("s_waitcnt vmcnt(0) lgkmcnt(0)" ::: "memory"); __builtin_amdgcn_s_barrier(); asm volatile("" ::: "memory");
        if (lane < 32) {
            const unsigned long long* slot = xbuf + (size_t)(u.pm * BM + row) * 4; float mt[4], m2[4]; float ms = 0.f;
#pragma unroll
            for (int t = 0; t < 4; ++t) { const unsigned long long w = __hip_atomic_load(slot + t, __ATOMIC_RELAXED, __HIP_MEMORY_SCOPE_AGENT); mt[t] = __uint_as_float((unsigned)w); m2[t] = __uint_as_float((unsigned)(w >> 32)); ms += mt[t]; }
            const float mean = ms * 0.25f; float q = 0.f;
#pragma unroll
            for (int t = 0; t < 4; ++t) { const float dm = mt[t] - mean; q += m2[t] + 256.0f * dm * dm; }
            S[row] = (f32x2){mean, 1.0f / sqrtf(q * (1.0f / 1024.0f) + LN_EPS)};
        }
        asm volatile("s_waitcnt lgkmcnt(0)" ::: "memory"); __builtin_amdgcn_s_barrier(); asm volatile("" ::: "memory");
    }
};
__device__ __forceinline__ const char* uptr(const void* p) { const unsigned long long v = (unsigned long long)p;
    const unsigned lo = __builtin_amdgcn_readfirstlane((unsigned)v), hi = __builtin_amdgcn_readfirstlane((unsigned)(v >> 32)); return (const char*)(((unsigned long long)hi << 32) | lo); }
__device__ __forceinline__ f32x4 ld4bf(const bf16_t* p) { const u32x2 w = __builtin_nontemporal_load((const u32x2*)p); return (f32x4){bflo(w.x), bfhi(w.x), bflo(w.y), bfhi(w.y)}; }
#define EPI_FOR4 _Pragma("unroll") for (int bj = 0; bj < 2; ++bj) _Pragma("unroll") for (int n = 0; n < 2; ++n)
#define EPI_ROWS _Pragma("unroll") for (int ai = 0; ai < 2; ++ai) _Pragma("unroll") for (int m = 0; m < 4; ++m)
struct EpiLnOut {
    static constexpr bool PERM = false;
    const bf16_t* X1; const float* gmod; const float* lg; const float* lb; float* OUT; PanelStats st;
    __device__ __forceinline__ void operator()(f32x4 (&acc)[2][2][4][2], const Unit& u, int wr, int wc, int fr, int fq) const {
        const int b = (u.pm * BM) >> 11; const unsigned loff = (unsigned)(fr * DM + 4 * fq), coff = 4 * fq;
        const size_t ub = (size_t)(u.pm * BM + wr * 64) * DM + u.pn * BM + wc * 32; const int cb = u.pn * BM + wc * 32;
        const float* gm = gmod + (size_t)b * 6144 + cb;
        EPI_FOR4 { const f32x4 gv = *(const f32x4*)(gm + (bj * HALF + n * 16) + coff);
            EPI_ROWS { const f32x4 xv = ld4bf(X1 + (ub + (size_t)((ai * HALF + m * 16) * DM + bj * HALF + n * 16)) + loff);
                acc[ai][bj][m][n] = xv * ALPHA + gv * acc[ai][bj][m][n]; }
            asm volatile("" ::: "memory"); __builtin_amdgcn_sched_barrier(0); }
        st.run(acc, u, wr, wc, fr, fq);
        const LAS f32x2* S = (const LAS f32x2*)(st.scr + 8192) + (wr * 64 + fr);
        EPI_FOR4 { const f32x4 g4 = *(const f32x4*)(lg + (cb + bj * HALF + n * 16) + coff), b4 = *(const f32x4*)(lb + (cb + bj * HALF + n * 16) + coff);
            EPI_ROWS { const f32x2 sr = S[ai * HALF + m * 16];
                __builtin_nontemporal_store((f32x4)((acc[ai][bj][m][n] - sr.x) * sr.y * g4 + b4), (f32x4*)(OUT + (ub + (size_t)((ai * HALF + m * 16) * DM + bj * HALF + n * 16)) + loff)); }
            asm volatile("" ::: "memory"); __builtin_amdgcn_sched_barrier(0); }
    }
};
struct EpiLnMid {
    static constexpr bool PERM = false;
    const float* X; const float* lg; const float* lb; unsigned char* wsb; bf16_t* H2; LAS unsigned char* scr;
    __device__ __forceinline__ void operator()(f32x4 (&acc)[2][2][4][2], const Unit& u, int wr, int wc, int fr, int fq) const {
        const int b = (u.pm * BM) >> 11; const unsigned loff = (unsigned)(fr * DM + 4 * fq), coff = 4 * fq;
        const size_t ub = (size_t)(u.pm * BM + wr * 64) * DM + u.pn * BM + wc * 32; const int cb = u.pn * BM + wc * 32;
        const float* modb = (const float*)(wsb + WS_MOD) + (size_t)b * 6144 + cb; bf16_t* X1 = (bf16_t*)(wsb + WS_X1);
        const PanelStats st1{(unsigned long long*)(wsb + WS_XB1), (unsigned*)(wsb + WS_CNT), scr}, st2{(unsigned long long*)(wsb + WS_XB2), (unsigned*)(wsb + WS_CNT + 32768), scr};
        EPI_FOR4 { const f32x4 gv = *(const f32x4*)(modb + (2048 + bj * HALF + n * 16) + coff);
            EPI_ROWS { const f32x4 xv = *(const f32x4*)(X + (ub + (size_t)((ai * HALF + m * 16) * DM + bj * HALF + n * 16)) + loff);
                acc[ai][bj][m][n] = xv * ALPHA + gv * acc[ai][bj][m][n]; if (m & 1) asm volatile("" ::: "memory"); __builtin_amdgcn_sched_barrier(0); }
            asm volatile("" ::: "memory"); __builtin_amdgcn_sched_barrier(0); }
        st1.run(acc, u, wr, wc, fr, fq);
        { const LAS f32x2* S = (const LAS f32x2*)(st1.scr + 8192) + (wr * 64 + fr);
        EPI_FOR4 { const f32x4 g4 = *(const f32x4*)(lg + (cb + bj * HALF + n * 16) + coff), b4 = *(const f32x4*)(lb + (cb + bj * HALF + n * 16) + coff);
            EPI_ROWS { const f32x2 sr = S[ai * HALF + m * 16];
                const f32x4 o = (acc[ai][bj][m][n] - sr.x) * sr.y * g4 + b4; acc[ai][bj][m][n] = o;
                u32x2 w; w.x = pk2(o[0], o[1]); w.y = pk2(o[2], o[3]);
                *(u32x2*)(X1 + (ub + (size_t)((ai * HALF + m * 16) * DM + bj * HALF + n * 16)) + loff) = w; }
            asm volatile("" ::: "memory"); __builtin_amdgcn_sched_barrier(0); } }
        st2.run(acc, u, wr, wc, fr, fq);
        { const LAS f32x2* S = (const LAS f32x2*)(st2.scr + 8192) + (wr * 64 + fr);
        EPI_FOR4 { const f32x4 sh = *(const f32x4*)(modb + (3072 + bj * HALF + n * 16) + coff), sc = *(const f32x4*)(modb + (4096 + bj * HALF + n * 16) + coff) + 1.0f;
            EPI_ROWS { const f32x2 sr = S[ai * HALF + m * 16];
                const f32x4 o = (acc[ai][bj][m][n] - sr.x) * sr.y * sc + sh;
                u32x2 w; w.x = pk2(o[0], o[1]); w.y = pk2(o[2], o[3]);
                *(u32x2*)(H2 + (ub + (size_t)((ai * HALF + m * 16) * DM + bj * HALF + n * 16)) + loff) = w; }
            asm volatile("" ::: "memory"); __builtin_amdgcn_sched_barrier(0); } }
    }
};
#undef EPI_FOR4
#undef EPI_ROWS
}

__device__ __forceinline__ void tr_item(const float* __restrict__ src, int ld, int k0, int c0, bf16_t* dst, int dstK, int r0, LAS float* scr, int lane) {
    f32x4 t[8];
#pragma unroll
    for (int i = 0; i < 8; ++i) t[i] = *(const f32x4*)(src + (size_t)(k0 + 8 * i + (lane >> 3)) * ld + c0 + 4 * (lane & 7));
#pragma unroll
    for (int i = 0; i < 8; ++i) { LAS float* d = scr + (8 * i + (lane >> 3)) * 33 + 4 * (lane & 7); d[0] = t[i][0]; d[1] = t[i][1]; d[2] = t[i][2]; d[3] = t[i][3]; }
    LDS_WAIT();
    const int c = lane & 7;
#pragma unroll
    for (int j = 0; j < 4; ++j) { const int n = (lane >> 3) + 8 * j; const LAS float* s = scr + (8 * c) * 33 + n;
        u32x4 o; o.x = pk2(s[0 * 33], s[1 * 33]); o.y = pk2(s[2 * 33], s[3 * 33]); o.z = pk2(s[4 * 33], s[5 * 33]); o.w = pk2(s[6 * 33], s[7 * 33]);
        *(u32x4*)(dst + (size_t)(r0 + n) * dstK + k0 + 8 * c) = o; }
    LDS_WAIT();
}

__device__ __forceinline__ void split_arrive(unsigned* ctr);
__device__ __forceinline__ void split_wait(unsigned* ctr, unsigned want);
__device__ __forceinline__ void p0_prologue(LAS unsigned char* lds, const float* const* in, unsigned char* ws, unsigned* ctr) {
    const int tid = threadIdx.x, lane = tid & 63, wave = __builtin_amdgcn_readfirstlane(tid >> 6);
    const int G = gridDim.x;
    {
        const float* c = in[1]; const float* w_ada = in[2]; const float* b_ada = in[3]; float* MOD = (float*)(ws + WS_MOD);
        LAS float* sc = (LAS float*)lds; LAS float* red = (LAS float*)(lds + 65536);
        if ((int)blockIdx.x < 192) {
            for (int idx = tid; idx < 16384; idx += 512) { const int b = idx & 15, k = idx >> 4; const float v = c[b * 1024 + k]; sc[k * 16 + b] = v / (1.0f + expf(-v)); }
            __syncthreads();
            for (int item = blockIdx.x; item < 192; item += G) {
                const int e = item * 32 + (lane & 31), kbase = wave * 128 + (lane >> 5) * 64;
                float acc[16];
#pragma unroll
                for (int b = 0; b < 16; ++b) acc[b] = 0.f;
                for (int kk0 = 0; kk0 < 64; kk0 += 16) {
                    float wv[16];
#pragma unroll
                    for (int i = 0; i < 16; ++i) wv[i] = w_ada[(size_t)(kbase + kk0 + i) * 6144 + e];
#pragma unroll
                    for (int i = 0; i < 16; ++i) { const int k = kbase + kk0 + i; const float w = wv[i];
                        const LAS f32x4* s = (const LAS f32x4*)(sc + k * 16);
#pragma unroll
                        for (int q = 0; q < 4; ++q) { const f32x4 sv = s[q]; acc[4 * q + 0] += sv[0] * w; acc[4 * q + 1] += sv[1] * w; acc[4 * q + 2] += sv[2] * w; acc[4 * q + 3] += sv[3] * w; } } }
#pragma unroll
                for (int b = 0; b < 16; ++b) { acc[b] += __shfl_xor(acc[b], 32); if (lane < 32) red[(wave * 16 + b) * 32 + lane] = acc[b]; }
                __syncthreads();
                { const int b = tid >> 5, col = tid & 31; float s = 0.f;
#pragma unroll
                  for (int w = 0; w < 8; ++w) s += red[(w * 16 + b) * 32 + col];
                  MOD[b * 6144 + item * 32 + col] = s + b_ada[item * 32 + col]; }
                __syncthreads();
            }
        }
        __syncthreads();
    }
    {
        const float* w_in = in[4]; const float* b_in = in[5]; float* WG = (float*)(ws + WS_WG); float* BG = (float*)(ws + WS_BG);
        for (int idx = blockIdx.x * 512 + tid; idx < 16384; idx += G * 512) { const int j = idx >> 10, k = idx & 1023;
            const int col = j < 8 ? 1536 + j : (j < 12 ? 3592 + (j - 8) : 3596 + (j - 12));
            WG[idx] = w_in[(size_t)k * DIN + col]; if (k == 0) BG[j] = b_in[col]; }
    }
    split_arrive(ctr);
    {
        LAS float* scr = (LAS float*)(lds + wave * 16384);
        const int gw = blockIdx.x * 8 + wave, NGW = G * 8;
        constexpr int NITEMS = 3328 + 128 + 256 + 512 + 512 + 2816 + 1408;
        for (int it = gw; it < NITEMS; it += NGW) {
            int r = it; const float* src; int ld, k0, c0, dstK, r0; bf16_t* dst;
            if (r < 3328) { const int kb = r / 208, nb = r % 208, n0 = nb * 32; src = in[4]; ld = DIN; k0 = kb * 64; c0 = n0 + (n0 >= 1536 ? 8 : 0) + (n0 >= 3584 ? 8 : 0); dst = (bf16_t*)(ws + WS_WT_IN); dstK = 1024; r0 = n0; }
            else if ((r -= 3328) < 128) { const int sj = r >> 4, q = r & 15, h = sj >> 1, which = sj & 1, kb = q >> 2, nb = q & 3; src = (which ? in[9] : in[8]) + (size_t)h * 256 * 128; ld = 128; k0 = kb * 64; c0 = nb * 32; dst = (bf16_t*)(ws + WS_WT_QK); dstK = 256; r0 = h * 256 + which * 128 + nb * 32; }
            else if ((r -= 128) < 256) { const int kb = r >> 5, nb = r & 31; src = in[11]; ld = 1024; k0 = kb * 64; c0 = nb * 32; dst = (bf16_t*)(ws + WS_WT_PA); dstK = 512; r0 = nb * 32; }
            else if ((r -= 256) < 512) { const int kb = r >> 5, nb = r & 31; src = in[12]; ld = 1024; k0 = kb * 64; c0 = nb * 32; dst = (bf16_t*)(ws + WS_WT_PB); dstK = 1024; r0 = nb * 32; }
            else if ((r -= 512) < 512) { const int kb = r >> 5, nb = r & 31; src = in[13]; ld = 1024; k0 = kb * 64; c0 = nb * 32; dst = (bf16_t*)(ws + WS_WT_OUT); dstK = 1024; r0 = nb * 32; }
            else if ((r -= 512) < 2816) { const int kb = r / 176, nb = r % 176, n0 = nb * 32, pn = n0 >> 8, hh = (n0 & 255) >> 7, j = n0 & 127; src = in[16]; ld = 2 * DFF; k0 = kb * 64; c0 = hh * DFF + 128 * pn + j; dst = (bf16_t*)(ws + WS_WT_FI); dstK = 1024; r0 = n0; }
            else { r -= 2816; const int kb = r >> 5, nb = r & 31; src = in[17]; ld = 1024; k0 = kb * 64; c0 = nb * 32; dst = (bf16_t*)(ws + WS_WT_FD); dstK = DFF; r0 = nb * 32; }
            tr_item(src, ld, k0, c0, dst, dstK, r0, scr, lane);
        }
    }
    split_wait(ctr, gridDim.x);
}

__device__ __forceinline__ void p1_ln_gates(LAS unsigned char* lds, const float* x, const float* MOD, const float* WG, const float* BG, bf16_t* H1, float* G16) {
    const int tid = threadIdx.x, lane = tid & 63, wave = __builtin_amdgcn_readfirstlane(tid >> 6);
    LAS f32x4* WGl = (LAS f32x4*)lds;
    for (int idx = tid; idx < 4096; idx += 512) WGl[idx] = ((const f32x4*)WG)[idx];
    __syncthreads();
    for (int rp = blockIdx.x * 8 + wave; rp < MT / 2; rp += gridDim.x * 8) {
        const int r0 = 2 * rp, b = r0 >> 11;
        f32x4 v[2][4], shv[4], scv[4];
#pragma unroll
        for (int r = 0; r < 2; ++r)
#pragma unroll
            for (int j = 0; j < 4; ++j) v[r][j] = __builtin_nontemporal_load((const f32x4*)(x + (size_t)(r0 + r) * DM + 4 * lane + 256 * j));
#pragma unroll
        for (int j = 0; j < 4; ++j) { shv[j] = *(const f32x4*)(MOD + (size_t)b * 6144 + 4 * lane + 256 * j); scv[j] = *(const f32x4*)(MOD + (size_t)b * 6144 + 1024 + 4 * lane + 256 * j) + 1.0f; }
        asm volatile("" ::: "memory");
#pragma unroll
        for (int r = 0; r < 2; ++r) {
            float s = 0.f;
#pragma unroll
            for (int j = 0; j < 4; ++j) s += (v[r][j][0] + v[r][j][1]) + (v[r][j][2] + v[r][j][3]);
            const float mean = wave_sum(s) * (1.f / DM); float s2 = 0.f;
#pragma unroll
            for (int j = 0; j < 4; ++j) { v[r][j] = v[r][j] - mean; s2 += (v[r][j][0] * v[r][j][0] + v[r][j][1] * v[r][j][1]) + (v[r][j][2] * v[r][j][2] + v[r][j][3] * v[r][j][3]); }
            const float rstd = 1.f / sqrtf(wave_sum(s2) * (1.f / DM) + LN_EPS);
#pragma unroll
            for (int j = 0; j < 4; ++j) {
                v[r][j] = v[r][j] * rstd * scv[j] + shv[j];
                u32x2 o; o.x = pk2(v[r][j][0], v[r][j][1]); o.y = pk2(v[r][j][2], v[r][j][3]);
                *(u32x2*)(H1 + (size_t)(r0 + r) * DM + 4 * lane + 256 * j) = o; }
        }
        float vals[32];
#pragma unroll
        for (int j16 = 0; j16 < 16; ++j16) { float p0 = 0.f, p1 = 0.f;
#pragma unroll
            for (int q = 0; q < 4; ++q) { const f32x4 w = WGl[j16 * 256 + lane + 64 * q];
                p0 += (v[0][q][0] * w[0] + v[0][q][1] * w[1]) + (v[0][q][2] * w[2] + v[0][q][3] * w[3]);
                p1 += (v[1][q][0] * w[0] + v[1][q][1] * w[1]) + (v[1][q][2] * w[2] + v[1][q][3] * w[3]); }
            vals[j16] = p0; vals[16 + j16] = p1; asm volatile("" ::: "memory"); }
#define BFLY(N, MASK) { const bool up = (lane & MASK) != 0; _Pragma("unroll") for (int i = 0; i < N; ++i) { const float lo = vals[i], hi = vals[i + N]; const float send = up ? lo : hi, keep = up ? hi : lo; vals[i] = keep + __shfl_xor(send, MASK); } }
        BFLY(16, 32) BFLY(8, 16) BFLY(4, 8) BFLY(2, 4) BFLY(1, 2)
#undef BFLY
        const float tot = vals[0] + __shfl_xor(vals[0], 1);
        const int idx = lane >> 1;
        if (!(lane & 1)) G16[(size_t)(r0 + (idx >> 4)) * 16 + (idx & 15)] = tot + BG[idx & 15];
    }
}

__device__ __forceinline__ void fscan(LAS unsigned char* lds, const float* G16, float* FCUM) {
    const int tid = threadIdx.x, lane = tid & 63, wave = __builtin_amdgcn_readfirstlane(tid >> 6);
    LAS float* wsum = (LAS float*)lds;
    for (int s = blockIdx.x; s < 128; s += gridDim.x) {
        const int b = s >> 3, hh = s & 7;
        float v[4];
#pragma unroll
        for (int i = 0; i < 4; ++i) v[i] = logsig(G16[(size_t)(b * SEQ + 4 * tid + i) * 16 + hh]) * LOG2E;
        v[1] += v[0]; v[2] += v[1]; v[3] += v[2];
        const float tot = v[3]; float sc = tot;
#pragma unroll
        for (int o = 1; o < 64; o <<= 1) { const float y = __shfl_up(sc, o); if (lane >= o) sc += y; }
        if (lane == 63) wsum[wave] = sc;
        __syncthreads();
        float off = 0.f;
        for (int w = 0; w < wave; ++w) off += wsum[w];
        const float excl = off + sc - tot;
#pragma unroll
        for (int i = 0; i < 4; ++i) FCUM[(size_t)s * SEQ + 4 * tid + i] = v[i] + excl;
        __syncthreads();
    }
}

__device__ __forceinline__ void conv_phase(const bf16_t* PROJ, const float* conv_w, const float* conv_b, bf16_t* U) {
    const int tid = threadIdx.x, lane = tid & 63, wave = __builtin_amdgcn_readfirstlane(tid >> 6);
    const int gw = blockIdx.x * 8 + wave, NGW = gridDim.x * 8;
    for (int it = gw; it < 4096; it += NGW) {
        const int rg = it >> 1, chf = it & 1, m0 = rg * 16, c = chf * 512 + lane * 8;
        float w[4][8], cb[8];
#pragma unroll
        for (int j = 0; j < 4; ++j) { const f32x4 a = *(const f32x4*)(conv_w + j * 1024 + c), bq = *(const f32x4*)(conv_w + j * 1024 + c + 4);
            w[j][0] = a[0]; w[j][1] = a[1]; w[j][2] = a[2]; w[j][3] = a[3]; w[j][4] = bq[0]; w[j][5] = bq[1]; w[j][6] = bq[2]; w[j][7] = bq[3]; }
        { const f32x4 a = *(const f32x4*)(conv_b + c), bq = *(const f32x4*)(conv_b + c + 4); cb[0] = a[0]; cb[1] = a[1]; cb[2] = a[2]; cb[3] = a[3]; cb[4] = bq[0]; cb[5] = bq[1]; cb[6] = bq[2]; cb[7] = bq[3]; }
        const bool has_prev = (m0 & (SEQ - 1)) != 0;
        u32x4 raw[19];
#pragma unroll
        for (int j = 0; j < 3; ++j) { raw[j] = (u32x4){0u, 0u, 0u, 0u}; if (has_prev) raw[j] = __builtin_nontemporal_load((const u32x4*)(PROJ + (size_t)(m0 - 3 + j) * NP + C_MU + c)); }
#pragma unroll
        for (int r = 0; r < 16; ++r) raw[3 + r] = __builtin_nontemporal_load((const u32x4*)(PROJ + (size_t)(m0 + r) * NP + C_MU + c));
#pragma unroll
        for (int r = 0; r < 16; ++r) {
            float x0[8], x1[8], x2[8], x3[8]; unpack8(raw[r], x0); unpack8(raw[r + 1], x1); unpack8(raw[r + 2], x2); unpack8(raw[r + 3], x3);
            float y[8];
#pragma unroll
            for (int e = 0; e < 8; ++e) { const float t = w[0][e] * x0[e] + w[1][e] * x1[e] + w[2][e] * x2[e] + w[3][e] * x3[e] + cb[e]; y[e] = t * sigmoidf_(t); }
            *(u32x4*)(U + (size_t)(m0 + r) * DM + c) = pack8(y);
        }
    }
}


namespace fox_attn {
using bf16=__hip_bfloat16;
using bf16x8=__attribute__((ext_vector_type(8)))short;
using s16x4=__attribute__((ext_vector_type(4)))short;
using f32x16=__attribute__((ext_vector_type(16)))float;
using u32x4=__attribute__((ext_vector_type(4)))unsigned;
using f32x4v=__attribute__((ext_vector_type(4)))float;
constexpr int BATCH=16,NHEAD=8,SEQ=2048,D=64,DM=6656,OP=512;
constexpr int NW=8,QBLK=32,QB=QBLK*NW,KVBLK=64,NQB=SEQ/QB;
constexpr int ATTN_UNIT_ROWS=QB;
__device__ __forceinline__ int crow(int r,int hi){return (r&3)+8*(r>>2)+4*hi;}
#define SBAR() __builtin_amdgcn_sched_barrier(0)
__device__ __forceinline__ void cmask(f32x16&p0,f32x16&p1,int jb,int qrel,int hi){
  const float NEG=-INFINITY; int kb=64*jb+4*hi;
  #pragma unroll
  for(int r=0;r<16;++r){int kv=kb+(r&3)+8*(r>>2); if(kv>qrel)p0[r]=NEG; if(kv+32>qrel)p1[r]=NEG;}
}

constexpr int NSLOT=3, SLOTB=8192;
constexpr int LDS_K=0, LDS_V=NSLOT*SLOTB, LDS_WS=2*NSLOT*SLOTB, LDS_OST=LDS_WS+NW*64*4, LDS_BYTES=LDS_OST+NW*4096;
constexpr float C2=0.125f*1.4426950408889634f;
__device__ __forceinline__ void glds16(const void*gsrc,unsigned lds_dst){unsigned keep;
  asm volatile("s_mov_b32 %0, m0\n\ts_mov_b32 m0, %2\n\ts_nop 0\n\tglobal_load_lds_dwordx4 %1, off\n\ts_mov_b32 m0, %0":"=&s"(keep):"v"(gsrc),"s"(lds_dst):"memory");}
__device__ __forceinline__ float max3f(float a,float b,float c){float r;asm("v_max3_f32 %0, %1, %2, %3":"=v"(r):"v"(a),"v"(b),"v"(c));return r;}
__device__ __forceinline__ float max2f(float a,float b){float r;asm("v_max_f32_e32 %0, %1, %2":"=v"(r):"v"(a),"v"(b));return r;}
__device__ __forceinline__ float fadd_s(float a,float b){float r;asm("v_add_f32_e32 %0, %1, %2":"=v"(r):"v"(a),"v"(b));return r;}
__device__ __forceinline__ float fsub_s(float a,float b){float r;asm("v_sub_f32_e32 %0, %1, %2":"=v"(r):"v"(a),"v"(b));return r;}
typedef float f32x2_t __attribute__((ext_vector_type(2))); typedef __bf16 bf16x2_t __attribute__((ext_vector_type(2)));
__device__ __forceinline__ unsigned cvtpk_s(float lo,float hi){f32x2_t v={lo,hi};bf16x2_t b=__builtin_convertvector(v,bf16x2_t);return __builtin_bit_cast(unsigned,b);}
#define WAIT_BAR(N) asm volatile("s_waitcnt vmcnt(" #N ") lgkmcnt(0)\n\ts_barrier":::"memory")

__device__ __forceinline__ void qkt(f32x16&p0,f32x16&p1,const char*Kslot,const bf16x8*qr,const f32x16&negm,int r32,int hi){
  const char*kb=Kslot+hi*1024+r32*16;
  #pragma unroll
  for(int d0=0;d0<4;++d0){
    const bf16x8 b0=*reinterpret_cast<const bf16x8*>(kb+d0*2048);
    const bf16x8 b1=*reinterpret_cast<const bf16x8*>(kb+d0*2048+512);
    if(d0==0){p0=__builtin_amdgcn_mfma_f32_32x32x16_bf16(b0,qr[0],negm,0,0,0);p1=__builtin_amdgcn_mfma_f32_32x32x16_bf16(b1,qr[0],negm,0,0,0);}
    else{p0=__builtin_amdgcn_mfma_f32_32x32x16_bf16(b0,qr[d0],p0,0,0,0);p1=__builtin_amdgcn_mfma_f32_32x32x16_bf16(b1,qr[d0],p1,0,0,0);}}
}
typedef __attribute__((address_space(3))) const char* lds_cptr;
typedef short v4i16_t __attribute__((ext_vector_type(4)));
__device__ __forceinline__ void kload8(bf16x8*kf,lds_cptr kp){
  kf[0]=*(const __attribute__((address_space(3))) bf16x8*)(kp);      kf[1]=*(const __attribute__((address_space(3))) bf16x8*)(kp+512);
  kf[2]=*(const __attribute__((address_space(3))) bf16x8*)(kp+2048); kf[3]=*(const __attribute__((address_space(3))) bf16x8*)(kp+2560);
  kf[4]=*(const __attribute__((address_space(3))) bf16x8*)(kp+4096); kf[5]=*(const __attribute__((address_space(3))) bf16x8*)(kp+4608);
  kf[6]=*(const __attribute__((address_space(3))) bf16x8*)(kp+6144); kf[7]=*(const __attribute__((address_space(3))) bf16x8*)(kp+6656);
}
__device__ __forceinline__ void kload2(bf16x8*kf,lds_cptr kp,int j){ kf[2*j]=*(const __attribute__((address_space(3))) bf16x8*)(kp+j*2048); kf[2*j+1]=*(const __attribute__((address_space(3))) bf16x8*)(kp+j*2048+512); }
__device__ __forceinline__ s16x4 vtr(lds_cptr p){ return __builtin_bit_cast(s16x4,__builtin_amdgcn_ds_read_tr16_b64_v4i16((__attribute__((address_space(3))) v4i16_t*)p)); }
__device__ __forceinline__ float rowmax(const f32x16&p0,const f32x16&p1){
  float a=max3f(p0[0],p0[1],p1[0]),b=max3f(p0[2],p0[3],p1[1]);a=max3f(a,p1[2],p1[3]);
  #pragma unroll
  for(int r=4;r<16;r+=4){a=max3f(a,p0[r],p0[r+1]);b=max3f(b,p0[r+2],p0[r+3]);a=max3f(a,p1[r],p1[r+1]);b=max3f(b,p1[r+2],p1[r+3]);}
  const float m=max2f(a,b);
  auto rr=__builtin_amdgcn_permlane32_swap(__float_as_uint(m),__float_as_uint(m),false,false);
  return max2f(__uint_as_float(rr[0]),__uint_as_float(rr[1]));
}
__device__ __forceinline__ void pv(f32x16*o,int vb,bf16x8 pa0,bf16x8 pa1,bf16x8 pa2,bf16x8 pa3){
  #pragma unroll
  for(int d0=0;d0<2;++d0){s16x4 lo[4],hi[4];
    #pragma unroll
    for(int ks=0;ks<4;++ks){
      asm volatile("ds_read_b64_tr_b16 %0,%1 offset:%c2":"=&v"(lo[ks]):"v"(vb),"i"(d0*4096+ks*1024):"memory");
      asm volatile("ds_read_b64_tr_b16 %0,%1 offset:%c2":"=&v"(hi[ks]):"v"(vb),"i"(d0*4096+ks*1024+512):"memory");}
    asm volatile("s_waitcnt lgkmcnt(0)":::"memory");SBAR();
    #define PK(k) (bf16x8){lo[k][0],lo[k][1],lo[k][2],lo[k][3],hi[k][0],hi[k][1],hi[k][2],hi[k][3]}
    o[d0]=__builtin_amdgcn_mfma_f32_32x32x16_bf16(pa0,PK(0),o[d0],0,0,0);
    o[d0]=__builtin_amdgcn_mfma_f32_32x32x16_bf16(pa1,PK(1),o[d0],0,0,0);
    o[d0]=__builtin_amdgcn_mfma_f32_32x32x16_bf16(pa2,PK(2),o[d0],0,0,0);
    o[d0]=__builtin_amdgcn_mfma_f32_32x32x16_bf16(pa3,PK(3),o[d0],0,0,0);
    #undef PK
  }
}

#ifndef ATTN_STORE16
#define ATTN_STORE16(p,v) (*(u32x4*)(p)=(v))
#endif
template<int THRL> __device__ __forceinline__ void attn_unit(int b,int h,int qb,const bf16*Q,const bf16*__restrict__ K,const bf16*__restrict__ V,bf16*O,const float*__restrict__ Frow,char*shm){
  int tid_=threadIdx.x; asm volatile("":"+v"(tid_));
  const int tid=tid_,lane=tid&63,r32=lane&31,hi=lane>>5; const int wid=__builtin_amdgcn_readfirstlane(tid>>6);
  const long rowbase=(long)b*SEQ; const int q0=qb*QB;
  const bf16*Qw=Q+(rowbase+q0+wid*QBLK)*DM+h*D;
  const bf16*Kh=K+rowbase*DM+h*D,*Vh=V+rowbase*DM+h*D;
  const unsigned lds0=(unsigned)(uintptr_t)shm;
  float*wsf=(float*)(shm+LDS_WS)+wid*64;
  const bf16*ksrc=Kh+(long)lane*DM+wid*8;
  const bf16*vsrc=Vh+(long)(16*(wid&3)+(lane>>2))*DM+(wid>>2)*32+(lane&3)*8;
  const unsigned kdst=lds0+LDS_K+wid*1024, vdst=lds0+LDS_V+wid*1024;
  #define DMA_K(t,slot) glds16(ksrc+(long)(t)*KVBLK*DM,(unsigned)__builtin_amdgcn_readfirstlane(kdst+(slot)))
  #define DMA_V(t,slot) glds16(vsrc+(long)(t)*KVBLK*DM,(unsigned)__builtin_amdgcn_readfirstlane(vdst+(slot)))
  const int vb0=(int)(lds0+LDS_V)+((lane>>4)&1)*32+(lane&3)*8+(4*hi+((lane&15)>>2))*64;
  const char*Kbase=shm+LDS_K; bf16x8 kf[8];
  const lds_cptr shm3=(lds_cptr)shm; const lds_cptr kp0=shm3+LDS_K+hi*1024+r32*16; const lds_cptr vp0=shm3+LDS_V+((lane>>4)&1)*32+(lane&3)*8+(4*hi+((lane&15)>>2))*64;
  const int NT=(q0+QB)/KVBLK;
  float*nfk=(float*)(shm+LDS_BYTES);
  for(int i=tid;i<NT*KVBLK;i+=512)nfk[i]=-Frow[i];
  asm volatile("s_waitcnt vmcnt(0) lgkmcnt(0)\n\ts_barrier":::"memory");
  #define BIAS(P0,P1,t) do{ const float*nb_=nfk+(t)*KVBLK+4*hi; const float mh_=mhat; _Pragma("unroll") for(int r_=0;r_<16;++r_){ P0[r_]+=nb_[(r_&3)+8*(r_>>2)]-mh_; } \
      _Pragma("unroll") for(int r_=0;r_<16;++r_){ P1[r_]+=nb_[(r_&3)+8*(r_>>2)+32]-mh_; } }while(0)
  DMA_K(0,0);DMA_V(0,0);DMA_K(1,SLOTB);
  bf16x8 qr[4];
  #pragma unroll
  for(int d0=0;d0<4;++d0){ const u32x4 qw_=*reinterpret_cast<const u32x4*>(&Qw[(long)r32*DM+d0*16+hi*8]); u32x4 qs_;
    #define QSC(w) cvtpk_s(__uint_as_float((w)<<16)*C2,__uint_as_float((w)&0xffff0000u)*C2)
    qs_.x=QSC(qw_.x);qs_.y=QSC(qw_.y);qs_.z=QSC(qw_.z);qs_.w=QSC(qw_.w);
    #undef QSC
    qr[d0]=__builtin_bit_cast(bf16x8,qs_); }
  float mhat=0.f,l_reg=0.f;f32x16 o[2];o[0]=f32x16{};o[1]=f32x16{};const f32x16 negm=f32x16{};
  const int qrel=wid*QBLK+r32;
  #define CMASK(P0,P1,t) do{int jb_=(t)-(NT-4); if(jb_>=0)cmask(P0,P1,jb_,qrel,hi);}while(0)
  bool resc=false;
  #define START(P0,P1) do{ const float rm=rowmax(P0,P1); resc=false; \
    { const float dl=rm; mhat=fadd_s(mhat,dl); \
      _Pragma("unroll") for(int r=0;r<16;++r){P0[r]=fsub_s(P0[r],dl);P1[r]=fsub_s(P1[r],dl);} \
        } \
    _Pragma("unroll") for(int r=0;r<16;++r)P0[r]=__builtin_amdgcn_exp2f(P0[r]); }while(0)
  #define RESC() do{ if(resc){ asm volatile("s_waitcnt lgkmcnt(0)":::"memory"); \
      _Pragma("unroll") for(int d_=0;d_<2;++d_) _Pragma("unroll") for(int r=0;r<16;++r)o[d_][r]*=wsf[crow(r,hi)]; } }while(0)
  f32x16 pA0,pA1,pB0,pB1;
  int sl_prev=0,sl_cur=0,sl_next=SLOTB;
  #define ROT() do{sl_prev=sl_cur;sl_cur=sl_next;sl_next=(sl_next==(NSLOT-1)*SLOTB)?0:sl_next+SLOTB;}while(0)
  DMA_K(2,2*SLOTB);
  WAIT_BAR(3);
  qkt(pA0,pA1,Kbase,qr,negm,r32,hi);asm volatile("s_nop 15\n\ts_nop 7":"+v"(pA0),"+v"(pA1));BIAS(pA0,pA1,0);CMASK(pA0,pA1,0);
  START(pA0,pA1);
  _Pragma("unroll") for(int r=0;r<16;++r)pA1[r]=__builtin_amdgcn_exp2f(pA1[r]);
  WAIT_BAR(0);
  DMA_K(3,0);DMA_V(1,SLOTB);
  ROT();
  kload8(kf,kp0+sl_cur);
  WAIT_BAR(2);
  s16x4 vlo[8],vhi[8]; u32x4 pw0,pw1,pw2,pw3;
  #define PKW(P,B) cvtpk_s(P[B],P[B+1])
  #define PAF(k) __builtin_bit_cast(bf16x8,pw##k)
  #define VFR(i) (bf16x8){vlo[i][0],vlo[i][1],vlo[i][2],vlo[i][3],vhi[i][0],vhi[i][1],vhi[i][2],vhi[i][3]}
  #define PIN(x) asm volatile("":"+v"(x))
  #define MX3(a,b,c) __builtin_fmaxf(__builtin_fmaxf((a),(b)),(c))
  #define GAPA(MF,A0,A1,A2,A3,W0,W1,PW) do{ MF; sacc+=A0; sacc+=A1; sacc+=A2; sacc+=A3; PIN(sacc); W0; W1; PIN(PW); SBAR(); }while(0)
  #define EX(v) __builtin_amdgcn_exp2f(v)
  #define GAPB(MF,X,B) do{ MF; X[B]=EX(X[B]); X[B+1]=EX(X[B+1]); X[B+2]=EX(X[B+2]); X[B+3]=EX(X[B+3]); PIN(X); SBAR(); }while(0)
  #define VRD(i) do{ vlo[i]=vtr(vp_+(((i)>>2)*4096+((i)&3)*1024)); vhi[i]=vtr(vp_+(((i)>>2)*4096+((i)&3)*1024+512)); }while(0)
  #define KRD(G,j) do{ if(G){ kload2(kf,kp0+sl_next,j); SBAR(); } }while(0)
  #define STEP(C0,C1,P0,P1,t,GK,GV,GL) do{ SBAR(); \
    const lds_cptr vp_=vp0+sl_prev; \
    VRD(0); SBAR(); float sacc=(P0[0]+P0[1]); \
    GAPA(C0=__builtin_amdgcn_mfma_f32_32x32x16_bf16(kf[0],qr[0],negm,0,0,0), P0[2],P0[3],P0[4],P0[5],     pw0[0]=PKW(P0,0), pw0[1]=PKW(P0,2), pw0); \
    VRD(4); SBAR(); GAPA(C1=__builtin_amdgcn_mfma_f32_32x32x16_bf16(kf[1],qr[0],negm,0,0,0), P0[6],P0[7],P0[8],P0[9],     pw0[2]=PKW(P0,4), pw0[3]=PKW(P0,6), pw0); \
    VRD(1); SBAR(); GAPA(C0=__builtin_amdgcn_mfma_f32_32x32x16_bf16(kf[2],qr[1],C0,0,0,0),   P0[10],P0[11],P0[12],P0[13], pw1[0]=PKW(P0,8), pw1[1]=PKW(P0,10), pw1); \
    VRD(5); SBAR(); GAPA(C1=__builtin_amdgcn_mfma_f32_32x32x16_bf16(kf[3],qr[1],C1,0,0,0),   P0[14],P0[15],P1[0],P1[1],   pw1[2]=PKW(P0,12),pw1[3]=PKW(P0,14), pw1); \
    VRD(2); SBAR(); GAPA(C0=__builtin_amdgcn_mfma_f32_32x32x16_bf16(kf[4],qr[2],C0,0,0,0),   P1[2],P1[3],P1[4],P1[5],     pw2[0]=PKW(P1,0), pw2[1]=PKW(P1,2), pw2); \
    VRD(6); SBAR(); GAPA(C1=__builtin_amdgcn_mfma_f32_32x32x16_bf16(kf[5],qr[2],C1,0,0,0),   P1[6],P1[7],P1[8],P1[9],     pw2[2]=PKW(P1,4), pw2[3]=PKW(P1,6), pw2); \
    VRD(3); SBAR(); GAPA(C0=__builtin_amdgcn_mfma_f32_32x32x16_bf16(kf[6],qr[3],C0,0,0,0),   P1[10],P1[11],P1[12],P1[13], pw3[0]=PKW(P1,8), pw3[1]=PKW(P1,10), pw3); \
    VRD(7); SBAR(); GAPA(C1=__builtin_amdgcn_mfma_f32_32x32x16_bf16(kf[7],qr[3],C1,0,0,0),   P1[14],P1[15],0.f,0.f,       pw3[2]=PKW(P1,12),pw3[3]=PKW(P1,14), pw3); \
    l_reg+=sacc; \
    if(GK){DMA_K((t)+3,sl_cur);} if(GV){DMA_V((t)+1,sl_next);} \
    BIAS(C0,C1,t); CMASK(C0,C1,t); \
    { float a=MX3(C0[0],C0[1],C1[0]),b=MX3(C0[2],C0[3],C1[1]); a=MX3(a,C1[2],C1[3]); \
      _Pragma("unroll") for(int r=4;r<16;r+=4){a=MX3(a,C0[r],C0[r+1]);b=MX3(b,C0[r+2],C0[r+3]);a=MX3(a,C1[r],C1[r+1]);b=MX3(b,C1[r+2],C1[r+3]);} \
      float rm=__builtin_fmaxf(a,b); { auto rr=__builtin_amdgcn_permlane32_swap(__float_as_uint(rm),__float_as_uint(rm),false,false); rm=__builtin_fmaxf(__uint_as_float(rr[0]),__uint_as_float(rr[1])); } \
      resc=false; \
      if(__builtin_expect(__any(rm>(float)THRL),0)){ const float dl=__builtin_fmaxf(rm,0.f); mhat+=dl; \
        _Pragma("unroll") for(int r=0;r<16;++r){C0[r]-=dl;C1[r]-=dl;} \
          \
        const float f=__builtin_amdgcn_exp2f(-dl); l_reg*=f; if(hi==0)wsf[r32]=f; resc=true; } } \
    SBAR(); \
    GAPB(o[0]=__builtin_amdgcn_mfma_f32_32x32x16_bf16(PAF(0),VFR(0),o[0],0,0,0), C0,0); \
    GAPB(o[1]=__builtin_amdgcn_mfma_f32_32x32x16_bf16(PAF(0),VFR(4),o[1],0,0,0), C0,4); \
    KRD(GL,0); GAPB(o[0]=__builtin_amdgcn_mfma_f32_32x32x16_bf16(PAF(1),VFR(1),o[0],0,0,0), C0,8); \
    KRD(GL,1); GAPB(o[1]=__builtin_amdgcn_mfma_f32_32x32x16_bf16(PAF(1),VFR(5),o[1],0,0,0), C0,12); \
    KRD(GL,2); GAPB(o[0]=__builtin_amdgcn_mfma_f32_32x32x16_bf16(PAF(2),VFR(2),o[0],0,0,0), C1,0); \
    KRD(GL,3); GAPB(o[1]=__builtin_amdgcn_mfma_f32_32x32x16_bf16(PAF(2),VFR(6),o[1],0,0,0), C1,4); \
    GAPB(o[0]=__builtin_amdgcn_mfma_f32_32x32x16_bf16(PAF(3),VFR(3),o[0],0,0,0), C1,8); \
    GAPB(o[1]=__builtin_amdgcn_mfma_f32_32x32x16_bf16(PAF(3),VFR(7),o[1],0,0,0), C1,12); \
    }while(0)
  int t=1;
  #undef CMASK
  #define CMASK(P0,P1,t) do{}while(0)
  for(;t+5<NT;t+=2){
    STEP(pB0,pB1,pA0,pA1,t,true,true,true);     WAIT_BAR(2); RESC(); ROT();
    STEP(pA0,pA1,pB0,pB1,t+1,true,true,true);   WAIT_BAR(2); RESC(); ROT();
  }
  #undef CMASK
  #define CMASK(P0,P1,t) do{int jb_=(t)-(NT-4); if(jb_>=0)cmask(P0,P1,jb_,qrel,hi);}while(0)
  #define ENDW(tt) do{ if((tt)+3<NT){WAIT_BAR(2);} else if((tt)+2<NT){WAIT_BAR(1);} else {WAIT_BAR(0);} }while(0)
  for(;t+1<NT;t+=2){
    STEP(pB0,pB1,pA0,pA1,t,(t+3<NT),(t+1<NT),(t+1<NT));       ENDW(t);   RESC(); ROT();
    STEP(pA0,pA1,pB0,pB1,t+1,(t+4<NT),(t+2<NT),(t+2<NT));     ENDW(t+1); RESC(); ROT();
  }
  STEP(pB0,pB1,pA0,pA1,NT-1,false,false,false); RESC();
  { float sacc=pB0[0]+pB0[1]; _Pragma("unroll") for(int r=2;r<16;++r)sacc+=pB0[r]; _Pragma("unroll") for(int r=0;r<16;++r)sacc+=pB1[r]; l_reg+=sacc;
    pw0=(u32x4){PKW(pB0,0),PKW(pB0,2),PKW(pB0,4),PKW(pB0,6)};pw1=(u32x4){PKW(pB0,8),PKW(pB0,10),PKW(pB0,12),PKW(pB0,14)};pw2=(u32x4){PKW(pB1,0),PKW(pB1,2),PKW(pB1,4),PKW(pB1,6)};pw3=(u32x4){PKW(pB1,8),PKW(pB1,10),PKW(pB1,12),PKW(pB1,14)};
    SBAR(); pv(o,vb0+sl_cur,PAF(0),PAF(1),PAF(2),PAF(3)); }
  #undef PKW
  #undef PAF
  #undef VFR
  #undef PIN
  #undef MX3
  #undef GAPA
  #undef GAPB
  #undef EX
  #undef VRD
  #undef KRD
  #undef STEP
  #undef ENDW
  {auto rr=__builtin_amdgcn_permlane32_swap(__float_as_uint(l_reg),__float_as_uint(l_reg),false,false);l_reg=__uint_as_float(rr[0])+__uint_as_float(rr[1]);}
  if(hi==0)wsf[32+r32]=l_reg;asm volatile("s_waitcnt lgkmcnt(0)":::"memory");
  float rli[16];
  #pragma unroll
  for(int r=0;r<16;++r)rli[r]=__builtin_amdgcn_rcpf(wsf[32+crow(r,hi)]);
  bf16*Ow=O+(rowbase+q0+wid*QBLK)*OP+h*D;
  { bf16*stg=(bf16*)(shm+LDS_OST)+wid*2048;
    #pragma unroll
    for(int r=0;r<16;++r){const int orow=crow(r,hi);
      #pragma unroll
      for(int d0=0;d0<2;++d0)stg[orow*64+d0*32+r32]=__float2bfloat16(o[d0][r]*rli[r]);}
    asm volatile("s_waitcnt lgkmcnt(0)":::"memory");
    #pragma unroll
    for(int i=0;i<4;++i){const int row=i*8+(lane>>3),ch=lane&7; const u32x4 v=*(const u32x4*)(stg+row*64+ch*8); ATTN_STORE16(Ow+(long)row*OP+ch*8,v);} }
  asm volatile("s_waitcnt lgkmcnt(0)\n\ts_barrier":::"memory");
  #undef BIAS
  #undef DMA_K
  #undef DMA_V
  #undef CMASK
  #undef START
  #undef RESC
  #undef ROT
}
constexpr int ATTN_LDS_BYTES=LDS_BYTES+8192;
#undef SBAR
#undef WAIT_BAR
}

__device__ __forceinline__ void attn_phase_ref(char* shm, const bf16_t* PROJ, const float* FCUM, bf16_t* ATT) {
    const int vblk = (gridDim.x % 8 == 0) ? (int)((blockIdx.x & 7) * (gridDim.x >> 3) + (blockIdx.x >> 3)) : (int)blockIdx.x;
    for (int uid = vblk; uid < 1024; uid += gridDim.x) {
        const int round = uid >> 8, v = uid & 255, bh = v >> 1, par = v & 1, b = bh >> 3, hh = bh & 7;
        const int qb = par ? (round == 0 ? 1 : round == 1 ? 6 : round == 2 ? 3 : 4) : (round == 0 ? 0 : round == 1 ? 7 : round == 2 ? 2 : 5);
        fox_attn::attn_unit<8>(b, hh, qb, (const fox_attn::bf16*)(PROJ + C_FQ), (const fox_attn::bf16*)(PROJ + C_FK), (const fox_attn::bf16*)(PROJ + C_FV), (fox_attn::bf16*)ATT, FCUM + (size_t)bh * SEQ, shm);
    }
}

__device__ __forceinline__ float xmax16(float m) { auto r = __builtin_amdgcn_permlane16_swap(__float_as_uint(m), __float_as_uint(m), false, false); return fmaxf(__uint_as_float(r[0]), __uint_as_float(r[1])); }
__device__ __forceinline__ float xmax32(float m) { auto r = __builtin_amdgcn_permlane32_swap(__float_as_uint(m), __float_as_uint(m), false, false); return fmaxf(__uint_as_float(r[0]), __uint_as_float(r[1])); }
__device__ __forceinline__ float xadd16(float m) { auto r = __builtin_amdgcn_permlane16_swap(__float_as_uint(m), __float_as_uint(m), false, false); return __uint_as_float(r[0]) + __uint_as_float(r[1]); }
__device__ __forceinline__ float xadd32(float m) { auto r = __builtin_amdgcn_permlane32_swap(__float_as_uint(m), __float_as_uint(m), false, false); return __uint_as_float(r[0]) + __uint_as_float(r[1]); }
template <bool MASK> struct BoolC { static constexpr bool value = MASK; };
__device__ __forceinline__ void attn_phase(LAS unsigned char* lds, const bf16_t* PROJ, const float* FCUM, bf16_t* ATT) {
    const int tid = threadIdx.x, lane = tid & 63, wave = __builtin_amdgcn_readfirstlane(tid >> 6);
    const int g = lane >> 4, c16 = lane & 15, q4 = (lane & 15) >> 2, p4 = lane & 3;
    LAS unsigned char* Ks = lds;
    constexpr float C1 = 0.125f * LOG2E;
    const int lrow = tid >> 3, lch = tid & 7;
    const int vblk = (gridDim.x % 8 == 0) ? (int)((blockIdx.x & 7) * (gridDim.x >> 3) + (blockIdx.x >> 3)) : (int)blockIdx.x;
    for (int uid = vblk; uid < 1024; uid += gridDim.x) {
        const int round = uid >> 8, v = uid & 255, bh = v >> 1, par = v & 1, b = bh >> 3, hh = bh & 7;
        const int qb = par ? (round == 0 ? 1 : round == 1 ? 6 : round == 2 ? 3 : 4) : (round == 0 ? 0 : round == 1 ? 7 : round == 2 ? 2 : 5);
        const int q0 = qb * 256, NT = 4 * (qb + 1);
        const size_t rowbase = (size_t)b * SEQ;
        bf16x8 qf[2][2]; float mrun[2], lrun[2]; f32x4 acc[2][4];
#pragma unroll
        for (int qt = 0; qt < 2; ++qt) { const int qr = q0 + 32 * wave + 16 * qt + c16;
#pragma unroll
            for (int kd = 0; kd < 2; ++kd) qf[qt][kd] = *(const bf16x8*)(PROJ + (rowbase + qr) * NP + C_FQ + hh * 64 + 32 * kd + 8 * g);
            mrun[qt] = -1e30f; lrun[qt] = 0.f;
#pragma unroll
            for (int dt = 0; dt < 4; ++dt) acc[qt][dt] = (f32x4){0.f, 0.f, 0.f, 0.f}; }
        u32x4 kreg[2], vreg[2]; float freg[2];
#define ATT_LOAD(tt, S) do { const size_t r_ = rowbase + (size_t)(tt) * 64 + lrow; \
            kreg[S] = *(const u32x4*)(PROJ + r_ * NP + C_FK + hh * 64 + lch * 8); vreg[S] = *(const u32x4*)(PROJ + r_ * NP + C_FV + hh * 64 + lch * 8); \
            freg[S] = FCUM[(size_t)bh * SEQ + (tt) * 64 + (tid & 63)]; } while (0)
#define ATT_STORE(tt, S) do { LAS unsigned char* kb_ = Ks + ((tt) & 1) * 18688; \
            *(LAS u32x4*)(kb_ + lrow * 128 + ((lch ^ ((lrow >> 1) & 7)) * 16)) = kreg[S]; *(LAS u32x4*)(kb_ + 9216 + lrow * 144 + lch * 16) = vreg[S]; if (tid < 64) ((LAS float*)(kb_ + 18432))[tid] = -freg[S]; } while (0)
        ATT_LOAD(0, 0); ATT_LOAD(1, 1);
        LBAR();
        ATT_STORE(0, 0);
        LBAR();
        auto tile = [&](const int t, auto maskc) {
            constexpr bool MASK = decltype(maskc)::value;
            const LAS unsigned char* Kb = Ks + (t & 1) * 18688; const LAS unsigned char* Vb = Kb + 9216; const LAS float* fb = (const LAS float*)(Kb + 18432);
            if (!MASK || 64 * t <= q0 + 32 * wave + 31) {
                f32x4 s[4][2];
#pragma unroll
                for (int kt = 0; kt < 4; ++kt) {
#pragma unroll
                    for (int kd = 0; kd < 2; ++kd) { const bf16x8 kf = *(const LAS bf16x8*)(Kb + (16 * kt + c16) * 128 + (((4 * kd + g) ^ ((c16 >> 1) & 7)) * 16));
#pragma unroll
                        for (int qt = 0; qt < 2; ++qt) s[kt][qt] = __builtin_amdgcn_mfma_f32_16x16x32_bf16(kf, qf[qt][kd], kd == 0 ? (f32x4){0.f, 0.f, 0.f, 0.f} : s[kt][qt], 0, 0, 0); } }
#pragma unroll
                for (int kt = 0; kt < 4; ++kt) { const f32x4 nfk = *(const LAS f32x4*)(fb + 16 * kt + 4 * g);
#pragma unroll
                    for (int qt = 0; qt < 2; ++qt) { s[kt][qt] = s[kt][qt] * C1 + nfk;
                        if (MASK) {
#pragma unroll
                            for (int i = 0; i < 4; ++i) { const int kv = 64 * t + 16 * kt + 4 * g + i, qq = q0 + 32 * wave + 16 * qt + c16; if (kv > qq) s[kt][qt][i] = -1e30f; } } } }
                bf16x8 pf[2][2];
#pragma unroll
                for (int qt = 0; qt < 2; ++qt) {
                    float m0 = fmaxf(fmaxf(s[0][qt][0], s[0][qt][1]), fmaxf(s[0][qt][2], s[0][qt][3]));
#pragma unroll
                    for (int kt = 1; kt < 4; ++kt) { m0 = fmaxf(fmaxf(m0, s[kt][qt][0]), s[kt][qt][1]); m0 = fmaxf(fmaxf(m0, s[kt][qt][2]), s[kt][qt][3]); }
                    m0 = xmax32(xmax16(m0));
                    const float mnew = fmaxf(mrun[qt], m0), corr = __builtin_amdgcn_exp2f(mrun[qt] - mnew);
                    mrun[qt] = mnew;
#pragma unroll
                    for (int dt = 0; dt < 4; ++dt) acc[qt][dt] = acc[qt][dt] * corr;
                    f32x4 ps = (f32x4){0.f, 0.f, 0.f, 0.f};
#pragma unroll
                    for (int kt = 0; kt < 4; ++kt) { const f32x4 d = s[kt][qt] - mnew; f32x4 p;
                        p[0] = __builtin_amdgcn_exp2f(d[0]); p[1] = __builtin_amdgcn_exp2f(d[1]); p[2] = __builtin_amdgcn_exp2f(d[2]); p[3] = __builtin_amdgcn_exp2f(d[3]);
                        ps = ps + p; s[kt][qt] = p; }
                    lrun[qt] = lrun[qt] * corr + ((ps[0] + ps[1]) + (ps[2] + ps[3]));
#pragma unroll
                    for (int ks = 0; ks < 2; ++ks) { u32x4 w; w.x = pk2(s[2 * ks][qt][0], s[2 * ks][qt][1]); w.y = pk2(s[2 * ks][qt][2], s[2 * ks][qt][3]);
                        w.z = pk2(s[2 * ks + 1][qt][0], s[2 * ks + 1][qt][1]); w.w = pk2(s[2 * ks + 1][qt][2], s[2 * ks + 1][qt][3]); pf[qt][ks] = __builtin_bit_cast(bf16x8, w); }
                }
#pragma unroll
                for (int dt = 0; dt < 4; ++dt)
#pragma unroll
                    for (int ks = 0; ks < 2; ++ks) {
                        const s16x4 lo = vtr(Vb + (32 * ks + 4 * g + q4) * 144 + (16 * dt + 4 * p4) * 2), hi = vtr(Vb + (32 * ks + 16 + 4 * g + q4) * 144 + (16 * dt + 4 * p4) * 2);
                        const bf16x8 vf = (bf16x8){lo[0], lo[1], lo[2], lo[3], hi[0], hi[1], hi[2], hi[3]};
#pragma unroll
                        for (int qt = 0; qt < 2; ++qt) acc[qt][dt] = __builtin_amdgcn_mfma_f32_16x16x32_bf16(vf, pf[qt][ks], acc[qt][dt], 0, 0, 0);
                    }
            }
        };
        for (int t0 = 0; t0 < NT; t0 += 2) {
            const bool diag = (t0 >= NT - 4);
            ATT_LOAD(t0 + 2 < NT ? t0 + 2 : NT - 1, 0);
            if (diag) tile(t0, BoolC<true>{}); else tile(t0, BoolC<false>{});
            ATT_STORE(t0 + 1, 1); LBAR();
            ATT_LOAD(t0 + 3 < NT ? t0 + 3 : NT - 1, 1);
            if (diag) tile(t0 + 1, BoolC<true>{}); else tile(t0 + 1, BoolC<false>{});
            if (t0 + 2 < NT) ATT_STORE(t0 + 2, 0);
            LBAR();
        }
#undef ATT_LOAD
#undef ATT_STORE
#pragma unroll
        for (int qt = 0; qt < 2; ++qt) { float lt = xadd32(xadd16(lrun[qt])); const float inv = 1.0f / lt;
            const size_t qr = rowbase + q0 + 32 * wave + 16 * qt + c16;
#pragma unroll
            for (int dt = 0; dt < 4; ++dt) { const f32x4 o = acc[qt][dt] * inv; u32x2 w; w.x = pk2(o[0], o[1]); w.y = pk2(o[2], o[3]);
                *(u32x2*)(ATT + qr * 512 + hh * 64 + 16 * dt + 4 * g) = w; } }
    }
    LBAR();
}

__device__ __forceinline__ void mlstm_phase(LAS unsigned char* lds, const bf16_t* PROJ, const bf16_t* MQK, const float* G16, bf16_t* HRAW) {
    const int tid = threadIdx.x, lane = tid & 63, wave = __builtin_amdgcn_readfirstlane(tid >> 6);
    const int g = lane >> 4, c16 = lane & 15, q4 = (lane & 15) >> 2, p4 = lane & 3;
    LAS unsigned char* Qs = lds; LAS unsigned char* Ks = lds + 17408; LAS unsigned char* Vs = lds + 34816; LAS unsigned char* Vw = lds + 44032; LAS unsigned char* Cbt = lds + 53248;
    LAS float* bb = (LAS float*)(lds + 70656); LAS float* ee = (LAS float*)(lds + 78848); LAS float* cm = (LAS float*)(lds + 87040);
    LAS float* nbuf = (LAS float*)(lds + 95232); LAS float* wl = (LAS float*)(lds + 96256); LAS float* gch = (LAS float*)(lds + 96512);
    LAS float* amax = (LAS float*)(lds + 96640); LAS float* mprev = (LAS float*)(lds + 96768); LAS unsigned char* Hs = lds + 97280;
    constexpr float QSCALE = 0.08838834764831845f;
    const int vblk = (gridDim.x % 8 == 0) ? (int)((blockIdx.x & 7) * (gridDim.x >> 3) + (blockIdx.x >> 3)) : (int)blockIdx.x;
    for (int item = vblk; item < 256; item += gridDim.x) {
        const int bhid = item >> 2, vs = item & 3, b = bhid >> 2, h = bhid & 3;
        const size_t rowbase = (size_t)b * SEQ;
        {
            float lf[4], ig[4];
#pragma unroll
            for (int i = 0; i < 4; ++i) { const float* gp = G16 + (rowbase + 4 * tid + i) * 16; lf[i] = logsig(gp[12 + h]); ig[i] = gp[8 + h]; }
            lf[1] += lf[0]; lf[2] += lf[1]; lf[3] += lf[2];
            const float tot = lf[3]; float sc = tot;
#pragma unroll
            for (int o = 1; o < 16; o <<= 1) { const float y = __shfl_up(sc, o, 16); if (c16 >= o) sc += y; }
            const float excl = sc - tot;
            float bi[4], ei[4], pm[4];
#pragma unroll
            for (int i = 0; i < 4; ++i) { bi[i] = lf[i] + excl; ei[i] = ig[i] - bi[i]; }
            pm[0] = ei[0]; pm[1] = fmaxf(pm[0], ei[1]); pm[2] = fmaxf(pm[1], ei[2]); pm[3] = fmaxf(pm[2], ei[3]);
            float scm = pm[3];
#pragma unroll
            for (int o = 1; o < 16; o <<= 1) { const float y = __shfl_up(scm, o, 16); if (c16 >= o) scm = fmaxf(scm, y); }
            float exm = __shfl_up(scm, 1, 16); if (c16 == 0) exm = -1e30f;
#pragma unroll
            for (int i = 0; i < 4; ++i) { bb[4 * tid + i] = bi[i]; ee[4 * tid + i] = ei[i]; cm[4 * tid + i] = fmaxf(pm[i], exm); }
            if (c16 == 15) { gch[tid >> 4] = bi[3]; amax[tid >> 4] = bi[3] + fmaxf(pm[3], exm); }
            if (tid < 128) nbuf[tid] = 0.f;
            for (int i = tid; i < 17408 / 4; i += 512) ((LAS unsigned*)Cbt)[i] = 0u;
        }
        LBAR();
        if (tid == 0) { float m = 0.f; for (int c = 0; c < 32; ++c) { mprev[c] = m; m = fmaxf(gch[c] + m, amax[c]); } mprev[32] = m; }
        LBAR();
        f32x4 Cst[2][4], Cn[2];
#pragma unroll
        for (int dd = 0; dd < 2; ++dd) { Cn[dd] = (f32x4){0.f, 0.f, 0.f, 0.f};
#pragma unroll
            for (int vt = 0; vt < 4; ++vt) Cst[dd][vt] = (f32x4){0.f, 0.f, 0.f, 0.f}; }
        const int vrow = tid >> 3, vch = tid & 7;
#define MLOAD(cc, Q, K, V) do { _Pragma("unroll") for (int i_ = 0; i_ < 2; ++i_) { const int p_ = tid + 512 * i_, row_ = p_ >> 4, ch_ = p_ & 15; const size_t r_ = rowbase + (size_t)(cc) * 64 + row_; \
            Q[i_] = *(const u32x4*)(MQK + r_ * DM + h * 256 + ch_ * 8); K[i_] = *(const u32x4*)(MQK + r_ * DM + h * 256 + 128 + ch_ * 8); } \
            V = __builtin_nontemporal_load((const u32x4*)(PROJ + (rowbase + (size_t)(cc) * 64 + vrow) * NP + C_MV + h * 256 + vs * 64 + vch * 8)); } while (0)
        u32x4 qA[2], kA[2], vA, qB[2], kB[2], vB;
        MLOAD(0, qA, kA, vA); MLOAD(1, qB, kB, vB);
        auto chunk = [&](const int c, u32x4 (&qreg)[2], u32x4 (&kreg)[2], u32x4& vreg) {
            const float mp = mprev[c], mn = mprev[c + 1], gc = gch[c];
#pragma unroll
            for (int i = 0; i < 2; ++i) { const int p = tid + 512 * i, row = p >> 4, ch = p & 15;
                *(LAS u32x4*)(Qs + row * 272 + ch * 16) = qreg[i]; *(LAS u32x4*)(Ks + row * 272 + ch * 16) = kreg[i]; }
            *(LAS u32x4*)(Vs + vrow * 144 + vch * 16) = vreg;
            { const float wv = __expf(gc + ee[64 * c + vrow] - mn); u32x4 o;
              o.x = pk2(bflo(vreg.x) * wv, bfhi(vreg.x) * wv); o.y = pk2(bflo(vreg.y) * wv, bfhi(vreg.y) * wv); o.z = pk2(bflo(vreg.z) * wv, bfhi(vreg.z) * wv); o.w = pk2(bflo(vreg.w) * wv, bfhi(vreg.w) * wv);
              *(LAS u32x4*)(Vw + vrow * 144 + vch * 16) = o; }
            if (tid < 64) wl[tid] = __expf(gc + ee[64 * c + tid] - mn);
            LBAR();
            MLOAD(c + 2 < 32 ? c + 2 : 31, qreg, kreg, vreg);
            const float decay = __expf(gc + mp - mn);
            if (wave < 4) {
                const int lt = wave, l = 16 * lt + c16;
                const float mx_l = fmaxf(mp, cm[64 * c + l]), winter = __expf(mp - mx_l);
                const LAS float* nb_ = nbuf + (c & 1) * 128;
                bf16x8 qf[4]; f32x4 n0[4], n1[4], e4[4];
#pragma unroll
                for (int kd = 0; kd < 4; ++kd) { qf[kd] = *(const LAS bf16x8*)(Qs + l * 272 + (32 * kd + 8 * g) * 2); n0[kd] = *(const LAS f32x4*)(nb_ + 32 * kd + 8 * g); n1[kd] = *(const LAS f32x4*)(nb_ + 32 * kd + 8 * g + 4); }
#pragma unroll
                for (int st = 0; st < 4; ++st) e4[st] = *(const LAS f32x4*)(ee + 64 * c + 16 * st + 4 * g);
                f32x4 sT[4], acc[4];
#pragma unroll
                for (int h2 = 0; h2 < 2; ++h2) {
                    bf16x8 kf[2][4];
#pragma unroll
                    for (int s2 = 0; s2 < 2; ++s2)
#pragma unroll
                        for (int kd = 0; kd < 4; ++kd) kf[s2][kd] = *(const LAS bf16x8*)(Ks + (16 * (2 * h2 + s2) + c16) * 272 + (32 * kd + 8 * g) * 2);
#pragma unroll
                    for (int s2 = 0; s2 < 2; ++s2) { sT[2 * h2 + s2] = (f32x4){0.f, 0.f, 0.f, 0.f};
#pragma unroll
                        for (int kd = 0; kd < 4; ++kd) sT[2 * h2 + s2] = __builtin_amdgcn_mfma_f32_16x16x32_bf16(kf[s2][kd], qf[kd], sT[2 * h2 + s2], 0, 0, 0); }
                    asm volatile("" ::: "memory");
                }
                float qn = 0.f;
#pragma unroll
                for (int kd = 0; kd < 4; ++kd) { const u32x4 qw = __builtin_bit_cast(u32x4, qf[kd]);
                    qn += bflo(qw.x) * n0[kd][0] + bfhi(qw.x) * n0[kd][1] + bflo(qw.y) * n0[kd][2] + bfhi(qw.y) * n0[kd][3] + bflo(qw.z) * n1[kd][0] + bfhi(qw.z) * n1[kd][1] + bflo(qw.w) * n1[kd][2] + bfhi(qw.w) * n1[kd][3]; }
                qn = xadd32(xadd16(qn));
#pragma unroll
                for (int h2 = 0; h2 < 2; ++h2) {
                    bf16x8 cf[2][4];
#pragma unroll
                    for (int j2 = 0; j2 < 2; ++j2)
#pragma unroll
                        for (int kd = 0; kd < 4; ++kd) cf[j2][kd] = *(const LAS bf16x8*)(Cbt + (16 * (2 * h2 + j2) + c16) * 272 + (32 * kd + 8 * g) * 2);
#pragma unroll
                    for (int j2 = 0; j2 < 2; ++j2) { acc[2 * h2 + j2] = (f32x4){0.f, 0.f, 0.f, 0.f};
#pragma unroll
                        for (int kd = 0; kd < 4; ++kd) acc[2 * h2 + j2] = __builtin_amdgcn_mfma_f32_16x16x32_bf16(cf[j2][kd], qf[kd], acc[2 * h2 + j2], 0, 0, 0); }
                    asm volatile("" ::: "memory");
                }
                bf16x8 vf[2][4];
#pragma unroll
                for (int ks = 0; ks < 2; ++ks)
#pragma unroll
                    for (int j = 0; j < 4; ++j) {
                        const s16x4 lo = vtr(Vs + (32 * ks + 4 * g + q4) * 144 + (16 * j + 4 * p4) * 2), hi = vtr(Vs + (32 * ks + 16 + 4 * g + q4) * 144 + (16 * j + 4 * p4) * 2);
                        vf[ks][j] = (bf16x8){lo[0], lo[1], lo[2], lo[3], hi[0], hi[1], hi[2], hi[3]}; }
                float psum = 0.f;
#pragma unroll
                for (int st = 0; st < 4; ++st)
#pragma unroll
                    for (int i = 0; i < 4; ++i) { const int sidx = 16 * st + 4 * g + i; float val = sT[st][i] * QSCALE * __expf(e4[st][i] - mx_l); if (sidx > l) val = 0.f; psum += val; sT[st][i] = val; }
                const float wis = winter * QSCALE;
#pragma unroll
                for (int j = 0; j < 4; ++j) acc[j] = acc[j] * wis;
#pragma unroll
                for (int ks = 0; ks < 2; ++ks) {
                    u32x4 w; w.x = pk2(sT[2 * ks][0], sT[2 * ks][1]); w.y = pk2(sT[2 * ks][2], sT[2 * ks][3]); w.z = pk2(sT[2 * ks + 1][0], sT[2 * ks + 1][1]); w.w = pk2(sT[2 * ks + 1][2], sT[2 * ks + 1][3]);
                    const bf16x8 pf = __builtin_bit_cast(bf16x8, w);
#pragma unroll
                    for (int j = 0; j < 4; ++j) acc[j] = __builtin_amdgcn_mfma_f32_16x16x32_bf16(vf[ks][j], pf, acc[j], 0, 0, 0);
                }
                psum = xadd32(xadd16(psum));
                const float den = wis * qn + psum, mt = bb[64 * c + l] + mx_l;
                const float inv = 1.0f / fmaxf(fabsf(den), __expf(-mt));
#pragma unroll
                for (int j = 0; j < 4; ++j) { const f32x4 o = acc[j] * inv; u32x2 w; w.x = pk2(o[0], o[1]); w.y = pk2(o[2], o[3]);
                    *(LAS u32x2*)(Hs + l * 144 + (16 * j + 4 * g) * 2) = w; }
            } else {
                const int dt0 = 2 * (wave - 4);
                bf16x8 vb[2][4], ka[2][2]; f32x4 w0[2], w1[2];
#pragma unroll
                for (int kl = 0; kl < 2; ++kl) {
                    w0[kl] = *(const LAS f32x4*)(wl + 32 * kl + 8 * g); w1[kl] = *(const LAS f32x4*)(wl + 32 * kl + 8 * g + 4);
#pragma unroll
                    for (int dd = 0; dd < 2; ++dd) {
                        const s16x4 alo = vtr(Ks + (32 * kl + 8 * g + q4) * 272 + (16 * (dt0 + dd) + 4 * p4) * 2), ahi = vtr(Ks + (32 * kl + 8 * g + 4 + q4) * 272 + (16 * (dt0 + dd) + 4 * p4) * 2);
                        ka[kl][dd] = (bf16x8){alo[0], alo[1], alo[2], alo[3], ahi[0], ahi[1], ahi[2], ahi[3]}; }
#pragma unroll
                    for (int vt = 0; vt < 4; ++vt) {
                        const s16x4 blo = vtr(Vw + (32 * kl + 8 * g + q4) * 144 + (16 * vt + 4 * p4) * 2), bhi = vtr(Vw + (32 * kl + 8 * g + 4 + q4) * 144 + (16 * vt + 4 * p4) * 2);
                        vb[kl][vt] = (bf16x8){blo[0], blo[1], blo[2], blo[3], bhi[0], bhi[1], bhi[2], bhi[3]}; }
                }
#pragma unroll
                for (int dd = 0; dd < 2; ++dd) { Cn[dd] = Cn[dd] * decay;
#pragma unroll
                    for (int vt = 0; vt < 4; ++vt) Cst[dd][vt] = Cst[dd][vt] * decay; }
#pragma unroll
                for (int kl = 0; kl < 2; ++kl) {
                    u32x4 wa; wa.x = pk2(w0[kl][0], w0[kl][1]); wa.y = pk2(w0[kl][2], w0[kl][3]); wa.z = pk2(w1[kl][0], w1[kl][1]); wa.w = pk2(w1[kl][2], w1[kl][3]);
                    if (c16 != 0) wa = (u32x4){0u, 0u, 0u, 0u};
#pragma unroll
                    for (int dd = 0; dd < 2; ++dd) {
                        Cn[dd] = __builtin_amdgcn_mfma_f32_16x16x32_bf16(ka[kl][dd], __builtin_bit_cast(bf16x8, wa), Cn[dd], 0, 0, 0);
#pragma unroll
                        for (int vt = 0; vt < 4; ++vt) Cst[dd][vt] = __builtin_amdgcn_mfma_f32_16x16x32_bf16(ka[kl][dd], vb[kl][vt], Cst[dd][vt], 0, 0, 0);
                    }
                }
                if (c16 == 0) {
#pragma unroll
                    for (int dd = 0; dd < 2; ++dd) *(LAS f32x4*)(nbuf + ((c + 1) & 1) * 128 + 16 * (dt0 + dd) + 4 * g) = Cn[dd]; }
            }
            LBAR();
            *(u32x4*)(HRAW + (rowbase + (size_t)c * 64 + vrow) * DM + h * 256 + vs * 64 + vch * 8) = *(const LAS u32x4*)(Hs + vrow * 144 + vch * 16);
            if (wave >= 4) {
                const int dt0 = 2 * (wave - 4);
#pragma unroll
                for (int dd = 0; dd < 2; ++dd)
#pragma unroll
                    for (int vt = 0; vt < 4; ++vt) { u32x2 w; w.x = pk2(Cst[dd][vt][0], Cst[dd][vt][1]); w.y = pk2(Cst[dd][vt][2], Cst[dd][vt][3]);
                        *(LAS u32x2*)(Cbt + (16 * vt + c16) * 272 + (16 * (dt0 + dd) + 4 * g) * 2) = w; }
            }
        };
        for (int c0 = 0; c0 < 32; c0 += 2) { chunk(c0, qA, kA, vA); chunk(c0 + 1, qB, kB, vB); }
#undef MLOAD
        LBAR();
    }
}

__device__ __forceinline__ void headnorm_phase(const bf16_t* PROJ, const float* gnorm, bf16_t* HM) {
    const int tid = threadIdx.x, lane = tid & 63, wave = __builtin_amdgcn_readfirstlane(tid >> 6);
    float gq[16]; { float t0[8], t1[8]; ld8f(gnorm + 16 * lane, t0); ld8f(gnorm + 16 * lane + 8, t1);
#pragma unroll
        for (int e = 0; e < 8; ++e) { gq[e] = t0[e]; gq[8 + e] = t1[e]; } }
    for (int m0 = (blockIdx.x * 8 + wave) * 4; m0 < MT; m0 += gridDim.x * 32) {
        u32x4 hr[4][2], mr[4][2];
#pragma unroll
        for (int r = 0; r < 4; ++r) { const bf16_t* hp = HM + (size_t)(m0 + r) * DM + 16 * lane; const bf16_t* mo = PROJ + (size_t)(m0 + r) * NP + C_MO + 16 * lane;
            hr[r][0] = __builtin_nontemporal_load((const u32x4*)hp); hr[r][1] = __builtin_nontemporal_load((const u32x4*)(hp + 8)); mr[r][0] = __builtin_nontemporal_load((const u32x4*)mo); mr[r][1] = __builtin_nontemporal_load((const u32x4*)(mo + 8)); }
#pragma unroll
        for (int r = 0; r < 4; ++r) {
            float v[16], og[16];
            { float t0[8], t1[8]; unpack8(hr[r][0], t0); unpack8(hr[r][1], t1);
#pragma unroll
              for (int e = 0; e < 8; ++e) { v[e] = t0[e]; v[8 + e] = t1[e]; }
              unpack8(mr[r][0], t0); unpack8(mr[r][1], t1);
#pragma unroll
              for (int e = 0; e < 8; ++e) { og[e] = t0[e]; og[8 + e] = t1[e]; } }
            float s = 0.f;
#pragma unroll
            for (int i = 0; i < 16; ++i) s += v[i];
#pragma unroll
            for (int o = 1; o < 16; o <<= 1) s += __shfl_xor(s, o);
            const float mean = s * (1.f / 256.f); float s2 = 0.f;
#pragma unroll
            for (int i = 0; i < 16; ++i) { v[i] -= mean; s2 += v[i] * v[i]; }
#pragma unroll
            for (int o = 1; o < 16; o <<= 1) s2 += __shfl_xor(s2, o);
            const float rstd = 1.f / sqrtf(s2 * (1.f / 256.f) + LN_EPS);
            float r0[8], r1[8];
#pragma unroll
            for (int e = 0; e < 8; ++e) { r0[e] = v[e] * rstd * gq[e] * sigmoidf_(og[e]); r1[e] = v[8 + e] * rstd * gq[8 + e] * sigmoidf_(og[8 + e]); }
            bf16_t* hp = HM + (size_t)(m0 + r) * DM + 16 * lane;
            *(u32x4*)hp = pack8(r0); *(u32x4*)(hp + 8) = pack8(r1);
        }
    }
}

__device__ __forceinline__ void ln16(float (&v)[2][8]) {
    float s = 0.f;
#pragma unroll
    for (int j = 0; j < 2; ++j)
#pragma unroll
        for (int e = 0; e < 8; ++e) s += v[j][e];
    const float mean = wave_sum(s) * (1.f / DM); float s2 = 0.f;
#pragma unroll
    for (int j = 0; j < 2; ++j)
#pragma unroll
        for (int e = 0; e < 8; ++e) { v[j][e] -= mean; s2 += v[j][e] * v[j][e]; }
    const float rstd = 1.f / sqrtf(wave_sum(s2) * (1.f / DM) + LN_EPS);
#pragma unroll
    for (int j = 0; j < 2; ++j)
#pragma unroll
        for (int e = 0; e < 8; ++e) v[j][e] *= rstd;
}
__device__ __forceinline__ void ln_mid_phase(const bf16_t* Z, const float* lg, const float* lb, const float* MOD, bf16_t* X1, bf16_t* H2) {
    const int tid = threadIdx.x, lane = tid & 63, wave = __builtin_amdgcn_readfirstlane(tid >> 6);
    float gg[2][8], bq[2][8];
#pragma unroll
    for (int j = 0; j < 2; ++j) { ld8f(lg + 8 * lane + 512 * j, gg[j]); ld8f(lb + 8 * lane + 512 * j, bq[j]); }
    for (int m0 = (blockIdx.x * 8 + wave) * 4; m0 < MT; m0 += gridDim.x * 32) {
        const int b = m0 >> 11;
        u32x4 raw[4][2]; float sh[2][8], sc[2][8];
#pragma unroll
        for (int r = 0; r < 4; ++r)
#pragma unroll
            for (int j = 0; j < 2; ++j) raw[r][j] = __builtin_nontemporal_load((const u32x4*)(Z + (size_t)(m0 + r) * DM + 8 * lane + 512 * j));
#pragma unroll
        for (int j = 0; j < 2; ++j) { ld8f(MOD + (size_t)b * 6144 + 3072 + 8 * lane + 512 * j, sh[j]); ld8f(MOD + (size_t)b * 6144 + 4096 + 8 * lane + 512 * j, sc[j]); }
        asm volatile("" ::: "memory");
#pragma unroll
        for (int r = 0; r < 4; ++r) {
            float v[2][8]; unpack8(raw[r][0], v[0]); unpack8(raw[r][1], v[1]);
            ln16(v);
#pragma unroll
            for (int j = 0; j < 2; ++j) {
#pragma unroll
                for (int e = 0; e < 8; ++e) v[j][e] = v[j][e] * gg[j][e] + bq[j][e];
                __builtin_nontemporal_store(pack8(v[j]), (u32x4*)(X1 + (size_t)(m0 + r) * DM + 8 * lane + 512 * j)); }
            ln16(v);
#pragma unroll
            for (int j = 0; j < 2; ++j) {
#pragma unroll
                for (int e = 0; e < 8; ++e) v[j][e] = v[j][e] * (sc[j][e] + 1.0f) + sh[j][e];
                *(u32x4*)(H2 + (size_t)(m0 + r) * DM + 8 * lane + 512 * j) = pack8(v[j]); }
        }
    }
}
__device__ __forceinline__ void ln_out_phase(const bf16_t* Z, const float* lg, const float* lb, float* OUT) {
    const int tid = threadIdx.x, lane = tid & 63, wave = __builtin_amdgcn_readfirstlane(tid >> 6);
    float gg[2][8], bq[2][8];
#pragma unroll
    for (int j = 0; j < 2; ++j) { ld8f(lg + 8 * lane + 512 * j, gg[j]); ld8f(lb + 8 * lane + 512 * j, bq[j]); }
    for (int m0 = (blockIdx.x * 8 + wave) * 4; m0 < MT; m0 += gridDim.x * 32) {
        u32x4 raw[4][2];
#pragma unroll
        for (int r = 0; r < 4; ++r)
#pragma unroll
            for (int j = 0; j < 2; ++j) raw[r][j] = *(const u32x4*)(Z + (size_t)(m0 + r) * DM + 8 * lane + 512 * j);
#pragma unroll
        for (int r = 0; r < 4; ++r) {
            float v[2][8]; unpack8(raw[r][0], v[0]); unpack8(raw[r][1], v[1]);
            ln16(v);
#pragma unroll
            for (int j = 0; j < 2; ++j) { float* op = OUT + (size_t)(m0 + r) * DM + 8 * lane + 512 * j;
                *(f32x4*)op = (f32x4){v[j][0] * gg[j][0] + bq[j][0], v[j][1] * gg[j][1] + bq[j][1], v[j][2] * gg[j][2] + bq[j][2], v[j][3] * gg[j][3] + bq[j][3]};
                *(f32x4*)(op + 4) = (f32x4){v[j][4] * gg[j][4] + bq[j][4], v[j][5] * gg[j][5] + bq[j][5], v[j][6] * gg[j][6] + bq[j][6], v[j][7] * gg[j][7] + bq[j][7]}; }
        }
    }
}

#define XB_TMO      128
#define XB_XCNT(j)  (256  + 64 * (j))
#define XB_XSUB(j)  (1280 + 64 * (j))
#define XB_XGEN(j)  (2304 + 64 * (j))
#define XB_TOP      3328
#define XB_TOPGEN   3392
#define XCD_BAR_WORDS 3456
#define XB_SPIN_CAP (1u << 22)
__device__ __forceinline__ unsigned xb_ld(unsigned* p)              { return __hip_atomic_load(p, __ATOMIC_RELAXED, __HIP_MEMORY_SCOPE_AGENT); }
__device__ __forceinline__ unsigned xb_add(unsigned* p, unsigned v) { return __hip_atomic_fetch_add(p, v, __ATOMIC_RELAXED, __HIP_MEMORY_SCOPE_AGENT); }
__device__ __forceinline__ unsigned xb_xcc_id() { return (unsigned)__builtin_amdgcn_s_getreg((3 << 11) | 20) & 0xFu; }
#define XB_SPIN(cond, bar) do { unsigned _sp = 0; while (cond) { __builtin_amdgcn_s_sleep(1); \
    if ((++_sp & 255u) == 0u) { if (xb_ld(&(bar)[XB_TMO])) break; if (_sp > XB_SPIN_CAP) { atomicAdd(&(bar)[XB_TMO], 1u); break; } } } } while (0)
struct XcdBarrier { unsigned* bar; unsigned x; volatile LAS unsigned* st; };
__device__ __forceinline__ XcdBarrier xcd_barrier_post(unsigned* bar, volatile LAS unsigned* st) {
    XcdBarrier b; b.bar = bar; b.x = xb_xcc_id(); b.st = st;
    if (threadIdx.x == 0) (void)xb_add(&bar[XB_XCNT(b.x)], 1u);
    return b;
}
__device__ __forceinline__ void xcd_barrier_complete(unsigned* bar, unsigned x, unsigned& nloc, unsigned& nx) {
    const unsigned G = gridDim.x * gridDim.y * gridDim.z;
    unsigned sum, cnt, mine, sp = 0u;
    for (;;) {
        sum = 0u; cnt = 0u; mine = 0u;
#pragma unroll
        for (unsigned j = 0; j < 16; ++j) { const unsigned c = xb_ld(&bar[XB_XCNT(j)]); sum += c; cnt += (c > 0u) ? 1u : 0u; mine = (j == x) ? c : mine; }
        if (sum == G) break;
        __builtin_amdgcn_s_sleep(1);
        if ((++sp & 255u) == 0u) { if (xb_ld(&bar[XB_TMO])) break; if (sp > XB_SPIN_CAP) { atomicAdd(&bar[XB_TMO], 1u); break; } }
    }
    nloc = mine > 0u ? mine : 1u; nx = cnt > 0u ? cnt : 1u;
}
__device__ __forceinline__ void xcd_barrier(const XcdBarrier& b) {
    asm volatile("s_waitcnt vmcnt(0)" ::: "memory");
    __syncthreads();
    if (threadIdx.x == 0) {
        unsigned* bar = b.bar;
        __builtin_amdgcn_s_waitcnt(0);
        unsigned nloc = b.st[0], nx = b.st[1];
        if (nloc == 0u) { xcd_barrier_complete(bar, b.x, nloc, nx); b.st[0] = nloc; b.st[1] = nx; }
        const unsigned old = xb_add(&bar[XB_XSUB(b.x)], 1u);
        const unsigned gen = old / nloc;
        if (old + 1u == (gen + 1u) * nloc) {
            __builtin_amdgcn_fence(__ATOMIC_RELEASE, "agent");
            asm volatile("s_waitcnt vmcnt(0)" ::: "memory");
            const unsigned og = xb_add(&bar[XB_TOP], 1u);
            const unsigned tg = og / nx;
            if (og + 1u == (tg + 1u) * nx) xb_add(&bar[XB_TOPGEN], 1u);
            else XB_SPIN(xb_ld(&bar[XB_TOPGEN]) == tg, bar);
            __builtin_amdgcn_fence(__ATOMIC_ACQUIRE, "agent");
            xb_add(&bar[XB_XGEN(b.x)], 1u);
            asm volatile("s_waitcnt vmcnt(0)" ::: "memory");
        } else {
            XB_SPIN(xb_ld(&bar[XB_XGEN(b.x)]) == gen, bar);
            __builtin_amdgcn_fence(__ATOMIC_ACQUIRE, "agent");
            asm volatile("s_waitcnt vmcnt(0)" ::: "memory");
        }
    }
    __syncthreads();
}

__device__ __forceinline__ void split_arrive(unsigned* ctr) {
    asm volatile("s_waitcnt vmcnt(0)" ::: "memory");
    __syncthreads();
    if (threadIdx.x == 0) { __builtin_amdgcn_fence(__ATOMIC_RELEASE, "agent"); asm volatile("s_waitcnt vmcnt(0)" ::: "memory"); (void)xb_add(ctr, 1u); }
}
__device__ __forceinline__ void split_wait(unsigned* ctr, unsigned want) {
    if (threadIdx.x == 0) { unsigned sp = 0; while (xb_ld(ctr) < want) { __builtin_amdgcn_s_sleep(2); if (++sp > (1u << 24)) break; }
        __builtin_amdgcn_fence(__ATOMIC_ACQUIRE, "agent"); asm volatile("s_waitcnt vmcnt(0)" ::: "memory"); }
    __syncthreads();
}

constexpr int N_PHASES = 12;
struct Args { const float* in[20]; float* out; unsigned char* ws; int ph_lo, ph_hi; };

__global__ void __launch_bounds__(512, 2) fwd_megakernel(Args a) {
    extern __shared__ __attribute__((aligned(16))) unsigned char lds_raw[];
    LAS unsigned char* lds = (LAS unsigned char*)lds_raw;
    cg::grid_group grid = cg::this_grid();
    unsigned char* ws = a.ws; unsigned char* dob = (unsigned char*)a.out;
    const int lo = a.ph_lo, hi = a.ph_hi, G = gridDim.x;
#ifndef REP_ID
#define REP_ID 0
#endif
#ifndef PH_MASK
#define PH_MASK 0x1ff
#endif
#define IN(k) (((PH_MASK >> (k)) & 1) && lo <= (k) && (k) < hi)
#define SEAM(k) do { if (IN(k) && IN((k) + 1)) { xcd_barrier(xbar); } } while (0)
    volatile LAS unsigned* MISC = (volatile LAS unsigned*)(lds + 131072 + 320);
    if (threadIdx.x < 32) MISC[threadIdx.x] = 0u;
    __syncthreads();
    XcdBarrier xbar = xcd_barrier_post((unsigned*)ws, MISC + 8);
    float* MOD = (float*)(ws + WS_MOD); float* G16 = (float*)(ws + WS_G16); float* FCUM = (float*)(ws + WS_FCUM);
    bf16_t* PROJ = (bf16_t*)(ws + WS_PROJ); bf16_t* ATT = (bf16_t*)(ws + WS_ATT);
    bf16_t* BUFA = (bf16_t*)(dob + DO_A); bf16_t* BUFB = (bf16_t*)(dob + DO_B);

    unsigned* SC = (unsigned*)(ws + WS_CNT + 98304);
    if (lo > 1000) grid.sync();
    if (IN(0)) {
        p0_prologue(lds, a.in, ws, SC);
        p1_ln_gates(lds, a.in[0], MOD, (const float*)(ws + WS_WG), (const float*)(ws + WS_BG), BUFA, G16);
    }
    SEAM(0);
    if (IN(1)) {
        fscan(lds, G16, FCUM);
        pg8::Gemm g{BUFA, (const bf16_t*)(ws + WS_WT_IN), MT, NP, 1024, 1024, 1024, 0}; pg8::StaticOrder S; S.init(MT, NP, G, (int)blockIdx.x);
        pg8::EpiProj E{PROJ, NP, a.in[5], 1};
        pg8::gemm_phase(lds, g, S, E);
    }
    SEAM(1);
    if (IN(2)) {
        conv_phase(PROJ, a.in[6], a.in[7], BUFA);
        split_arrive(SC + 64);
#if FOX_REF_ATTN
        attn_phase_ref((char*)lds_raw, PROJ, FCUM, ATT);
#else
        attn_phase(lds, PROJ, FCUM, ATT);
#endif
        split_wait(SC + 64, G);
        pg8::Gemm g{BUFA, (const bf16_t*)(ws + WS_WT_QK), MT, 1024, 256, 1024, 256, 512}; pg8::StaticOrder S; S.init(MT, 1024, G, (int)blockIdx.x);
        pg8::EpiProj E{BUFB, 1024, nullptr, 0};
        pg8::gemm_phase(lds, g, S, E);
    }
    SEAM(2);
    if (IN(3)) mlstm_phase(lds, PROJ, BUFB, G16, BUFA);
    SEAM(3);
    if (IN(4)) {
        headnorm_phase(PROJ, a.in[10], BUFA);
        split_arrive(SC + 128);
        { pg8::Gemm g{ATT, (const bf16_t*)(ws + WS_WT_PA), MT, 1024, 512, 512, 512, 0}; pg8::StaticOrder S; S.init(MT, 1024, G, (int)blockIdx.x);
          pg8::EpiY<0> E{BUFB, PROJ + C_GA};
          pg8::gemm_phase(lds, g, S, E); }
        split_wait(SC + 128, G);
        { pg8::Gemm g{BUFA, (const bf16_t*)(ws + WS_WT_PB), MT, 1024, 1024, 1024, 1024, 0}; pg8::StaticOrder S; S.init(MT, 1024, G, (int)blockIdx.x);
          pg8::EpiY<1> E{BUFB, PROJ + C_GB};
          pg8::gemm_phase(lds, g, S, E); }
    }
    SEAM(4);
    if (IN(5)) {
        pg8::Gemm g{BUFB, (const bf16_t*)(ws + WS_WT_OUT), MT, 1024, 1024, 1024, 1024, 0}; pg8::StaticOrder S; S.init(MT, 1024, G, (int)blockIdx.x);
        pg8::EpiRes<0> E{(const void*)a.in[0], MOD + 2048, (bf16_t*)(ws + WS_Z)};
        pg8::gemm_phase(lds, g, S, E);
    }
    SEAM(5);
    if (IN(6)) ln_mid_phase((const bf16_t*)(ws + WS_Z), a.in[14], a.in[15], MOD, (bf16_t*)(ws + WS_X1), BUFA);
    SEAM(6);
    if (IN(7)) {
        pg8::Gemm g{BUFA, (const bf16_t*)(ws + WS_WT_FI), MT, 2 * DFF, 1024, 1024, 1024, 0}; pg8::StaticOrder S; S.init(MT, 2 * DFF, G, (int)blockIdx.x);
        pg8::EpiSwiglu E{(bf16_t*)(ws + WS_ACT)};
        pg8::gemm_phase(lds, g, S, E);
    }
    SEAM(7);
    if (IN(8)) {
        pg8::Gemm g{(const bf16_t*)(ws + WS_ACT), (const bf16_t*)(ws + WS_WT_FD), MT, 1024, DFF, DFF, DFF, 0}; pg8::StaticOrder S; S.init(MT, 1024, G, (int)blockIdx.x);
        pg8::PanelStats st{(unsigned long long*)(ws + WS_XB3), (unsigned*)(ws + WS_CNT + 65536), lds + 132096};
        pg8::EpiLnOut E{(const bf16_t*)(ws + WS_X1), MOD + 5120, a.in[18], a.in[19], a.out, st};
        pg8::gemm_phase(lds, g, S, E);
    }
#undef IN
#undef SEAM
}

extern "C" void kernel_launch(void* const* d_in, const int* in_sizes, int n_in, void* d_out, int out_size, void* d_ws, size_t ws_size, hipStream_t stream) {
    static int grid = 0;
    if (grid == 0) {
        int dev = 0, cus = 0, per_cu = 0;
        hipGetDevice(&dev);
        hipDeviceGetAttribute(&cus, hipDeviceAttributeMultiprocessorCount, dev);
        if (hipFuncSetAttribute((const void*)fwd_megakernel, hipFuncAttributeMaxDynamicSharedMemorySize, LDS_BYTES) != hipSuccess) fprintf(stderr, "kernel_launch: hipFuncSetAttribute failed\n");
        if (hipOccupancyMaxActiveBlocksPerMultiprocessor(&per_cu, (const void*)fwd_megakernel, 512, LDS_BYTES) != hipSuccess || per_cu < 1) per_cu = 1;
        (void)hipGetLastError();
        grid = cus * per_cu; if (grid <= 0) grid = 256;
    }
    (void)hipMemsetAsync(d_ws, 0, 262144, stream);
    Args a{};
    for (int i = 0; i < 20; ++i) a.in[i] = (const float*)d_in[i];
    a.out = (float*)d_out; a.ws = (unsigned char*)d_ws;
    constexpr int NPH = 9;
    const int nl = MK_N_LAUNCHES;
    for (int li = 0; li < nl; ++li) {
        a.ph_lo = (nl == 1) ? 0 : li; a.ph_hi = (nl == 1) ? NPH : li + 1;
        void* args[] = {&a};
        hipError_t e = hipLaunchCooperativeKernel((const void*)fwd_megakernel, dim3(grid), dim3(512), args, LDS_BYTES, stream);
        if (e != hipSuccess) { fprintf(stderr, "cooperative launch failed: %s (grid %d)\n", hipGetErrorString(e), grid); break; }
    }
}
```

```cpp
#include <hip/hip_runtime.h>
#include <hip/hip_cooperative_groups.h>
#include <hip/hip_bf16.h>
#include <cmath>
#include <cstdio>
#include <cstdint>
namespace cg = cooperative_groups;

#ifndef FOX_REF_ATTN
#define FOX_REF_ATTN 1
#endif
#ifndef MK_N_LAUNCHES
#define MK_N_LAUNCHES 1
#endif

#define LAS __attribute__((address_space(3)))
typedef unsigned short bf16_t;
typedef short bf16x8 __attribute__((ext_vector_type(8)));
typedef short s16x4 __attribute__((ext_vector_type(4)));
typedef short v4i16_t __attribute__((ext_vector_type(4)));
typedef float f32x4 __attribute__((ext_vector_type(4)));
typedef float f32x2 __attribute__((ext_vector_type(2)));
typedef unsigned u32x4 __attribute__((ext_vector_type(4)));
typedef unsigned u32x2 __attribute__((ext_vector_type(2)));
typedef __bf16 bf16x2_t __attribute__((ext_vector_type(2)));

constexpr int BATCH = 16, SEQ = 2048, DM = 1024, MT = BATCH * SEQ;
constexpr int DIN = 6672, NP = 6656, DFF = 2816;
constexpr int C_FQ = 0, C_FK = 512, C_FV = 1024, C_MU = 1536, C_MV = 2560, C_MO = 3584, C_GA = 4608, C_GB = 5632;
constexpr float LN_EPS = 1e-5f, ALPHA = 1.189207115002721f, LOG2E = 1.4426950408889634f;
constexpr int LDS_BYTES = 147456;

constexpr size_t MiB = 1u << 20;
constexpr size_t WS_MOD = 1 * MiB, WS_WG = 2 * MiB, WS_BG = 2 * MiB + 65536, WS_FCUM = 3 * MiB, WS_G16 = 4 * MiB;
constexpr size_t WS_WT_IN = 8 * MiB, WS_WT_QK = 21 * MiB, WS_WT_PA = 22 * MiB, WS_WT_PB = 23 * MiB, WS_WT_OUT = 25 * MiB, WS_WT_FI = 27 * MiB, WS_WT_FD = 38 * MiB;
constexpr size_t WS_XB1 = 44 * MiB, WS_XB2 = 45 * MiB, WS_XB3 = 46 * MiB;
constexpr size_t WS_CNT = 65536;
constexpr size_t WS_PROJ = 48 * MiB;
constexpr size_t WS_ATT = 464 * MiB;
constexpr size_t WS_Z = 48 * MiB;
constexpr size_t WS_X1 = 176 * MiB;
constexpr size_t WS_ACT = 304 * MiB;
constexpr size_t WS_Z2 = 48 * MiB;
constexpr size_t DO_A = 0, DO_B = 64 * MiB;

__device__ __forceinline__ unsigned pk2(float lo, float hi) { f32x2 v = {lo, hi}; bf16x2_t b = __builtin_convertvector(v, bf16x2_t); return __builtin_bit_cast(unsigned, b); }
__device__ __forceinline__ float bflo(unsigned w) { return __uint_as_float(w << 16); }
__device__ __forceinline__ float bfhi(unsigned w) { return __uint_as_float(w & 0xffff0000u); }
__device__ __forceinline__ float sigmoidf_(float x) { return __builtin_amdgcn_rcpf(1.0f + __expf(-x)); }
__device__ __forceinline__ float logsig(float x) { return fminf(x, 0.f) - log1pf(expf(-fabsf(x))); }
__device__ __forceinline__ float wave_sum(float v) {
#pragma unroll
    for (int o = 1; o < 64; o <<= 1) v += __shfl_xor(v, o);
    return v;
}
__device__ __forceinline__ s16x4 vtr(const LAS unsigned char* p) { return __builtin_bit_cast(s16x4, __builtin_amdgcn_ds_read_tr16_b64_v4i16((LAS v4i16_t*)p)); }
#define LDS_WAIT() asm volatile("s_waitcnt lgkmcnt(0)" ::: "memory")
#define LBAR() do { asm volatile("s_waitcnt lgkmcnt(0)" ::: "memory"); __builtin_amdgcn_s_barrier(); asm volatile("" ::: "memory"); } while (0)

__device__ __forceinline__ void unpack8(const u32x4 w, float (&v)[8]) { v[0] = bflo(w.x); v[1] = bfhi(w.x); v[2] = bflo(w.y); v[3] = bfhi(w.y); v[4] = bflo(w.z); v[5] = bfhi(w.z); v[6] = bflo(w.w); v[7] = bfhi(w.w); }
__device__ __forceinline__ u32x4 pack8(const float (&v)[8]) { u32x4 w; w.x = pk2(v[0], v[1]); w.y = pk2(v[2], v[3]); w.z = pk2(v[4], v[5]); w.w = pk2(v[6], v[7]); return w; }
__device__ __forceinline__ void ld8f(const float* p, float (&v)[8]) { const f32x4 a = *(const f32x4*)p, b = *(const f32x4*)(p + 4); v[0] = a[0]; v[1] = a[1]; v[2] = a[2]; v[3] = a[3]; v[4] = b[0]; v[5] = b[1]; v[6] = b[2]; v[7] = b[3]; }

namespace pg8 {
constexpr int BM = 256, BK = 64, HALF = 128, HTB = HALF * BK * 2, STAGE_BYTES = 8 * HTB, NXCD = 8, WGM = 8;
__host__ __device__ __forceinline__ int lds_byte(int r, int c) { const int st = (r >> 4) * 2 + (c >> 5), rr = r & 15, cc = c & 31, ob = rr * 64 + cc * 2; return st * 1024 + (ob ^ (((ob >> 9) & 1) << 5)); }
__host__ __device__ __forceinline__ void stage_rc(int b, int& R, int& C) { const int st = b / 1024, sb = b % 1024, swz = sb ^ (((sb >> 9) & 1) << 5); R = (st >> 1) * 16 + swz / 64; C = (st & 1) * 32 + (swz % 64) / 2; }
__host__ __device__ __forceinline__ int perm32(int rho) { const int n = rho >> 4, i = rho & 15; return 8 * (i >> 2) + 4 * n + (i & 3); }

struct Unit { int pm, pn; };
struct Gemm { const bf16_t* A; const bf16_t* Bt; int M, N, K, lda, ldb, aoffN; };

struct StaticOrder {
    int nM, nN, nwg, G, c;
    __device__ void init(int M, int N, int G_, int c_) { nM = M / BM; nN = N / BM; nwg = nM * nN; G = G_; c = c_; }
    __device__ bool next(int i, Unit& u) const {
        const long L = (long)i * G + c; if (L >= nwg) return false;
        int wgid = (int)L; { const int q = nwg / NXCD, r = nwg % NXCD, xcd = wgid % NXCD, off = wgid / NXCD; wgid = (xcd < r ? xcd * (q + 1) : r * (q + 1) + (xcd - r) * q) + off; }
        const int nig = WGM * nN, gid = wgid / nig, fm = gid * WGM, gsz = (nM - fm) < WGM ? (nM - fm) : WGM;
        u.pm = fm + ((wgid % nig) % gsz); u.pn = (wgid % nig) / gsz; return true;
    }
};
template <class E, class = void> struct has_pre { static constexpr bool value = false; };
template <class E> struct has_pre<E, decltype((void)E::HAS_PRE)> { static constexpr bool value = true; };
template <class Epi, class Sched>
__device__ __forceinline__ void gemm_phase(LAS unsigned char* lds, const Gemm g, const Sched& S, const Epi& E) {
    const int tid = threadIdx.x, wid = __builtin_amdgcn_readfirstlane(tid >> 6), lane = tid & 63, wr = wid >> 2, wc = wid & 3, fr = lane & 15, fq = lane >> 4;
    const int K = g.K, nt = K / BK;
    unsigned voffA[2], voffB[2];
#pragma unroll
    for (int i = 0; i < 2; ++i) { int R, C; stage_rc(tid * 16 + i * 8192, R, C); const int Rb = Epi::PERM ? ((R & ~31) + perm32(R & 31)) : R;
        voffA[i] = (unsigned)(R * g.lda + C) * 2u; voffB[i] = (unsigned)(Rb * g.ldb + C) * 2u; }
    const size_t kstep = (size_t)(BK * 2);
    const size_t hstepA = (size_t)HALF * g.lda * 2, hstepB = (size_t)HALF * g.ldb * 2;
    const size_t tstepA = 2 * hstepA, tstepB = 2 * hstepB;
    const unsigned ldsw = (unsigned)wid * 1024u;
    const int aoff = lds_byte(wr * 64 + fr, fq * 8), boff = lds_byte(wc * 32 + fr, fq * 8);
#define PG8_SA(b, h) (((b) * 2 + (h)) * HTB)
#define PG8_SB(b, h) ((4 + (b) * 2 + (h)) * HTB)
#define PG8_STAGE(bufoff, gbase, voff) do { _Pragma("unroll") for (int _i = 0; _i < 2; ++_i) \
        __builtin_amdgcn_global_load_lds((const unsigned*)((const char*)(gbase) + (voff)[_i]), (LAS unsigned*)(lds + (bufoff) + ldsw + _i * 8192), 16, 0, 0); } while (0)
#define PG8_LDA(dst, b, h) do { _Pragma("unroll") for (int m = 0; m < 4; ++m) _Pragma("unroll") for (int k = 0; k < 2; ++k) dst[m][k] = *(const LAS bf16x8*)(lds + PG8_SA(b, h) + aoff + m * 2048 + k * 1024); } while (0)
#define PG8_LDB(dst, b, h) do { _Pragma("unroll") for (int n = 0; n < 2; ++n) _Pragma("unroll") for (int k = 0; k < 2; ++k) dst[n][k] = *(const LAS bf16x8*)(lds + PG8_SB(b, h) + boff + n * 2048 + k * 1024); } while (0)
#define PG8_MMA(ai, bj, At, Bt) do { __builtin_amdgcn_s_setprio(1); _Pragma("unroll") for (int m = 0; m < 4; ++m) _Pragma("unroll") for (int n = 0; n < 2; ++n) _Pragma("unroll") for (int k = 0; k < 2; ++k) \
        acc[ai][bj][m][n] = __builtin_amdgcn_mfma_f32_16x16x32_bf16(Bt[n][k], At[m][k], acc[ai][bj][m][n], 0, 0, 0); __builtin_amdgcn_s_setprio(0); } while (0)
#define PG8_WAIT_V(n) asm volatile("s_waitcnt vmcnt(" #n ")" ::: "memory")
#define PG8_WAIT_L(n) asm volatile("s_waitcnt lgkmcnt(" #n ")" ::: "memory")
#define PG8_BAR __builtin_amdgcn_s_barrier()
#define PG8_SCHED __builtin_amdgcn_sched_barrier(0)
    Unit cur, nxt; int ui = 0;
    if (!S.next(0, cur)) return;
    f32x4 acc[2][2][4][2];
#pragma unroll
    for (int a = 0; a < 2; ++a)
#pragma unroll
        for (int b = 0; b < 2; ++b)
#pragma unroll
            for (int m = 0; m < 4; ++m)
#pragma unroll
                for (int n = 0; n < 2; ++n) acc[a][b][m][n] = (f32x4){0.f, 0.f, 0.f, 0.f};
    bf16x8 At[4][2], B0[2][2], B1[2][2];
    LAS unsigned char* bslot = lds + 142592;
#define PG8_BIAS_DMA(unit, slotidx) do { if constexpr (has_pre<Epi>::value) { if (wid == 0) { const float* bp_ = E.bias_tile(unit); \
        if (bp_) __builtin_amdgcn_global_load_lds((const unsigned*)((const char*)bp_ + lane * 16), (LAS unsigned*)(bslot + ((slotidx) & 1) * 1024), 16, 0, 0); } } } while (0)
    PG8_BIAS_DMA(cur, 0);
    const char* cA = (const char*)g.A + (size_t)cur.pm * tstepA + (size_t)cur.pn * g.aoffN; const char* cB = (const char*)g.Bt + (size_t)cur.pn * tstepB;
    PG8_STAGE(PG8_SB(0, 0), cB, voffB); PG8_STAGE(PG8_SB(0, 1), cB + hstepB, voffB); PG8_STAGE(PG8_SA(0, 0), cA, voffA); PG8_STAGE(PG8_SA(0, 1), cA + hstepA, voffA);
    if (wr == 1) PG8_BAR;
    PG8_WAIT_V(2); PG8_BAR;
    PG8_STAGE(PG8_SB(1, 0), cB + kstep, voffB); PG8_STAGE(PG8_SA(1, 0), cA + kstep, voffA); PG8_STAGE(PG8_SB(1, 1), cB + hstepB + kstep, voffB);
    PG8_WAIT_V(6); PG8_BAR;
    for (;;) {
        const bool has_next = S.next(ui + 1, nxt);
        const char* nA = has_next ? (const char*)g.A + (size_t)nxt.pm * tstepA + (size_t)nxt.pn * g.aoffN : cA; const char* nB = has_next ? (const char*)g.Bt + (size_t)nxt.pn * tstepB : cB;
        for (int t = 0; t < nt; t += 2) {
            const bool last = (t == nt - 2);
            if (last && has_next) PG8_BIAS_DMA(nxt, ui + 1);
            const char* a1 = cA + (size_t)(t + 1) * kstep;
            const char* a2 = last ? nA : cA + (size_t)(t + 2) * kstep; const char* b2 = last ? nB : cB + (size_t)(t + 2) * kstep;
            const char* a3 = a2 + kstep; const char* b3 = b2 + kstep;
            PG8_LDB(B0, 0, 0); PG8_LDB(B1, 0, 1); PG8_SCHED; PG8_LDA(At, 0, 0); PG8_STAGE(PG8_SA(1, 1), a1 + hstepA, voffA);
            PG8_WAIT_V(8); PG8_WAIT_L(0); PG8_BAR; PG8_MMA(0, 0, At, B0); PG8_MMA(0, 1, At, B1); PG8_BAR; PG8_SCHED;
            PG8_LDA(At, 0, 1); PG8_STAGE(PG8_SB(0, 0), b2, voffB); PG8_STAGE(PG8_SB(0, 1), b2 + hstepB, voffB); PG8_STAGE(PG8_SA(0, 0), a2, voffA);
            PG8_WAIT_V(8); PG8_WAIT_L(0); PG8_BAR; PG8_MMA(1, 0, At, B0); PG8_MMA(1, 1, At, B1); PG8_BAR; PG8_SCHED;
            PG8_LDB(B0, 1, 0); PG8_LDB(B1, 1, 1); PG8_SCHED; PG8_LDA(At, 1, 0); PG8_STAGE(PG8_SA(0, 1), a2 + hstepA, voffA);
            PG8_WAIT_V(8); PG8_WAIT_L(0); PG8_BAR; PG8_MMA(0, 0, At, B0); PG8_MMA(0, 1, At, B1); PG8_BAR; PG8_SCHED;
            PG8_LDA(At, 1, 1); PG8_STAGE(PG8_SB(1, 0), b3, voffB); PG8_STAGE(PG8_SB(1, 1), b3 + hstepB, voffB); PG8_STAGE(PG8_SA(1, 0), a3, voffA);
            PG8_WAIT_V(8); PG8_WAIT_L(0); PG8_BAR; PG8_MMA(1, 0, At, B0); PG8_MMA(1, 1, At, B1); PG8_BAR; PG8_SCHED;
        }
        if (wr == 0) PG8_BAR;
        asm volatile("" ::: "memory"); PG8_SCHED;
        if constexpr (has_pre<Epi>::value) E.run(acc, cur, wr, wc, fr, fq, (const LAS float*)(bslot + (ui & 1) * 1024)); else E(acc, cur, wr, wc, fr, fq);
        if (!has_next) break;
#pragma unroll
        for (int a = 0; a < 2; ++a)
#pragma unroll
            for (int b = 0; b < 2; ++b)
#pragma unroll
                for (int m = 0; m < 4; ++m)
#pragma unroll
                    for (int n = 0; n < 2; ++n) acc[a][b][m][n] = (f32x4){0.f, 0.f, 0.f, 0.f};
        cur = nxt; cA = nA; cB = nB; ++ui;
        if (wr == 1) PG8_BAR;
    }
    PG8_WAIT_V(0);
    PG8_BAR;
#undef PG8_BIAS_DMA
#undef PG8_SA
#undef PG8_SB
#undef PG8_STAGE
#undef PG8_LDA
#undef PG8_LDB
#undef PG8_MMA
#undef PG8_WAIT_V
#undef PG8_WAIT_L
#undef PG8_BAR
#undef PG8_SCHED
}

struct EpiProj {
    static constexpr bool PERM = true; static constexpr bool HAS_PRE = true;
    bf16_t* O; int ldc; const float* bias; int has_shift;
    __device__ __forceinline__ const float* bias_tile(const Unit& u) const {
        if (!bias) return nullptr;
        const int colt = u.pn * BM; int shift = 0; if (has_shift) shift = (colt >= 1536 ? 8 : 0) + (colt >= 3584 ? 8 : 0);
        return bias + colt + shift;
    }
    __device__ __forceinline__ void run(f32x4 (&acc)[2][2][4][2], const Unit& u, int wr, int wc, int fr, int fq, const LAS float* bl) const {
        const int row0 = u.pm * BM + wr * 64 + fr; const int col0 = u.pn * BM + wc * 32 + 8 * fq;
        f32x4 bv[2][2];
#pragma unroll
        for (int bj = 0; bj < 2; ++bj)
#pragma unroll
            for (int n = 0; n < 2; ++n) bv[bj][n] = bias ? *(const LAS f32x4*)(bl + wc * 32 + 8 * fq + bj * HALF + 4 * n) : (f32x4){0.f, 0.f, 0.f, 0.f};
#pragma unroll
        for (int ai = 0; ai < 2; ++ai)
#pragma unroll
            for (int m = 0; m < 4; ++m) { bf16_t* rowp = O + (size_t)(row0 + ai * HALF + m * 16) * ldc + col0;
#pragma unroll
                for (int bj = 0; bj < 2; ++bj) { const f32x4 v0 = acc[ai][bj][m][0] + bv[bj][0], v1 = acc[ai][bj][m][1] + bv[bj][1];
                    u32x4 w; w.x = pk2(v0[0], v0[1]); w.y = pk2(v0[2], v0[3]); w.z = pk2(v1[0], v1[1]); w.w = pk2(v1[2], v1[3]);
                    __builtin_nontemporal_store(w, (u32x4*)(rowp + bj * HALF)); } }
    }
};
template <int MODE> struct EpiY {
    static constexpr bool PERM = true;
    bf16_t* Y; const bf16_t* G;
    __device__ __forceinline__ void operator()(f32x4 (&acc)[2][2][4][2], const Unit& u, int wr, int wc, int fr, int fq) const {
        const int row0 = u.pm * BM + wr * 64 + fr; const int col0 = u.pn * BM + wc * 32 + 8 * fq;
#pragma unroll
        for (int ai = 0; ai < 2; ++ai) {
            u32x4 gv[4][2], yo[4][2];
#pragma unroll
            for (int m = 0; m < 4; ++m)
#pragma unroll
                for (int bj = 0; bj < 2; ++bj) { const size_t row = (size_t)(row0 + ai * HALF + m * 16); const int col = col0 + bj * HALF;
                    gv[m][bj] = __builtin_nontemporal_load((const u32x4*)(G + row * NP + col)); if (MODE == 1) yo[m][bj] = *(const u32x4*)(Y + row * DM + col); }
            asm volatile("" ::: "memory");
#pragma unroll
            for (int m = 0; m < 4; ++m)
#pragma unroll
                for (int bj = 0; bj < 2; ++bj) { const size_t row = (size_t)(row0 + ai * HALF + m * 16); const int col = col0 + bj * HALF;
                    const f32x4 a0 = acc[ai][bj][m][0], a1 = acc[ai][bj][m][1]; float gsg[8], r[8]; unpack8(gv[m][bj], gsg);
#pragma unroll
                    for (int e = 0; e < 4; ++e) { r[e] = sigmoidf_(gsg[e]) * a0[e]; r[4 + e] = sigmoidf_(gsg[4 + e]) * a1[e]; }
                    if (MODE == 1) { float yv[8]; unpack8(yo[m][bj], yv);
#pragma unroll
                        for (int e = 0; e < 8; ++e) r[e] += yv[e]; }
                    *(u32x4*)(Y + row * DM + col) = pack8(r); }
            asm volatile("" ::: "memory");
        }
    }
};
template <int XBF> struct EpiRes {
    static constexpr bool PERM = true;
    const void* X; const float* gmod; bf16_t* Z;
    __device__ __forceinline__ void operator()(f32x4 (&acc)[2][2][4][2], const Unit& u, int wr, int wc, int fr, int fq) const {
        const int row0 = u.pm * BM + wr * 64 + fr; const int col0 = u.pn * BM + wc * 32 + 8 * fq; const int b = (u.pm * BM) >> 11;
        f32x4 gv[2][2];
#pragma unroll
        for (int bj = 0; bj < 2; ++bj)
#pragma unroll
            for (int n = 0; n < 2; ++n) gv[bj][n] = *(const f32x4*)(gmod + (size_t)b * 6144 + col0 + bj * HALF + n * 4);
#pragma unroll
        for (int ai = 0; ai < 2; ++ai) {
            f32x4 xv[4][2][2];
#pragma unroll
            for (int m = 0; m < 4; ++m)
#pragma unroll
                for (int bj = 0; bj < 2; ++bj) { const size_t off = (size_t)(row0 + ai * HALF + m * 16) * DM + col0 + bj * HALF;
                    if (XBF) { const u32x4 w = *(const u32x4*)((const bf16_t*)X + off); xv[m][bj][0] = (f32x4){bflo(w.x), bfhi(w.x), bflo(w.y), bfhi(w.y)}; xv[m][bj][1] = (f32x4){bflo(w.z), bfhi(w.z), bflo(w.w), bfhi(w.w)}; }
                    else { xv[m][bj][0] = __builtin_nontemporal_load((const f32x4*)((const float*)X + off)); xv[m][bj][1] = __builtin_nontemporal_load((const f32x4*)((const float*)X + off + 4)); } }
            asm volatile("" ::: "memory");
#pragma unroll
            for (int m = 0; m < 4; ++m)
#pragma unroll
                for (int bj = 0; bj < 2; ++bj) { const size_t off = (size_t)(row0 + ai * HALF + m * 16) * DM + col0 + bj * HALF;
                    const f32x4 o0 = xv[m][bj][0] * ALPHA + gv[bj][0] * acc[ai][bj][m][0], o1 = xv[m][bj][1] * ALPHA + gv[bj][1] * acc[ai][bj][m][1];
                    u32x4 w; w.x = pk2(o0[0], o0[1]); w.y = pk2(o0[2], o0[3]); w.z = pk2(o1[0], o1[1]); w.w = pk2(o1[2], o1[3]);
                    *(u32x4*)(Z + off) = w; }
            asm volatile("" ::: "memory");
        }
    }
};
struct EpiSwiglu {
    static constexpr bool PERM = true;
    bf16_t* O;
    __device__ __forceinline__ void operator()(f32x4 (&acc)[2][2][4][2], const Unit& u, int wr, int wc, int fr, int fq) const {
        const int row0 = u.pm * BM + wr * 64 + fr; const int col0 = u.pn * HALF + wc * 32 + 8 * fq;
#pragma unroll
        for (int ai = 0; ai < 2; ++ai)
#pragma unroll
            for (int m = 0; m < 4; ++m) { bf16_t* rowp = O + (size_t)(row0 + ai * HALF + m * 16) * DFF + col0;
                const f32x4 g0 = acc[ai][0][m][0], g1 = acc[ai][0][m][1], u0 = acc[ai][1][m][0], u1 = acc[ai][1][m][1];
                float r[8];
#pragma unroll
                for (int e = 0; e < 4; ++e) { r[e] = g0[e] * sigmoidf_(g0[e]) * u0[e]; r[4 + e] = g1[e] * sigmoidf_(g1[e]) * u1[e]; }
                u32x4 w; w.x = pk2(r[0], r[1]); w.y = pk2(r[2], r[3]); w.z = pk2(r[4], r[5]); w.w = pk2(r[6], r[7]);
                __builtin_nontemporal_store(w, (u32x4*)rowp); }
    }
};

struct PanelStats {
    unsigned long long* xbuf;
    unsigned* cnt;
    LAS unsigned char* scr;
    __device__ __forceinline__ void run(const f32x4 (&v)[2][2][4][2], const Unit& u, int wr, int wc, int fr, int fq) const {
        const int lane = threadIdx.x & 63, wid = __builtin_amdgcn_readfirstlane(threadIdx.x >> 6);
        LAS f32x2* P = (LAS f32x2*)scr;
        LAS f32x2* S = (LAS f32x2*)(scr + 8192);
#pragma unroll
        for (int ai = 0; ai < 2; ++ai)
#pragma unroll
            for (int m = 0; m < 4; ++m) {
                float s = 0.f;
#pragma unroll
                for (int bj = 0; bj < 2; ++bj)
#pragma unroll
                    for (int n = 0; n < 2; ++n) { const f32x4 x = v[ai][bj][m][n]; s += (x[0] + x[1]) + (x[2] + x[3]); }
                s += __shfl_xor(s, 16); s += __shfl_xor(s, 32);
                const float mw = s * (1.0f / 64.0f); float q = 0.f;
#pragma unroll
                for (int bj = 0; bj < 2; ++bj)
#pragma unroll
                    for (int n = 0; n < 2; ++n) { const f32x4 d = v[ai][bj][m][n] - mw; q += (d[0] * d[0] + d[1] * d[1]) + (d[2] * d[2] + d[3] * d[3]); }
                q += __shfl_xor(q, 16); q += __shfl_xor(q, 32);
                if (fq == 0) P[(ai * HALF + wr * 64 + m * 16 + fr) * 4 + wc] = (f32x2){mw, q};
            }
        asm volatile("s_waitcnt lgkmcnt(0)" ::: "memory"); __builtin_amdgcn_s_barrier(); asm volatile("" ::: "memory");
        const int row = wid * 32 + (lane & 31);
        if (lane < 32) {
            const f32x2 a = P[row * 4 + 0], b = P[row * 4 + 1], c = P[row * 4 + 2], d = P[row * 4 + 3];
            const float mt = (a.x + b.x + c.x + d.x) * 0.25f;
            const float da = a.x - mt, db = b.x - mt, dc = c.x - mt, dd = d.x - mt;
            const float m2 = (a.y + b.y) + (c.y + d.y) + 64.0f * ((da * da + db * db) + (dc * dc + dd * dd));
            unsigned long long* slot = xbuf + ((size_t)(u.pm * BM + row) * 4 + u.pn);
            __hip_atomic_store(slot, ((unsigned long long)__float_as_uint(m2) << 32) | __float_as_uint(mt), __ATOMIC_RELAXED, __HIP_MEMORY_SCOPE_AGENT);
        }
        asm volatile("s_waitcnt vmcnt(0)" ::: "memory");
        if (lane == 0) __hip_atomic_fetch_add(cnt + 64 * u.pm, 1u, __ATOMIC_RELAXED, __HIP_MEMORY_SCOPE_AGENT);
        if (wid == 0) {
            unsigned sp = 0;
            for (;;) {
                if ((unsigned)__builtin_amdgcn_readfirstlane(__hip_atomic_load(cnt + 64 * u.pm, __ATOMIC_RELAXED, __HIP_MEMORY_SCOPE_AGENT)) >= 32u) break;
                if (++sp > (1u << 24)) break;
                __builtin_amdgcn_s_sleep(2);
            }
            __builtin_amdgcn_fence(__ATOMIC_ACQUIRE, "agent");
        }
        asm volatile("s_waitcnt vmcnt(0) lgkmcnt(0)" ::: "memory"); __builtin_amdgcn_s_barrier(); asm volatile("" ::: "memory");
        if (lane < 32) {
            const unsigned long long* slot = xbuf + (size_t)(u.pm * BM + row) * 4; float mt[4], m2[4]; float ms = 0.f;
#pragma unroll
            for (int t = 0; t < 4; ++t) { const unsigned long long w = __hip_atomic_load(slot + t, __ATOMIC_RELAXED, __HIP_MEMORY_SCOPE_AGENT); mt[t] = __uint_as_float((unsigned)w); m2[t] = __uint_as_float((unsigned)(w >> 32)); ms += mt[t]; }
            const float mean = ms * 0.25f; float q = 0.f;
#pragma unroll
            for (int t = 0; t < 4; ++t) { const float dm = mt[t] - mean; q += m2[t] + 256.0f * dm * dm; }
            S[row] = (f32x2){mean, 1.0f / sqrtf(q * (1.0f / 1024.0f) + LN_EPS)};
        }
        asm volatile("s_waitcnt lgkmcnt(0)" ::: "memory"); __builtin_amdgcn_s_barrier(); asm volatile("" ::: "memory");
    }
};
__device__ __forceinline__ const char* uptr(const void* p) { const unsigned long long v = (unsigned long long)p;
    const unsigned lo = __builtin_amdgcn_readfirstlane((unsigned)v), hi = __builtin_amdgcn_readfirstlane((unsigned)(v >> 32)); return (const char*)(((unsigned long long)hi << 32) | lo); }
__device__ __forceinline__ f32x4 ld4bf(const bf16_t* p) { const u32x2 w = __builtin_nontemporal_load((const u32x2*)p); return (f32x4){bflo(w.x), bfhi(w.x), bflo(w.y), bfhi(w.y)}; }
#define EPI_FOR4 _Pragma("unroll") for (int bj = 0; bj < 2; ++bj) _Pragma("unroll") for (int n = 0; n < 2; ++n)
#define EPI_ROWS _Pragma("unroll") for (int ai = 0; ai < 2; ++ai) _Pragma("unroll") for (int m = 0; m < 4; ++m)
struct EpiLnOut {
    static constexpr bool PERM = false;
    const bf16_t* X1; const float* gmod; const float* lg; const float* lb; float* OUT; PanelStats st;
    __device__ __forceinline__ void operator()(f32x4 (&acc)[2][2][4][2], const Unit& u, int wr, int wc, int fr, int fq) const {
        const int b = (u.pm * BM) >> 11; const unsigned loff = (unsigned)(fr * DM + 4 * fq), coff = 4 * fq;
        const size_t ub = (size_t)(u.pm * BM + wr * 64) * DM + u.pn * BM + wc * 32; const int cb = u.pn * BM + wc * 32;
        const float* gm = gmod + (size_t)b * 6144 + cb;
        EPI_FOR4 { const f32x4 gv = *(const f32x4*)(gm + (bj * HALF + n * 16) + coff);
            EPI_ROWS { const f32x4 xv = ld4bf(X1 + (ub + (size_t)((ai * HALF + m * 16) * DM + bj * HALF + n * 16)) + loff);
                acc[ai][bj][m][n] = xv * ALPHA + gv * acc[ai][bj][m][n]; }
            asm volatile("" ::: "memory"); __builtin_amdgcn_sched_barrier(0); }
        st.run(acc, u, wr, wc, fr, fq);
        const LAS f32x2* S = (const LAS f32x2*)(st.scr + 8192) + (wr * 64 + fr);
        EPI_FOR4 { const f32x4 g4 = *(const f32x4*)(lg + (cb + bj * HALF + n * 16) + coff), b4 = *(const f32x4*)(lb + (cb + bj * HALF + n * 16) + coff);
            EPI_ROWS { const f32x2 sr = S[ai * HALF + m * 16];
                __builtin_nontemporal_store((f32x4)((acc[ai][bj][m][n] - sr.x) * sr.y * g4 + b4), (f32x4*)(OUT + (ub + (size_t)((ai * HALF + m * 16) * DM + bj * HALF + n * 16)) + loff)); }
            asm volatile("" ::: "memory"); __builtin_amdgcn_sched_barrier(0); }
    }
};
struct EpiLnMid {
    static constexpr bool PERM = false;
    const float* X; const float* lg; const float* lb; unsigned char* wsb; bf16_t* H2; LAS unsigned char* scr;
    __device__ __forceinline__ void operator()(f32x4 (&acc)[2][2][4][2], const Unit& u, int wr, int wc, int fr, int fq) const {
        const int b = (u.pm * BM) >> 11; const unsigned loff = (unsigned)(fr * DM + 4 * fq), coff = 4 * fq;
        const size_t ub = (size_t)(u.pm * BM + wr * 64) * DM + u.pn * BM + wc * 32; const int cb = u.pn * BM + wc * 32;
        const float* modb = (const float*)(wsb + WS_MOD) + (size_t)b * 6144 + cb; bf16_t* X1 = (bf16_t*)(wsb + WS_X1);
        const PanelStats st1{(unsigned long long*)(wsb + WS_XB1), (unsigned*)(wsb + WS_CNT), scr}, st2{(unsigned long long*)(wsb + WS_XB2), (unsigned*)(wsb + WS_CNT + 32768), scr};
        EPI_FOR4 { const f32x4 gv = *(const f32x4*)(modb + (2048 + bj * HALF + n * 16) + coff);
            EPI_ROWS { const f32x4 xv = *(const f32x4*)(X + (ub + (size_t)((ai * HALF + m * 16) * DM + bj * HALF + n * 16)) + loff);
                acc[ai][bj][m][n] = xv * ALPHA + gv * acc[ai][bj][m][n]; if (m & 1) asm volatile("" ::: "memory"); __builtin_amdgcn_sched_barrier(0); }
            asm volatile("" ::: "memory"); __builtin_amdgcn_sched_barrier(0); }
        st1.run(acc, u, wr, wc, fr, fq);
        { const LAS f32x2* S = (const LAS f32x2*)(st1.scr + 8192) + (wr * 64 + fr);
        EPI_FOR4 { const f32x4 g4 = *(const f32x4*)(lg + (cb + bj * HALF + n * 16) + coff), b4 = *(const f32x4*)(lb + (cb + bj * HALF + n * 16) + coff);
            EPI_ROWS { const f32x2 sr = S[ai * HALF + m * 16];
                const f32x4 o = (acc[ai][bj][m][n] - sr.x) * sr.y * g4 + b4; acc[ai][bj][m][n] = o;
                u32x2 w; w.x = pk2(o[0], o[1]); w.y = pk2(o[2], o[3]);
                *(u32x2*)(X1 + (ub + (size_t)((ai * HALF + m * 16) * DM + bj * HALF + n * 16)) + loff) = w; }
            asm volatile("" ::: "memory"); __builtin_amdgcn_sched_barrier(0); } }
        st2.run(acc, u, wr, wc, fr, fq);
        { const LAS f32x2* S = (const LAS f32x2*)(st2.scr + 8192) + (wr * 64 + fr);
        EPI_FOR4 { const f32x4 sh = *(const f32x4*)(modb + (3072 + bj * HALF + n * 16) + coff), sc = *(const f32x4*)(modb + (4096 + bj * HALF + n * 16) + coff) + 1.0f;
            EPI_ROWS { const f32x2 sr = S[ai * HALF + m * 16];
                const f32x4 o = (acc[ai][bj][m][n] - sr.x) * sr.y * sc + sh;
                u32x2 w; w.x = pk2(o[0], o[1]); w.y = pk2(o[2], o[3]);
                *(u32x2*)(H2 + (ub + (size_t)((ai * HALF + m * 16) * DM + bj * HALF + n * 16)) + loff) = w; }
            asm volatile("" ::: "memory"); __builtin_amdgcn_sched_barrier(0); } }
    }
};
#undef EPI_FOR4
#undef EPI_ROWS
}

__device__ __forceinline__ void tr_item(const float* __restrict__ src, int ld, int k0, int c0, bf16_t* dst, int dstK, int r0, LAS float* scr, int lane) {
    f32x4 t[8];
#pragma unroll
    for (int i = 0; i < 8; ++i) t[i] = *(const f32x4*)(src + (size_t)(k0 + 8 * i + (lane >> 3)) * ld + c0 + 4 * (lane & 7));
#pragma unroll
    for (int i = 0; i < 8; ++i) { LAS float* d = scr + (8 * i + (lane >> 3)) * 33 + 4 * (lane & 7); d[0] = t[i][0]; d[1] = t[i][1]; d[2] = t[i][2]; d[3] = t[i][3]; }
    LDS_WAIT();
    const int c = lane & 7;
#pragma unroll
    for (int j = 0; j < 4; ++j) { const int n = (lane >> 3) + 8 * j; const LAS float* s = scr + (8 * c) * 33 + n;
        u32x4 o; o.x = pk2(s[0 * 33], s[1 * 33]); o.y = pk2(s[2 * 33], s[3 * 33]); o.z = pk2(s[4 * 33], s[5 * 33]); o.w = pk2(s[6 * 33], s[7 * 33]);
        *(u32x4*)(dst + (size_t)(r0 + n) * dstK + k0 + 8 * c) = o; }
    LDS_WAIT();
}

__device__ __forceinline__ void split_arrive(unsigned* ctr);
__device__ __forceinline__ void split_wait(unsigned* ctr, unsigned want);
__device__ __forceinline__ void p0_prologue(LAS unsigned char* lds, const float* const* in, unsigned char* ws, unsigned* ctr) {
    const int tid = threadIdx.x, lane = tid & 63, wave = __builtin_amdgcn_readfirstlane(tid >> 6);
    const int G = gridDim.x;
    {
        const float* c = in[1]; const float* w_ada = in[2]; const float* b_ada = in[3]; float* MOD = (float*)(ws + WS_MOD);
        LAS float* sc = (LAS float*)lds; LAS float* red = (LAS float*)(lds + 65536);
        if ((int)blockIdx.x < 192) {
            for (int idx = tid; idx < 16384; idx += 512) { const int b = idx & 15, k = idx >> 4; const float v = c[b * 1024 + k]; sc[k * 16 + b] = v / (1.0f + expf(-v)); }
            __syncthreads();
            for (int item = blockIdx.x; item < 192; item += G) {
                const int e = item * 32 + (lane & 31), kbase = wave * 128 + (lane >> 5) * 64;
                float acc[16];
#pragma unroll
                for (int b = 0; b < 16; ++b) acc[b] = 0.f;
                for (int kk0 = 0; kk0 < 64; kk0 += 16) {
                    float wv[16];
#pragma unroll
                    for (int i = 0; i < 16; ++i) wv[i] = w_ada[(size_t)(kbase + kk0 + i) * 6144 + e];
#pragma unroll
                    for (int i = 0; i < 16; ++i) { const int k = kbase + kk0 + i; const float w = wv[i];
                        const LAS f32x4* s = (const LAS f32x4*)(sc + k * 16);
#pragma unroll
                        for (int q = 0; q < 4; ++q) { const f32x4 sv = s[q]; acc[4 * q + 0] += sv[0] * w; acc[4 * q + 1] += sv[1] * w; acc[4 * q + 2] += sv[2] * w; acc[4 * q + 3] += sv[3] * w; } } }
#pragma unroll
                for (int b = 0; b < 16; ++b) { acc[b] += __shfl_xor(acc[b], 32); if (lane < 32) red[(wave * 16 + b) * 32 + lane] = acc[b]; }
                __syncthreads();
                { const int b = tid >> 5, col = tid & 31; float s = 0.f;
#pragma unroll
                  for (int w = 0; w < 8; ++w) s += red[(w * 16 + b) * 32 + col];
                  MOD[b * 6144 + item * 32 + col] = s + b_ada[item * 32 + col]; }
                __syncthreads();
            }
        }
        __syncthreads();
    }
    {
        const float* w_in = in[4]; const float* b_in = in[5]; float* WG = (float*)(ws + WS_WG); float* BG = (float*)(ws + WS_BG);
        for (int idx = blockIdx.x * 512 + tid; idx < 16384; idx += G * 512) { const int j = idx >> 10, k = idx & 1023;
            const int col = j < 8 ? 1536 + j : (j < 12 ? 3592 + (j - 8) : 3596 + (j - 12));
            WG[idx] = w_in[(size_t)k * DIN + col]; if (k == 0) BG[j] = b_in[col]; }
    }
    split_arrive(ctr);
    {
        LAS float* scr = (LAS float*)(lds + wave * 16384);
        const int gw = blockIdx.x * 8 + wave, NGW = G * 8;
        constexpr int NITEMS = 3328 + 128 + 256 + 512 + 512 + 2816 + 1408;
        for (int it = gw; it < NITEMS; it += NGW) {
            int r = it; const float* src; int ld, k0, c0, dstK, r0; bf16_t* dst;
            if (r < 3328) { const int kb = r / 208, nb = r % 208, n0 = nb * 32; src = in[4]; ld = DIN; k0 = kb * 64; c0 = n0 + (n0 >= 1536 ? 8 : 0) + (n0 >= 3584 ? 8 : 0); dst = (bf16_t*)(ws + WS_WT_IN); dstK = 1024; r0 = n0; }
            else if ((r -= 3328) < 128) { const int sj = r >> 4, q = r & 15, h = sj >> 1, which = sj & 1, kb = q >> 2, nb = q & 3; src = (which ? in[9] : in[8]) + (size_t)h * 256 * 128; ld = 128; k0 = kb * 64; c0 = nb * 32; dst = (bf16_t*)(ws + WS_WT_QK); dstK = 256; r0 = h * 256 + which * 128 + nb * 32; }
            else if ((r -= 128) < 256) { const int kb = r >> 5, nb = r & 31; src = in[11]; ld = 1024; k0 = kb * 64; c0 = nb * 32; dst = (bf16_t*)(ws + WS_WT_PA); dstK = 512; r0 = nb * 32; }
            else if ((r -= 256) < 512) { const int kb = r >> 5, nb = r & 31; src = in[12]; ld = 1024; k0 = kb * 64; c0 = nb * 32; dst = (bf16_t*)(ws + WS_WT_PB); dstK = 1024; r0 = nb * 32; }
            else if ((r -= 512) < 512) { const int kb = r >> 5, nb = r & 31; src = in[13]; ld = 1024; k0 = kb * 64; c0 = nb * 32; dst = (bf16_t*)(ws + WS_WT_OUT); dstK = 1024; r0 = nb * 32; }
            else if ((r -= 512) < 2816) { const int kb = r / 176, nb = r % 176, n0 = nb * 32, pn = n0 >> 8, hh = (n0 & 255) >> 7, j = n0 & 127; src = in[16]; ld = 2 * DFF; k0 = kb * 64; c0 = hh * DFF + 128 * pn + j; dst = (bf16_t*)(ws + WS_WT_FI); dstK = 1024; r0 = n0; }
            else { r -= 2816; const int kb = r >> 5, nb = r & 31; src = in[17]; ld = 1024; k0 = kb * 64; c0 = nb * 32; dst = (bf16_t*)(ws + WS_WT_FD); dstK = DFF; r0 = nb * 32; }
            tr_item(src, ld, k0, c0, dst, dstK, r0, scr, lane);
        }
    }
    split_wait(ctr, gridDim.x);
}

__device__ __forceinline__ void p1_ln_gates(LAS unsigned char* lds, const float* x, const float* MOD, const float* WG, const float* BG, bf16_t* H1, float* G16) {
    const int tid = threadIdx.x, lane = tid & 63, wave = __builtin_amdgcn_readfirstlane(tid >> 6);
    LAS f32x4* WGl = (LAS f32x4*)lds;
    for (int idx = tid; idx < 4096; idx += 512) WGl[idx] = ((const f32x4*)WG)[idx];
    __syncthreads();
    for (int rp = blockIdx.x * 8 + wave; rp < MT / 2; rp += gridDim.x * 8) {
        const int r0 = 2 * rp, b = r0 >> 11;
        f32x4 v[2][4], shv[4], scv[4];
#pragma unroll
        for (int r = 0; r < 2; ++r)
#pragma unroll
            for (int j = 0; j < 4; ++j) v[r][j] = __builtin_nontemporal_load((const f32x4*)(x + (size_t)(r0 + r) * DM + 4 * lane + 256 * j));
#pragma unroll
        for (int j = 0; j < 4; ++j) { shv[j] = *(const f32x4*)(MOD + (size_t)b * 6144 + 4 * lane + 256 * j); scv[j] = *(const f32x4*)(MOD + (size_t)b * 6144 + 1024 + 4 * lane + 256 * j) + 1.0f; }
        asm volatile("" ::: "memory");
#pragma unroll
        for (int r = 0; r < 2; ++r) {
            float s = 0.f;
#pragma unroll
            for (int j = 0; j < 4; ++j) s += (v[r][j][0] + v[r][j][1]) + (v[r][j][2] + v[r][j][3]);
            const float mean = wave_sum(s) * (1.f / DM); float s2 = 0.f;
#pragma unroll
            for (int j = 0; j < 4; ++j) { v[r][j] = v[r][j] - mean; s2 += (v[r][j][0] * v[r][j][0] + v[r][j][1] * v[r][j][1]) + (v[r][j][2] * v[r][j][2] + v[r][j][3] * v[r][j][3]); }
            const float rstd = 1.f / sqrtf(wave_sum(s2) * (1.f / DM) + LN_EPS);
#pragma unroll
            for (int j = 0; j < 4; ++j) {
                v[r][j] = v[r][j] * rstd * scv[j] + shv[j];
                u32x2 o; o.x = pk2(v[r][j][0], v[r][j][1]); o.y = pk2(v[r][j][2], v[r][j][3]);
                *(u32x2*)(H1 + (size_t)(r0 + r) * DM + 4 * lane + 256 * j) = o; }
        }
        float vals[32];
#pragma unroll
        for (int j16 = 0; j16 < 16; ++j16) { float p0 = 0.f, p1 = 0.f;
#pragma unroll
            for (int q = 0; q < 4; ++q) { const f32x4 w = WGl[j16 * 256 + lane + 64 * q];
                p0 += (v[0][q][0] * w[0] + v[0][q][1] * w[1]) + (v[0][q][2] * w[2] + v[0][q][3] * w[3]);
                p1 += (v[1][q][0] * w[0] + v[1][q][1] * w[1]) + (v[1][q][2] * w[2] + v[1][q][3] * w[3]); }
            vals[j16] = p0; vals[16 + j16] = p1; asm volatile("" ::: "memory"); }
#define BFLY(N, MASK) { const bool up = (lane & MASK) != 0; _Pragma("unroll") for (int i = 0; i < N; ++i) { const float lo = vals[i], hi = vals[i + N]; const float send = up ? lo : hi, keep = up ? hi : lo; vals[i] = keep + __shfl_xor(send, MASK); } }
        BFLY(16, 32) BFLY(8, 16) BFLY(4, 8) BFLY(2, 4) BFLY(1, 2)
#undef BFLY
        const float tot = vals[0] + __shfl_xor(vals[0], 1);
        const int idx = lane >> 1;
        if (!(lane & 1)) G16[(size_t)(r0 + (idx >> 4)) * 16 + (idx & 15)] = tot + BG[idx & 15];
    }
}

__device__ __forceinline__ void fscan(LAS unsigned char* lds, const float* G16, float* FCUM) {
    const int tid = threadIdx.x, lane = tid & 63, wave = __builtin_amdgcn_readfirstlane(tid >> 6);
    LAS float* wsum = (LAS float*)lds;
    for (int s = blockIdx.x; s < 128; s += gridDim.x) {
        const int b = s >> 3, hh = s & 7;
        float v[4];
#pragma unroll
        for (int i = 0; i < 4; ++i) v[i] = logsig(G16[(size_t)(b * SEQ + 4 * tid + i) * 16 + hh]) * LOG2E;
        v[1] += v[0]; v[2] += v[1]; v[3] += v[2];
        const float tot = v[3]; float sc = tot;
#pragma unroll
        for (int o = 1; o < 64; o <<= 1) { const float y = __shfl_up(sc, o); if (lane >= o) sc += y; }
        if (lane == 63) wsum[wave] = sc;
        __syncthreads();
        float off = 0.f;
        for (int w = 0; w < wave; ++w) off += wsum[w];
        const float excl = off + sc - tot;
#pragma unroll
        for (int i = 0; i < 4; ++i) FCUM[(size_t)s * SEQ + 4 * tid + i] = v[i] + excl;
        __syncthreads();
    }
}

__device__ __forceinline__ void conv_phase(const bf16_t* PROJ, const float* conv_w, const float* conv_b, bf16_t* U) {
    const int tid = threadIdx.x, lane = tid & 63, wave = __builtin_amdgcn_readfirstlane(tid >> 6);
    const int gw = blockIdx.x * 8 + wave, NGW = gridDim.x * 8;
    for (int it = gw; it < 4096; it += NGW) {
        const int rg = it >> 1, chf = it & 1, m0 = rg * 16, c = chf * 512 + lane * 8;
        float w[4][8], cb[8];
#pragma unroll
        for (int j = 0; j < 4; ++j) { const f32x4 a = *(const f32x4*)(conv_w + j * 1024 + c), bq = *(const f32x4*)(conv_w + j * 1024 + c + 4);
            w[j][0] = a[0]; w[j][1] = a[1]; w[j][2] = a[2]; w[j][3] = a[3]; w[j][4] = bq[0]; w[j][5] = bq[1]; w[j][6] = bq[2]; w[j][7] = bq[3]; }
        { const f32x4 a = *(const f32x4*)(conv_b + c), bq = *(const f32x4*)(conv_b + c + 4); cb[0] = a[0]; cb[1] = a[1]; cb[2] = a[2]; cb[3] = a[3]; cb[4] = bq[0]; cb[5] = bq[1]; cb[6] = bq[2]; cb[7] = bq[3]; }
        const bool has_prev = (m0 & (SEQ - 1)) != 0;
        u32x4 raw[19];
#pragma unroll
        for (int j = 0; j < 3; ++j) { raw[j] = (u32x4){0u, 0u, 0u, 0u}; if (has_prev) raw[j] = __builtin_nontemporal_load((const u32x4*)(PROJ + (size_t)(m0 - 3 + j) * NP + C_MU + c)); }
#pragma unroll
        for (int r = 0; r < 16; ++r) raw[3 + r] = __builtin_nontemporal_load((const u32x4*)(PROJ + (size_t)(m0 + r) * NP + C_MU + c));
#pragma unroll
        for (int r = 0; r < 16; ++r) {
            float x0[8], x1[8], x2[8], x3[8]; unpack8(raw[r], x0); unpack8(raw[r + 1], x1); unpack8(raw[r + 2], x2); unpack8(raw[r + 3], x3);
            float y[8];
#pragma unroll
            for (int e = 0; e < 8; ++e) { const float t = w[0][e] * x0[e] + w[1][e] * x1[e] + w[2][e] * x2[e] + w[3][e] * x3[e] + cb[e]; y[e] = t * sigmoidf_(t); }
            *(u32x4*)(U + (size_t)(m0 + r) * DM + c) = pack8(y);
        }
    }
}


namespace fox_attn {
using bf16=__hip_bfloat16;
using bf16x8=__attribute__((ext_vector_type(8)))short;
using s16x4=__attribute__((ext_vector_type(4)))short;
using f32x16=__attribute__((ext_vector_type(16)))float;
using u32x4=__attribute__((ext_vector_type(4)))unsigned;
using f32x4v=__attribute__((ext_vector_type(4)))float;
constexpr int BATCH=16,NHEAD=8,SEQ=2048,D=64,DM=6656,OP=512;
constexpr int NW=8,QBLK=32,QB=QBLK*NW,KVBLK=64,NQB=SEQ/QB;
constexpr int ATTN_UNIT_ROWS=QB;
__device__ __forceinline__ int crow(int r,int hi){return (r&3)+8*(r>>2)+4*hi;}
#define SBAR() __builtin_amdgcn_sched_barrier(0)
__device__ __forceinline__ void cmask(f32x16&p0,f32x16&p1,int jb,int qrel,int hi){
  const float NEG=-INFINITY; int kb=64*jb+4*hi;
  #pragma unroll
  for(int r=0;r<16;++r){int kv=kb+(r&3)+8*(r>>2); if(kv>qrel)p0[r]=NEG; if(kv+32>qrel)p1[r]=NEG;}
}

constexpr int NSLOT=3, SLOTB=8192;
constexpr int LDS_K=0, LDS_V=NSLOT*SLOTB, LDS_WS=2*NSLOT*SLOTB, LDS_OST=LDS_WS+NW*64*4, LDS_BYTES=LDS_OST+NW*4096;
constexpr float C2=0.125f*1.4426950408889634f;
__device__ __forceinline__ void glds16(const void*gsrc,unsigned lds_dst){unsigned keep;
  asm volatile("s_mov_b32 %0, m0\n\ts_mov_b32 m0, %2\n\ts_nop 0\n\tglobal_load_lds_dwordx4 %1, off\n\ts_mov_b32 m0, %0":"=&s"(keep):"v"(gsrc),"s"(lds_dst):"memory");}
__device__ __forceinline__ float max3f(float a,float b,float c){float r;asm("v_max3_f32 %0, %1, %2, %3":"=v"(r):"v"(a),"v"(b),"v"(c));return r;}
__device__ __forceinline__ float max2f(float a,float b){float r;asm("v_max_f32_e32 %0, %1, %2":"=v"(r):"v"(a),"v"(b));return r;}
__device__ __forceinline__ float fadd_s(float a,float b){float r;asm("v_add_f32_e32 %0, %1, %2":"=v"(r):"v"(a),"v"(b));return r;}
__device__ __forceinline__ float fsub_s(float a,float b){float r;asm("v_sub_f32_e32 %0, %1, %2":"=v"(r):"v"(a),"v"(b));return r;}
typedef float f32x2_t __attribute__((ext_vector_type(2))); typedef __bf16 bf16x2_t __attribute__((ext_vector_type(2)));
__device__ __forceinline__ unsigned cvtpk_s(float lo,float hi){f32x2_t v={lo,hi};bf16x2_t b=__builtin_convertvector(v,bf16x2_t);return __builtin_bit_cast(unsigned,b);}
#define WAIT_BAR(N) asm volatile("s_waitcnt vmcnt(" #N ") lgkmcnt(0)\n\ts_barrier":::"memory")

__device__ __forceinline__ void qkt(f32x16&p0,f32x16&p1,const char*Kslot,const bf16x8*qr,const f32x16&negm,int r32,int hi){
  const char*kb=Kslot+hi*1024+r32*16;
  #pragma unroll
  for(int d0=0;d0<4;++d0){
    const bf16x8 b0=*reinterpret_cast<const bf16x8*>(kb+d0*2048);
    const bf16x8 b1=*reinterpret_cast<const bf16x8*>(kb+d0*2048+512);
    if(d0==0){p0=__builtin_amdgcn_mfma_f32_32x32x16_bf16(b0,qr[0],negm,0,0,0);p1=__builtin_amdgcn_mfma_f32_32x32x16_bf16(b1,qr[0],negm,0,0,0);}
    else{p0=__builtin_amdgcn_mfma_f32_32x32x16_bf16(b0,qr[d0],p0,0,0,0);p1=__builtin_amdgcn_mfma_f32_32x32x16_bf16(b1,qr[d0],p1,0,0,0);}}
}
typedef __attribute__((address_space(3))) const char* lds_cptr;
typedef short v4i16_t __attribute__((ext_vector_type(4)));
__device__ __forceinline__ void kload8(bf16x8*kf,lds_cptr kp){
  kf[0]=*(const __attribute__((address_space(3))) bf16x8*)(kp);      kf[1]=*(const __attribute__((address_space(3))) bf16x8*)(kp+512);
  kf[2]=*(const __attribute__((address_space(3))) bf16x8*)(kp+2048); kf[3]=*(const __attribute__((address_space(3))) bf16x8*)(kp+2560);
  kf[4]=*(const __attribute__((address_space(3))) bf16x8*)(kp+4096); kf[5]=*(const __attribute__((address_space(3))) bf16x8*)(kp+4608);
  kf[6]=*(const __attribute__((address_space(3))) bf16x8*)(kp+6144); kf[7]=*(const __attribute__((address_space(3))) bf16x8*)(kp+6656);
}
__device__ __forceinline__ void kload2(bf16x8*kf,lds_cptr kp,int j){ kf[2*j]=*(const __attribute__((address_space(3))) bf16x8*)(kp+j*2048); kf[2*j+1]=*(const __attribute__((address_space(3))) bf16x8*)(kp+j*2048+512); }
__device__ __forceinline__ s16x4 vtr(lds_cptr p){ return __builtin_bit_cast(s16x4,__builtin_amdgcn_ds_read_tr16_b64_v4i16((__attribute__((address_space(3))) v4i16_t*)p)); }
__device__ __forceinline__ float rowmax(const f32x16&p0,const f32x16&p1){
  float a=max3f(p0[0],p0[1],p1[0]),b=max3f(p0[2],p0[3],p1[1]);a=max3f(a,p1[2],p1[3]);
  #pragma unroll
  for(int r=4;r<16;r+=4){a=max3f(a,p0[r],p0[r+1]);b=max3f(b,p0[r+2],p0[r+3]);a=max3f(a,p1[r],p1[r+1]);b=max3f(b,p1[r+2],p1[r+3]);}
  const float m=max2f(a,b);
  auto rr=__builtin_amdgcn_permlane32_swap(__float_as_uint(m),__float_as_uint(m),false,false);
  return max2f(__uint_as_float(rr[0]),__uint_as_float(rr[1]));
}
__device__ __forceinline__ void pv(f32x16*o,int vb,bf16x8 pa0,bf16x8 pa1,bf16x8 pa2,bf16x8 pa3){
  #pragma unroll
  for(int d0=0;d0<2;++d0){s16x4 lo[4],hi[4];
    #pragma unroll
    for(int ks=0;ks<4;++ks){
      asm volatile("ds_read_b64_tr_b16 %0,%1 offset:%c2":"=&v"(lo[ks]):"v"(vb),"i"(d0*4096+ks*1024):"memory");
      asm volatile("ds_read_b64_tr_b16 %0,%1 offset:%c2":"=&v"(hi[ks]):"v"(vb),"i"(d0*4096+ks*1024+512):"memory");}
    asm volatile("s_waitcnt lgkmcnt(0)":::"memory");SBAR();
    #define PK(k) (bf16x8){lo[k][0],lo[k][1],lo[k][2],lo[k][3],hi[k][0],hi[k][1],hi[k][2],hi[k][3]}
    o[d0]=__builtin_amdgcn_mfma_f32_32x32x16_bf16(pa0,PK(0),o[d0],0,0,0);
    o[d0]=__builtin_amdgcn_mfma_f32_32x32x16_bf16(pa1,PK(1),o[d0],0,0,0);
    o[d0]=__builtin_amdgcn_mfma_f32_32x32x16_bf16(pa2,PK(2),o[d0],0,0,0);
    o[d0]=__builtin_amdgcn_mfma_f32_32x32x16_bf16(pa3,PK(3),o[d0],0,0,0);
    #undef PK
  }
}

#ifndef ATTN_STORE16
#define ATTN_STORE16(p,v) (*(u32x4*)(p)=(v))
#endif
template<int THRL> __device__ __forceinline__ void attn_unit(int b,int h,int qb,const bf16*Q,const bf16*__restrict__ K,const bf16*__restrict__ V,bf16*O,const float*__restrict__ Frow,char*shm){
  int tid_=threadIdx.x; asm volatile("":"+v"(tid_));
  const int tid=tid_,lane=tid&63,r32=lane&31,hi=lane>>5; const int wid=__builtin_amdgcn_readfirstlane(tid>>6);
  const long rowbase=(long)b*SEQ; const int q0=qb*QB;
  const bf16*Qw=Q+(rowbase+q0+wid*QBLK)*DM+h*D;
  const bf16*Kh=K+rowbase*DM+h*D,*Vh=V+rowbase*DM+h*D;
  const unsigned lds0=(unsigned)(uintptr_t)shm;
  float*wsf=(float*)(shm+LDS_WS)+wid*64;
  const bf16*ksrc=Kh+(long)lane*DM+wid*8;
  const bf16*vsrc=Vh+(long)(16*(wid&3)+(lane>>2))*DM+(wid>>2)*32+(lane&3)*8;
  const unsigned kdst=lds0+LDS_K+wid*1024, vdst=lds0+LDS_V+wid*1024;
  #define DMA_K(t,slot) glds16(ksrc+(long)(t)*KVBLK*DM,(unsigned)__builtin_amdgcn_readfirstlane(kdst+(slot)))
  #define DMA_V(t,slot) glds16(vsrc+(long)(t)*KVBLK*DM,(unsigned)__builtin_amdgcn_readfirstlane(vdst+(slot)))
  const int vb0=(int)(lds0+LDS_V)+((lane>>4)&1)*32+(lane&3)*8+(4*hi+((lane&15)>>2))*64;
  const char*Kbase=shm+LDS_K; bf16x8 kf[8];
  const lds_cptr shm3=(lds_cptr)shm; const lds_cptr kp0=shm3+LDS_K+hi*1024+r32*16; const lds_cptr vp0=shm3+LDS_V+((lane>>4)&1)*32+(lane&3)*8+(4*hi+((lane&15)>>2))*64;
  const int NT=(q0+QB)/KVBLK;
  float*nfk=(float*)(shm+LDS_BYTES);
  for(int i=tid;i<NT*KVBLK;i+=512)nfk[i]=-Frow[i];
  asm volatile("s_waitcnt vmcnt(0) lgkmcnt(0)\n\ts_barrier":::"memory");
  #define BIAS(P0,P1,t) do{ const float*nb_=nfk+(t)*KVBLK+4*hi; const float mh_=mhat; _Pragma("unroll") for(int r_=0;r_<16;++r_){ P0[r_]+=nb_[(r_&3)+8*(r_>>2)]-mh_; } \
      _Pragma("unroll") for(int r_=0;r_<16;++r_){ P1[r_]+=nb_[(r_&3)+8*(r_>>2)+32]-mh_; } }while(0)
  DMA_K(0,0);DMA_V(0,0);DMA_K(1,SLOTB);
  bf16x8 qr[4];
  #pragma unroll
  for(int d0=0;d0<4;++d0){ const u32x4 qw_=*reinterpret_cast<const u32x4*>(&Qw[(long)r32*DM+d0*16+hi*8]); u32x4 qs_;
    #define QSC(w) cvtpk_s(__uint_as_float((w)<<16)*C2,__uint_as_float((w)&0xffff0000u)*C2)
    qs_.x=QSC(qw_.x);qs_.y=QSC(qw_.y);qs_.z=QSC(qw_.z);qs_.w=QSC(qw_.w);
    #undef QSC
    qr[d0]=__builtin_bit_cast(bf16x8,qs_); }
  float mhat=0.f,l_reg=0.f;f32x16 o[2];o[0]=f32x16{};o[1]=f32x16{};const f32x16 negm=f32x16{};
  const int qrel=wid*QBLK+r32;
  #define CMASK(P0,P1,t) do{int jb_=(t)-(NT-4); if(jb_>=0)cmask(P0,P1,jb_,qrel,hi);}while(0)
  bool resc=false;
  #define START(P0,P1) do{ const float rm=rowmax(P0,P1); resc=false; \
    { const float dl=rm; mhat=fadd_s(mhat,dl); \
      _Pragma("unroll") for(int r=0;r<16;++r){P0[r]=fsub_s(P0[r],dl);P1[r]=fsub_s(P1[r],dl);} \
        } \
    _Pragma("unroll") for(int r=0;r<16;++r)P0[r]=__builtin_amdgcn_exp2f(P0[r]); }while(0)
  #define RESC() do{ if(resc){ asm volatile("s_waitcnt lgkmcnt(0)":::"memory"); \
      _Pragma("unroll") for(int d_=0;d_<2;++d_) _Pragma("unroll") for(int r=0;r<16;++r)o[d_][r]*=wsf[crow(r,hi)]; } }while(0)
  f32x16 pA0,pA1,pB0,pB1;
  int sl_prev=0,sl_cur=0,sl_next=SLOTB;
  #define ROT() do{sl_prev=sl_cur;sl_cur=sl_next;sl_next=(sl_next==(NSLOT-1)*SLOTB)?0:sl_next+SLOTB;}while(0)
  DMA_K(2,2*SLOTB);
  WAIT_BAR(3);
  qkt(pA0,pA1,Kbase,qr,negm,r32,hi);asm volatile("s_nop 15\n\ts_nop 7":"+v"(pA0),"+v"(pA1));BIAS(pA0,pA1,0);CMASK(pA0,pA1,0);
  START(pA0,pA1);
  _Pragma("unroll") for(int r=0;r<16;++r)pA1[r]=__builtin_amdgcn_exp2f(pA1[r]);
  WAIT_BAR(0);
  DMA_K(3,0);DMA_V(1,SLOTB);
  ROT();
  kload8(kf,kp0+sl_cur);
  WAIT_BAR(2);
  s16x4 vlo[8],vhi[8]; u32x4 pw0,pw1,pw2,pw3;
  #define PKW(P,B) cvtpk_s(P[B],P[B+1])
  #define PAF(k) __builtin_bit_cast(bf16x8,pw##k)
  #define VFR(i) (bf16x8){vlo[i][0],vlo[i][1],vlo[i][2],vlo[i][3],vhi[i][0],vhi[i][1],vhi[i][2],vhi[i][3]}
  #define PIN(x) asm volatile("":"+v"(x))
  #define MX3(a,b,c) __builtin_fmaxf(__builtin_fmaxf((a),(b)),(c))
  #define GAPA(MF,A0,A1,A2,A3,W0,W1,PW) do{ MF; sacc+=A0; sacc+=A1; sacc+=A2; sacc+=A3; PIN(sacc); W0; W1; PIN(PW); SBAR(); }while(0)
  #define EX(v) __builtin_amdgcn_exp2f(v)
  #define GAPB(MF,X,B) do{ MF; X[B]=EX(X[B]); X[B+1]=EX(X[B+1]); X[B+2]=EX(X[B+2]); X[B+3]=EX(X[B+3]); PIN(X); SBAR(); }while(0)
  #define VRD(i) do{ vlo[i]=vtr(vp_+(((i)>>2)*4096+((i)&3)*1024)); vhi[i]=vtr(vp_+(((i)>>2)*4096+((i)&3)*1024+512)); }while(0)
  #define KRD(G,j) do{ if(G){ kload2(kf,kp0+sl_next,j); SBAR(); } }while(0)
  #define STEP(C0,C1,P0,P1,t,GK,GV,GL) do{ SBAR(); \
    const lds_cptr vp_=vp0+sl_prev; \
    VRD(0); SBAR(); float sacc=(P0[0]+P0[1]); \
    GAPA(C0=__builtin_amdgcn_mfma_f32_32x32x16_bf16(kf[0],qr[0],negm,0,0,0), P0[2],P0[3],P0[4],P0[5],     pw0[0]=PKW(P0,0), pw0[1]=PKW(P0,2), pw0); \
    VRD(4); SBAR(); GAPA(C1=__builtin_amdgcn_mfma_f32_32x32x16_bf16(kf[1],qr[0],negm,0,0,0), P0[6],P0[7],P0[8],P0[9],     pw0[2]=PKW(P0,4), pw0[3]=PKW(P0,6), pw0); \
    VRD(1); SBAR(); GAPA(C0=__builtin_amdgcn_mfma_f32_32x32x16_bf16(kf[2],qr[1],C0,0,0,0),   P0[10],P0[11],P0[12],P0[13], pw1[0]=PKW(P0,8), pw1[1]=PKW(P0,10), pw1); \
    VRD(5); SBAR(); GAPA(C1=__builtin_amdgcn_mfma_f32_32x32x16_bf16(kf[3],qr[1],C1,0,0,0),   P0[14],P0[15],P1[0],P1[1],   pw1[2]=PKW(P0,12),pw1[3]=PKW(P0,14), pw1); \
    VRD(2); SBAR(); GAPA(C0=__builtin_amdgcn_mfma_f32_32x32x16_bf16(kf[4],qr[2],C0,0,0,0),   P1[2],P1[3],P1[4],P1[5],     pw2[0]=PKW(P1,0), pw2[1]=PKW(P1,2), pw2); \
    VRD(6); SBAR(); GAPA(C1=__builtin_amdgcn_mfma_f32_32x32x16_bf16(kf[5],qr[2],C1,0,0,0),   P1[6],P1[7],P1[8],P1[9],     pw2[2]=PKW(P1,4), pw2[3]=PKW(P1,6), pw2); \
    VRD(3); SBAR(); GAPA(C0=__builtin_amdgcn_mfma_f32_32x32x16_bf16(kf[6],qr[3],C0,0,0,0),   P1[10],P1[11],P1[12],P1[13], pw3[0]=PKW(P1,8), pw3[1]=PKW(P1,10), pw3); \
    VRD(7); SBAR(); GAPA(C1=__builtin_amdgcn_mfma_f32_32x32x16_bf16(kf[7],qr[3],C1,0,0,0),   P1[14],P1[15],0.f,0.f,       pw3[2]=PKW(P1,12),pw3[3]=PKW(P1,14), pw3); \
    l_reg+=sacc; \
    if(GK){DMA_K((t)+3,sl_cur);} if(GV){DMA_V((t)+1,sl_next);} \
    BIAS(C0,C1,t); CMASK(C0,C1,t); \
    { float a=MX3(C0[0],C0[1],C1[0]),b=MX3(C0[2],C0[3],C1[1]); a=MX3(a,C1[2],C1[3]); \
      _Pragma("unroll") for(int r=4;r<16;r+=4){a=MX3(a,C0[r],C0[r+1]);b=MX3(b,C0[r+2],C0[r+3]);a=MX3(a,C1[r],C1[r+1]);b=MX3(b,C1[r+2],C1[r+3]);} \
      float rm=__builtin_fmaxf(a,b); { auto rr=__builtin_amdgcn_permlane32_swap(__float_as_uint(rm),__float_as_uint(rm),false,false); rm=__builtin_fmaxf(__uint_as_float(rr[0]),__uint_as_float(rr[1])); } \
      resc=false; \
      if(__builtin_expect(__any(rm>(float)THRL),0)){ const float dl=__builtin_fmaxf(rm,0.f); mhat+=dl; \
        _Pragma("unroll") for(int r=0;r<16;++r){C0[r]-=dl;C1[r]-=dl;} \
          \
        const float f=__builtin_amdgcn_exp2f(-dl); l_reg*=f; if(hi==0)wsf[r32]=f; resc=true; } } \
    SBAR(); \
    GAPB(o[0]=__builtin_amdgcn_mfma_f32_32x32x16_bf16(PAF(0),VFR(0),o[0],0,0,0), C0,0); \
    GAPB(o[1]=__builtin_amdgcn_mfma_f32_32x32x16_bf16(PAF(0),VFR(4),o[1],0,0,0), C0,4); \
    KRD(GL,0); GAPB(o[0]=__builtin_amdgcn_mfma_f32_32x32x16_bf16(PAF(1),VFR(1),o[0],0,0,0), C0,8); \
    KRD(GL,1); GAPB(o[1]=__builtin_amdgcn_mfma_f32_32x32x16_bf16(PAF(1),VFR(5),o[1],0,0,0), C0,12); \
    KRD(GL,2); GAPB(o[0]=__builtin_amdgcn_mfma_f32_32x32x16_bf16(PAF(2),VFR(2),o[0],0,0,0), C1,0); \
    KRD(GL,3); GAPB(o[1]=__builtin_amdgcn_mfma_f32_32x32x16_bf16(PAF(2),VFR(6),o[1],0,0,0), C1,4); \
    GAPB(o[0]=__builtin_amdgcn_mfma_f32_32x32x16_bf16(PAF(3),VFR(3),o[0],0,0,0), C1,8); \
    GAPB(o[1]=__builtin_amdgcn_mfma_f32_32x32x16_bf16(PAF(3),VFR(7),o[1],0,0,0), C1,12); \
    }while(0)
  int t=1;
  #undef CMASK
  #define CMASK(P0,P1,t) do{}while(0)
  for(;t+5<NT;t+=2){
    STEP(pB0,pB1,pA0,pA1,t,true,true,true);     WAIT_BAR(2); RESC(); ROT();
    STEP(pA0,pA1,pB0,pB1,t+1,true,true,true);   WAIT_BAR(2); RESC(); ROT();
  }
  #undef CMASK
  #define CMASK(P0,P1,t) do{int jb_=(t)-(NT-4); if(jb_>=0)cmask(P0,P1,jb_,qrel,hi);}while(0)
  #define ENDW(tt) do{ if((tt)+3<NT){WAIT_BAR(2);} else if((tt)+2<NT){WAIT_BAR(1);} else {WAIT_BAR(0);} }while(0)
  for(;t+1<NT;t+=2){
    STEP(pB0,pB1,pA0,pA1,t,(t+3<NT),(t+1<NT),(t+1<NT));       ENDW(t);   RESC(); ROT();
    STEP(pA0,pA1,pB0,pB1,t+1,(t+4<NT),(t+2<NT),(t+2<NT));     ENDW(t+1); RESC(); ROT();
  }
  STEP(pB0,pB1,pA0,pA1,NT-1,false,false,false); RESC();
  { float sacc=pB0[0]+pB0[1]; _Pragma("unroll") for(int r=2;r<16;++r)sacc+=pB0[r]; _Pragma("unroll") for(int r=0;r<16;++r)sacc+=pB1[r]; l_reg+=sacc;
    pw0=(u32x4){PKW(pB0,0),PKW(pB0,2),PKW(pB0,4),PKW(pB0,6)};pw1=(u32x4){PKW(pB0,8),PKW(pB0,10),PKW(pB0,12),PKW(pB0,14)};pw2=(u32x4){PKW(pB1,0),PKW(pB1,2),PKW(pB1,4),PKW(pB1,6)};pw3=(u32x4){PKW(pB1,8),PKW(pB1,10),PKW(pB1,12),PKW(pB1,14)};
    SBAR(); pv(o,vb0+sl_cur,PAF(0),PAF(1),PAF(2),PAF(3)); }
  #undef PKW
  #undef PAF
  #undef VFR
  #undef PIN
  #undef MX3
  #undef GAPA
  #undef GAPB
  #undef EX
  #undef VRD
  #undef KRD
  #undef STEP
  #undef ENDW
  {auto rr=__builtin_amdgcn_permlane32_swap(__float_as_uint(l_reg),__float_as_uint(l_reg),false,false);l_reg=__uint_as_float(rr[0])+__uint_as_float(rr[1]);}
  if(hi==0)wsf[32+r32]=l_reg;asm volatile("s_waitcnt lgkmcnt(0)":::"memory");
  float rli[16];
  #pragma unroll
  for(int r=0;r<16;++r)rli[r]=__builtin_amdgcn_rcpf(wsf[32+crow(r,hi)]);
  bf16*Ow=O+(rowbase+q0+wid*QBLK)*OP+h*D;
  { bf16*stg=(bf16*)(shm+LDS_OST)+wid*2048;
    #pragma unroll
    for(int r=0;r<16;++r){const int orow=crow(r,hi);
      #pragma unroll
      for(int d0=0;d0<2;++d0)stg[orow*64+d0*32+r32]=__float2bfloat16(o[d0][r]*rli[r]);}
    asm volatile("s_waitcnt lgkmcnt(0)":::"memory");
    #pragma unroll
    for(int i=0;i<4;++i){const int row=i*8+(lane>>3),ch=lane&7; const u32x4 v=*(const u32x4*)(stg+row*64+ch*8); ATTN_STORE16(Ow+(long)row*OP+ch*8,v);} }
  asm volatile("s_waitcnt lgkmcnt(0)\n\ts_barrier":::"memory");
  #undef BIAS
  #undef DMA_K
  #undef DMA_V
  #undef CMASK
  #undef START
  #undef RESC
  #undef ROT
}
constexpr int ATTN_LDS_BYTES=LDS_BYTES+8192;
#undef SBAR
#undef WAIT_BAR
}

__device__ __forceinline__ void attn_phase_ref(char* shm, const bf16_t* PROJ, const float* FCUM, bf16_t* ATT) {
    const int vblk = (gridDim.x % 8 == 0) ? (int)((blockIdx.x & 7) * (gridDim.x >> 3) + (blockIdx.x >> 3)) : (int)blockIdx.x;
    for (int uid = vblk; uid < 1024; uid += gridDim.x) {
        const int round = uid >> 8, v = uid & 255, bh = v >> 1, par = v & 1, b = bh >> 3, hh = bh & 7;
        const int qb = par ? (round == 0 ? 1 : round == 1 ? 6 : round == 2 ? 3 : 4) : (round == 0 ? 0 : round == 1 ? 7 : round == 2 ? 2 : 5);
        fox_attn::attn_unit<8>(b, hh, qb, (const fox_attn::bf16*)(PROJ + C_FQ), (const fox_attn::bf16*)(PROJ + C_FK), (const fox_attn::bf16*)(PROJ + C_FV), (fox_attn::bf16*)ATT, FCUM + (size_t)bh * SEQ, shm);
    }
}

__device__ __forceinline__ float xmax16(float m) { auto r = __builtin_amdgcn_permlane16_swap(__float_as_uint(m), __float_as_uint(m), false, false); return fmaxf(__uint_as_float(r[0]), __uint_as_float(r[1])); }
__device__ __forceinline__ float xmax32(float m) { auto r = __builtin_amdgcn_permlane32_swap(__float_as_uint(m), __float_as_uint(m), false, false); return fmaxf(__uint_as_float(r[0]), __uint_as_float(r[1])); }
__device__ __forceinline__ float xadd16(float m) { auto r = __builtin_amdgcn_permlane16_swap(__float_as_uint(m), __float_as_uint(m), false, false); return __uint_as_float(r[0]) + __uint_as_float(r[1]); }
__device__ __forceinline__ float xadd32(float m) { auto r = __builtin_amdgcn_permlane32_swap(__float_as_uint(m), __float_as_uint(m), false, false); return __uint_as_float(r[0]) + __uint_as_float(r[1]); }
template <bool MASK> struct BoolC { static constexpr bool value = MASK; };
__device__ __forceinline__ void attn_phase(LAS unsigned char* lds, const bf16_t* PROJ, const float* FCUM, bf16_t* ATT) {
    const int tid = threadIdx.x, lane = tid & 63, wave = __builtin_amdgcn_readfirstlane(tid >> 6);
    const int g = lane >> 4, c16 = lane & 15, q4 = (lane & 15) >> 2, p4 = lane & 3;
    LAS unsigned char* Ks = lds;
    constexpr float C1 = 0.125f * LOG2E;
    const int lrow = tid >> 3, lch = tid & 7;
    const int vblk = (gridDim.x % 8 == 0) ? (int)((blockIdx.x & 7) * (gridDim.x >> 3) + (blockIdx.x >> 3)) : (int)blockIdx.x;
    for (int uid = vblk; uid < 1024; uid += gridDim.x) {
        const int round = uid >> 8, v = uid & 255, bh = v >> 1, par = v & 1, b = bh >> 3, hh = bh & 7;
        const int qb = par ? (round == 0 ? 1 : round == 1 ? 6 : round == 2 ? 3 : 4) : (round == 0 ? 0 : round == 1 ? 7 : round == 2 ? 2 : 5);
        const int q0 = qb * 256, NT = 4 * (qb + 1);
        const size_t rowbase = (size_t)b * SEQ;
        bf16x8 qf[2][2]; float mrun[2], lrun[2]; f32x4 acc[2][4];
#pragma unroll
        for (int qt = 0; qt < 2; ++qt) { const int qr = q0 + 32 * wave + 16 * qt + c16;
#pragma unroll
            for (int kd = 0; kd < 2; ++kd) qf[qt][kd] = *(const bf16x8*)(PROJ + (rowbase + qr) * NP + C_FQ + hh * 64 + 32 * kd + 8 * g);
            mrun[qt] = -1e30f; lrun[qt] = 0.f;
#pragma unroll
            for (int dt = 0; dt < 4; ++dt) acc[qt][dt] = (f32x4){0.f, 0.f, 0.f, 0.f}; }
        u32x4 kreg[2], vreg[2]; float freg[2];
#define ATT_LOAD(tt, S) do { const size_t r_ = rowbase + (size_t)(tt) * 64 + lrow; \
            kreg[S] = *(const u32x4*)(PROJ + r_ * NP + C_FK + hh * 64 + lch * 8); vreg[S] = *(const u32x4*)(PROJ + r_ * NP + C_FV + hh * 64 + lch * 8); \
            freg[S] = FCUM[(size_t)bh * SEQ + (tt) * 64 + (tid & 63)]; } while (0)
#define ATT_STORE(tt, S) do { LAS unsigned char* kb_ = Ks + ((tt) & 1) * 18688; \
            *(LAS u32x4*)(kb_ + lrow * 128 + ((lch ^ ((lrow >> 1) & 7)) * 16)) = kreg[S]; *(LAS u32x4*)(kb_ + 9216 + lrow * 144 + lch * 16) = vreg[S]; if (tid < 64) ((LAS float*)(kb_ + 18432))[tid] = -freg[S]; } while (0)
        ATT_LOAD(0, 0); ATT_LOAD(1, 1);
        LBAR();
        ATT_STORE(0, 0);
        LBAR();
        auto tile = [&](const int t, auto maskc) {
            constexpr bool MASK = decltype(maskc)::value;
            const LAS unsigned char* Kb = Ks + (t & 1) * 18688; const LAS unsigned char* Vb = Kb + 9216; const LAS float* fb = (const LAS float*)(Kb + 18432);
            if (!MASK || 64 * t <= q0 + 32 * wave + 31) {
                f32x4 s[4][2];
#pragma unroll
                for (int kt = 0; kt < 4; ++kt) {
#pragma unroll
                    for (int kd = 0; kd < 2; ++kd) { const bf16x8 kf = *(const LAS bf16x8*)(Kb + (16 * kt + c16) * 128 + (((4 * kd + g) ^ ((c16 >> 1) & 7)) * 16));
#pragma unroll
                        for (int qt = 0; qt < 2; ++qt) s[kt][qt] = __builtin_amdgcn_mfma_f32_16x16x32_bf16(kf, qf[qt][kd], kd == 0 ? (f32x4){0.f, 0.f, 0.f, 0.f} : s[kt][qt], 0, 0, 0); } }
#pragma unroll
                for (int kt = 0; kt < 4; ++kt) { const f32x4 nfk = *(const LAS f32x4*)(fb + 16 * kt + 4 * g);
#pragma unroll
                    for (int qt = 0; qt < 2; ++qt) { s[kt][qt] = s[kt][qt] * C1 + nfk;
                        if (MASK) {
#pragma unroll
                            for (int i = 0; i < 4; ++i) { const int kv = 64 * t + 16 * kt + 4 * g + i, qq = q0 + 32 * wave + 16 * qt + c16; if (kv > qq) s[kt][qt][i] = -1e30f; } } } }
                bf16x8 pf[2][2];
#pragma unroll
                for (int qt = 0; qt < 2; ++qt) {
                    float m0 = fmaxf(fmaxf(s[0][qt][0], s[0][qt][1]), fmaxf(s[0][qt][2], s[0][qt][3]));
#pragma unroll
                    for (int kt = 1; kt < 4; ++kt) { m0 = fmaxf(fmaxf(m0, s[kt][qt][0]), s[kt][qt][1]); m0 = fmaxf(fmaxf(m0, s[kt][qt][2]), s[kt][qt][3]); }
                    m0 = xmax32(xmax16(m0));
                    const float mnew = fmaxf(mrun[qt], m0), corr = __builtin_amdgcn_exp2f(mrun[qt] - mnew);
                    mrun[qt] = mnew;
#pragma unroll
                    for (int dt = 0; dt < 4; ++dt) acc[qt][dt] = acc[qt][dt] * corr;
                    f32x4 ps = (f32x4){0.f, 0.f, 0.f, 0.f};
#pragma unroll
                    for (int kt = 0; kt < 4; ++kt) { const f32x4 d = s[kt][qt] - mnew; f32x4 p;
                        p[0] = __builtin_amdgcn_exp2f(d[0]); p[1] = __builtin_amdgcn_exp2f(d[1]); p[2] = __builtin_amdgcn_exp2f(d[2]); p[3] = __builtin_amdgcn_exp2f(d[3]);
                        ps = ps + p; s[kt][qt] = p; }
                    lrun[qt] = lrun[qt] * corr + ((ps[0] + ps[1]) + (ps[2] + ps[3]));
#pragma unroll
                    for (int ks = 0; ks < 2; ++ks) { u32x4 w; w.x = pk2(s[2 * ks][qt][0], s[2 * ks][qt][1]); w.y = pk2(s[2 * ks][qt][2], s[2 * ks][qt][3]);
                        w.z = pk2(s[2 * ks + 1][qt][0], s[2 * ks + 1][qt][1]); w.w = pk2(s[2 * ks + 1][qt][2], s[2 * ks + 1][qt][3]); pf[qt][ks] = __builtin_bit_cast(bf16x8, w); }
                }
#pragma unroll
                for (int dt = 0; dt < 4; ++dt)
#pragma unroll
                    for (int ks = 0; ks < 2; ++ks) {
                        const s16x4 lo = vtr(Vb + (32 * ks + 4 * g + q4) * 144 + (16 * dt + 4 * p4) * 2), hi = vtr(Vb + (32 * ks + 16 + 4 * g + q4) * 144 + (16 * dt + 4 * p4) * 2);
                        const bf16x8 vf = (bf16x8){lo[0], lo[1], lo[2], lo[3], hi[0], hi[1], hi[2], hi[3]};
#pragma unroll
                        for (int qt = 0; qt < 2; ++qt) acc[qt][dt] = __builtin_amdgcn_mfma_f32_16x16x32_bf16(vf, pf[qt][ks], acc[qt][dt], 0, 0, 0);
                    }
            }
        };
        for (int t0 = 0; t0 < NT; t0 += 2) {
            const bool diag = (t0 >= NT - 4);
            ATT_LOAD(t0 + 2 < NT ? t0 + 2 : NT - 1, 0);
            if (diag) tile(t0, BoolC<true>{}); else tile(t0, BoolC<false>{});
            ATT_STORE(t0 + 1, 1); LBAR();
            ATT_LOAD(t0 + 3 < NT ? t0 + 3 : NT - 1, 1);
            if (diag) tile(t0 + 1, BoolC<true>{}); else tile(t0 + 1, BoolC<false>{});
            if (t0 + 2 < NT) ATT_STORE(t0 + 2, 0);
            LBAR();
        }
#undef ATT_LOAD
#undef ATT_STORE
#pragma unroll
        for (int qt = 0; qt < 2; ++qt) { float lt = xadd32(xadd16(lrun[qt])); const float inv = 1.0f / lt;
            const size_t qr = rowbase + q0 + 32 * wave + 16 * qt + c16;
#pragma unroll
            for (int dt = 0; dt < 4; ++dt) { const f32x4 o = acc[qt][dt] * inv; u32x2 w; w.x = pk2(o[0], o[1]); w.y = pk2(o[2], o[3]);
                *(u32x2*)(ATT + qr * 512 + hh * 64 + 16 * dt + 4 * g) = w; } }
    }
    LBAR();
}

__device__ __forceinline__ void mlstm_phase(LAS unsigned char* lds, const bf16_t* PROJ, const bf16_t* MQK, const float* G16, bf16_t* HRAW) {
    const int tid = threadIdx.x, lane = tid & 63, wave = __builtin_amdgcn_readfirstlane(tid >> 6);
    const int g = lane >> 4, c16 = lane & 15, q4 = (lane & 15) >> 2, p4 = lane & 3;
    LAS unsigned char* Qs = lds; LAS unsigned char* Ks = lds + 17408; LAS unsigned char* Vs = lds + 34816; LAS unsigned char* Vw = lds + 44032; LAS unsigned char* Cbt = lds + 53248;
    LAS float* bb = (LAS float*)(lds + 70656); LAS float* ee = (LAS float*)(lds + 78848); LAS float* cm = (LAS float*)(lds + 87040);
    LAS float* nbuf = (LAS float*)(lds + 95232); LAS float* wl = (LAS float*)(lds + 96256); LAS float* gch = (LAS float*)(lds + 96512);
    LAS float* amax = (LAS float*)(lds + 96640); LAS float* mprev = (LAS float*)(lds + 96768); LAS unsigned char* Hs = lds + 97280;
    constexpr float QSCALE = 0.08838834764831845f;
    const int vblk = (gridDim.x % 8 == 0) ? (int)((blockIdx.x & 7) * (gridDim.x >> 3) + (blockIdx.x >> 3)) : (int)blockIdx.x;
    for (int item = vblk; item < 256; item += gridDim.x) {
        const int bhid = item >> 2, vs = item & 3, b = bhid >> 2, h = bhid & 3;
        const size_t rowbase = (size_t)b * SEQ;
        {
            float lf[4], ig[4];
#pragma unroll
            for (int i = 0; i < 4; ++i) { const float* gp = G16 + (rowbase + 4 * tid + i) * 16; lf[i] = logsig(gp[12 + h]); ig[i] = gp[8 + h]; }
            lf[1] += lf[0]; lf[2] += lf[1]; lf[3] += lf[2];
            const float tot = lf[3]; float sc = tot;
#pragma unroll
            for (int o = 1; o < 16; o <<= 1) { const float y = __shfl_up(sc, o, 16); if (c16 >= o) sc += y; }
            const float excl = sc - tot;
            float bi[4], ei[4], pm[4];
#pragma unroll
            for (int i = 0; i < 4; ++i) { bi[i] = lf[i] + excl; ei[i] = ig[i] - bi[i]; }
            pm[0] = ei[0]; pm[1] = fmaxf(pm[0], ei[1]); pm[2] = fmaxf(pm[1], ei[2]); pm[3] = fmaxf(pm[2], ei[3]);
            float scm = pm[3];
#pragma unroll
            for (int o = 1; o < 16; o <<= 1) { const float y = __shfl_up(scm, o, 16); if (c16 >= o) scm = fmaxf(scm, y); }
            float exm = __shfl_up(scm, 1, 16); if (c16 == 0) exm = -1e30f;
#pragma unroll
            for (int i = 0; i < 4; ++i) { bb[4 * tid + i] = bi[i]; ee[4 * tid + i] = ei[i]; cm[4 * tid + i] = fmaxf(pm[i], exm); }
            if (c16 == 15) { gch[tid >> 4] = bi[3]; amax[tid >> 4] = bi[3] + fmaxf(pm[3], exm); }
            if (tid < 128) nbuf[tid] = 0.f;
            for (int i = tid; i < 17408 / 4; i += 512) ((LAS unsigned*)Cbt)[i] = 0u;
        }
        LBAR();
        if (tid == 0) { float m = 0.f; for (int c = 0; c < 32; ++c) { mprev[c] = m; m = fmaxf(gch[c] + m, amax[c]); } mprev[32] = m; }
        LBAR();
        f32x4 Cst[2][4], Cn[2];
#pragma unroll
        for (int dd = 0; dd < 2; ++dd) { Cn[dd] = (f32x4){0.f, 0.f, 0.f, 0.f};
#pragma unroll
            for (int vt = 0; vt < 4; ++vt) Cst[dd][vt] = (f32x4){0.f, 0.f, 0.f, 0.f}; }
        const int vrow = tid >> 3, vch = tid & 7;
#define MLOAD(cc, Q, K, V) do { _Pragma("unroll") for (int i_ = 0; i_ < 2; ++i_) { const int p_ = tid + 512 * i_, row_ = p_ >> 4, ch_ = p_ & 15; const size_t r_ = rowbase + (size_t)(cc) * 64 + row_; \
            Q[i_] = *(const u32x4*)(MQK + r_ * DM + h * 256 + ch_ * 8); K[i_] = *(const u32x4*)(MQK + r_ * DM + h * 256 + 128 + ch_ * 8); } \
            V = __builtin_nontemporal_load((const u32x4*)(PROJ + (rowbase + (size_t)(cc) * 64 + vrow) * NP + C_MV + h * 256 + vs * 64 + vch * 8)); } while (0)
        u32x4 qA[2], kA[2], vA, qB[2], kB[2], vB;
        MLOAD(0, qA, kA, vA); MLOAD(1, qB, kB, vB);
        auto chunk = [&](const int c, u32x4 (&qreg)[2], u32x4 (&kreg)[2], u32x4& vreg) {
            const float mp = mprev[c], mn = mprev[c + 1], gc = gch[c];
#pragma unroll
            for (int i = 0; i < 2; ++i) { const int p = tid + 512 * i, row = p >> 4, ch = p & 15;
                *(LAS u32x4*)(Qs + row * 272 + ch * 16) = qreg[i]; *(LAS u32x4*)(Ks + row * 272 + ch * 16) = kreg[i]; }
            *(LAS u32x4*)(Vs + vrow * 144 + vch * 16) = vreg;
            { const float wv = __expf(gc + ee[64 * c + vrow] - mn); u32x4 o;
              o.x = pk2(bflo(vreg.x) * wv, bfhi(vreg.x) * wv); o.y = pk2(bflo(vreg.y) * wv, bfhi(vreg.y) * wv); o.z = pk2(bflo(vreg.z) * wv, bfhi(vreg.z) * wv); o.w = pk2(bflo(vreg.w) * wv, bfhi(vreg.w) * wv);
              *(LAS u32x4*)(Vw + vrow * 144 + vch * 16) = o; }
            if (tid < 64) wl[tid] = __expf(gc + ee[64 * c + tid] - mn);
            LBAR();
            MLOAD(c + 2 < 32 ? c + 2 : 31, qreg, kreg, vreg);
            const float decay = __expf(gc + mp - mn);
            if (wave < 4) {
                const int lt = wave, l = 16 * lt + c16;
                const float mx_l = fmaxf(mp, cm[64 * c + l]), winter = __expf(mp - mx_l);
                const LAS float* nb_ = nbuf + (c & 1) * 128;
                bf16x8 qf[4]; f32x4 n0[4], n1[4], e4[4];
#pragma unroll
                for (int kd = 0; kd < 4; ++kd) { qf[kd] = *(const LAS bf16x8*)(Qs + l * 272 + (32 * kd + 8 * g) * 2); n0[kd] = *(const LAS f32x4*)(nb_ + 32 * kd + 8 * g); n1[kd] = *(const LAS f32x4*)(nb_ + 32 * kd + 8 * g + 4); }
#pragma unroll
                for (int st = 0; st < 4; ++st) e4[st] = *(const LAS f32x4*)(ee + 64 * c + 16 * st + 4 * g);
                f32x4 sT[4], acc[4];
#pragma unroll
                for (int h2 = 0; h2 < 2; ++h2) {
                    bf16x8 kf[2][4];
#pragma unroll
                    for (int s2 = 0; s2 < 2; ++s2)
#pragma unroll
                        for (int kd = 0; kd < 4; ++kd) kf[s2][kd] = *(const LAS bf16x8*)(Ks + (16 * (2 * h2 + s2) + c16) * 272 + (32 * kd + 8 * g) * 2);
#pragma unroll
                    for (int s2 = 0; s2 < 2; ++s2) { sT[2 * h2 + s2] = (f32x4){0.f, 0.f, 0.f, 0.f};
#pragma unroll
                        for (int kd = 0; kd < 4; ++kd) sT[2 * h2 + s2] = __builtin_amdgcn_mfma_f32_16x16x32_bf16(kf[s2][kd], qf[kd], sT[2 * h2 + s2], 0, 0, 0); }
                    asm volatile("" ::: "memory");
                }
                float qn = 0.f;
#pragma unroll
                for (int kd = 0; kd < 4; ++kd) { const u32x4 qw = __builtin_bit_cast(u32x4, qf[kd]);
                    qn += bflo(qw.x) * n0[kd][0] + bfhi(qw.x) * n0[kd][1] + bflo(qw.y) * n0[kd][2] + bfhi(qw.y) * n0[kd][3] + bflo(qw.z) * n1[kd][0] + bfhi(qw.z) * n1[kd][1] + bflo(qw.w) * n1[kd][2] + bfhi(qw.w) * n1[kd][3]; }
                qn = xadd32(xadd16(qn));
#pragma unroll
                for (int h2 = 0; h2 < 2; ++h2) {
                    bf16x8 cf[2][4];
#pragma unroll
                    for (int j2 = 0; j2 < 2; ++j2)
#pragma unroll
                        for (int kd = 0; kd < 4; ++kd) cf[j2][kd] = *(const LAS bf16x8*)(Cbt + (16 * (2 * h2 + j2) + c16) * 272 + (32 * kd + 8 * g) * 2);
#pragma unroll
                    for (int j2 = 0; j2 < 2; ++j2) { acc[2 * h2 + j2] = (f32x4){0.f, 0.f, 0.f, 0.f};
#pragma unroll
                        for (int kd = 0; kd < 4; ++kd) acc[2 * h2 + j2] = __builtin_amdgcn_mfma_f32_16x16x32_bf16(cf[j2][kd], qf[kd], acc[2 * h2 + j2], 0, 0, 0); }
                    asm volatile("" ::: "memory");
                }
                bf16x8 vf[2][4];
#pragma unroll
                for (int ks = 0; ks < 2; ++ks)
#pragma unroll
                    for (int j = 0; j < 4; ++j) {
                        const s16x4 lo = vtr(Vs + (32 * ks + 4 * g + q4) * 144 + (16 * j + 4 * p4) * 2), hi = vtr(Vs + (32 * ks + 16 + 4 * g + q4) * 144 + (16 * j + 4 * p4) * 2);
                        vf[ks][j] = (bf16x8){lo[0], lo[1], lo[2], lo[3], hi[0], hi[1], hi[2], hi[3]}; }
                float psum = 0.f;
#pragma unroll
                for (int st = 0; st < 4; ++st)
#pragma unroll
                    for (int i = 0; i < 4; ++i) { const int sidx = 16 * st + 4 * g + i; float val = sT[st][i] * QSCALE * __expf(e4[st][i] - mx_l); if (sidx > l) val = 0.f; psum += val; sT[st][i] = val; }
                const float wis = winter * QSCALE;
#pragma unroll
                for (int j = 0; j < 4; ++j) acc[j] = acc[j] * wis;
#pragma unroll
                for (int ks = 0; ks < 2; ++ks) {
                    u32x4 w; w.x = pk2(sT[2 * ks][0], sT[2 * ks][1]); w.y = pk2(sT[2 * ks][2], sT[2 * ks][3]); w.z = pk2(sT[2 * ks + 1][0], sT[2 * ks + 1][1]); w.w = pk2(sT[2 * ks + 1][2], sT[2 * ks + 1][3]);
                    const bf16x8 pf = __builtin_bit_cast(bf16x8, w);
#pragma unroll
                    for (int j = 0; j < 4; ++j) acc[j] = __builtin_amdgcn_mfma_f32_16x16x32_bf16(vf[ks][j], pf, acc[j], 0, 0, 0);
                }
                psum = xadd32(xadd16(psum));
                const float den = wis * qn + psum, mt = bb[64 * c + l] + mx_l;
                const float inv = 1.0f / fmaxf(fabsf(den), __expf(-mt));
#pragma unroll
                for (int j = 0; j < 4; ++j) { const f32x4 o = acc[j] * inv; u32x2 w; w.x = pk2(o[0], o[1]); w.y = pk2(o[2], o[3]);
                    *(LAS u32x2*)(Hs + l * 144 + (16 * j + 4 * g) * 2) = w; }
            } else {
                const int dt0 = 2 * (wave - 4);
                bf16x8 vb[2][4], ka[2][2]; f32x4 w0[2], w1[2];
#pragma unroll
                for (int kl = 0; kl < 2; ++kl) {
                    w0[kl] = *(const LAS f32x4*)(wl + 32 * kl + 8 * g); w1[kl] = *(const LAS f32x4*)(wl + 32 * kl + 8 * g + 4);
#pragma unroll
                    for (int dd = 0; dd < 2; ++dd) {
                        const s16x4 alo = vtr(Ks + (32 * kl + 8 * g + q4) * 272 + (16 * (dt0 + dd) + 4 * p4) * 2), ahi = vtr(Ks + (32 * kl + 8 * g + 4 + q4) * 272 + (16 * (dt0 + dd) + 4 * p4) * 2);
                        ka[kl][dd] = (bf16x8){alo[0], alo[1], alo[2], alo[3], ahi[0], ahi[1], ahi[2], ahi[3]}; }
#pragma unroll
                    for (int vt = 0; vt < 4; ++vt) {
                        const s16x4 blo = vtr(Vw + (32 * kl + 8 * g + q4) * 144 + (16 * vt + 4 * p4) * 2), bhi = vtr(Vw + (32 * kl + 8 * g + 4 + q4) * 144 + (16 * vt + 4 * p4) * 2);
                        vb[kl][vt] = (bf16x8){blo[0], blo[1], blo[2], blo[3], bhi[0], bhi[1], bhi[2], bhi[3]}; }
                }
#pragma unroll
                for (int dd = 0; dd < 2; ++dd) { Cn[dd] = Cn[dd] * decay;
#pragma unroll
                    for (int vt = 0; vt < 4; ++vt) Cst[dd][vt] = Cst[dd][vt] * decay; }
#pragma unroll
                for (int kl = 0; kl < 2; ++kl) {
                    u32x4 wa; wa.x = pk2(w0[kl][0], w0[kl][1]); wa.y = pk2(w0[kl][2], w0[kl][3]); wa.z = pk2(w1[kl][0], w1[kl][1]); wa.w = pk2(w1[kl][2], w1[kl][3]);
                    if (c16 != 0) wa = (u32x4){0u, 0u, 0u, 0u};
#pragma unroll
                    for (int dd = 0; dd < 2; ++dd) {
                        Cn[dd] = __builtin_amdgcn_mfma_f32_16x16x32_bf16(ka[kl][dd], __builtin_bit_cast(bf16x8, wa), Cn[dd], 0, 0, 0);
#pragma unroll
                        for (int vt = 0; vt < 4; ++vt) Cst[dd][vt] = __builtin_amdgcn_mfma_f32_16x16x32_bf16(ka[kl][dd], vb[kl][vt], Cst[dd][vt], 0, 0, 0);
                    }
                }
                if (c16 == 0) {
#pragma unroll
                    for (int dd = 0; dd < 2; ++dd) *(LAS f32x4*)(nbuf + ((c + 1) & 1) * 128 + 16 * (dt0 + dd) + 4 * g) = Cn[dd]; }
            }
            LBAR();
            *(u32x4*)(HRAW + (rowbase + (size_t)c * 64 + vrow) * DM + h * 256 + vs * 64 + vch * 8) = *(const LAS u32x4*)(Hs + vrow * 144 + vch * 16);
            if (wave >= 4) {
                const int dt0 = 2 * (wave - 4);
#pragma unroll
                for (int dd = 0; dd < 2; ++dd)
#pragma unroll
                    for (int vt = 0; vt < 4; ++vt) { u32x2 w; w.x = pk2(Cst[dd][vt][0], Cst[dd][vt][1]); w.y = pk2(Cst[dd][vt][2], Cst[dd][vt][3]);
                        *(LAS u32x2*)(Cbt + (16 * vt + c16) * 272 + (16 * (dt0 + dd) + 4 * g) * 2) = w; }
            }
        };
        for (int c0 = 0; c0 < 32; c0 += 2) { chunk(c0, qA, kA, vA); chunk(c0 + 1, qB, kB, vB); }
#undef MLOAD
        LBAR();
    }
}

__device__ __forceinline__ void headnorm_phase(const bf16_t* PROJ, const float* gnorm, bf16_t* HM) {
    const int tid = threadIdx.x, lane = tid & 63, wave = __builtin_amdgcn_readfirstlane(tid >> 6);
    float gq[16]; { float t0[8], t1[8]; ld8f(gnorm + 16 * lane, t0); ld8f(gnorm + 16 * lane + 8, t1);
#pragma unroll
        for (int e = 0; e < 8; ++e) { gq[e] = t0[e]; gq[8 + e] = t1[e]; } }
    for (int m0 = (blockIdx.x * 8 + wave) * 4; m0 < MT; m0 += gridDim.x * 32) {
        u32x4 hr[4][2], mr[4][2];
#pragma unroll
        for (int r = 0; r < 4; ++r) { const bf16_t* hp = HM + (size_t)(m0 + r) * DM + 16 * lane; const bf16_t* mo = PROJ + (size_t)(m0 + r) * NP + C_MO + 16 * lane;
            hr[r][0] = __builtin_nontemporal_load((const u32x4*)hp); hr[r][1] = __builtin_nontemporal_load((const u32x4*)(hp + 8)); mr[r][0] = __builtin_nontemporal_load((const u32x4*)mo); mr[r][1] = __builtin_nontemporal_load((const u32x4*)(mo + 8)); }
#pragma unroll
        for (int r = 0; r < 4; ++r) {
            float v[16], og[16];
            { float t0[8], t1[8]; unpack8(hr[r][0], t0); unpack8(hr[r][1], t1);
#pragma unroll
              for (int e = 0; e < 8; ++e) { v[e] = t0[e]; v[8 + e] = t1[e]; }
              unpack8(mr[r][0], t0); unpack8(mr[r][1], t1);
#pragma unroll
              for (int e = 0; e < 8; ++e) { og[e] = t0[e]; og[8 + e] = t1[e]; } }
            float s = 0.f;
#pragma unroll
            for (int i = 0; i < 16; ++i) s += v[i];
#pragma unroll
            for (int o = 1; o < 16; o <<= 1) s += __shfl_xor(s, o);
            const float mean = s * (1.f / 256.f); float s2 = 0.f;
#pragma unroll
            for (int i = 0; i < 16; ++i) { v[i] -= mean; s2 += v[i] * v[i]; }
#pragma unroll
            for (int o = 1; o < 16; o <<= 1) s2 += __shfl_xor(s2, o);
            const float rstd = 1.f / sqrtf(s2 * (1.f / 256.f) + LN_EPS);
            float r0[8], r1[8];
#pragma unroll
            for (int e = 0; e < 8; ++e) { r0[e] = v[e] * rstd * gq[e] * sigmoidf_(og[e]); r1[e] = v[8 + e] * rstd * gq[8 + e] * sigmoidf_(og[8 + e]); }
            bf16_t* hp = HM + (size_t)(m0 + r) * DM + 16 * lane;
            *(u32x4*)hp = pack8(r0); *(u32x4*)(hp + 8) = pack8(r1);
        }
    }
}

__device__ __forceinline__ void ln16(float (&v)[2][8]) {
    float s = 0.f;
#pragma unroll
    for (int j = 0; j < 2; ++j)
#pragma unroll
        for (int e = 0; e < 8; ++e) s += v[j][e];
    const float mean = wave_sum(s) * (1.f / DM); float s2 = 0.f;
#pragma unroll
    for (int j = 0; j < 2; ++j)
#pragma unroll
        for (int e = 0; e < 8; ++e) { v[j][e] -= mean; s2 += v[j][e] * v[j][e]; }
    const float rstd = 1.f / sqrtf(wave_sum(s2) * (1.f / DM) + LN_EPS);
#pragma unroll
    for (int j = 0; j < 2; ++j)
#pragma unroll
        for (int e = 0; e < 8; ++e) v[j][e] *= rstd;
}
__device__ __forceinline__ void ln_mid_phase(const bf16_t* Z, const float* lg, const float* lb, const float* MOD, bf16_t* X1, bf16_t* H2) {
    const int tid = threadIdx.x, lane = tid & 63, wave = __builtin_amdgcn_readfirstlane(tid >> 6);
    float gg[2][8], bq[2][8];
#pragma unroll
    for (int j = 0; j < 2; ++j) { ld8f(lg + 8 * lane + 512 * j, gg[j]); ld8f(lb + 8 * lane + 512 * j, bq[j]); }
    for (int m0 = (blockIdx.x * 8 + wave) * 4; m0 < MT; m0 += gridDim.x * 32) {
        const int b = m0 >> 11;
        u32x4 raw[4][2]; float sh[2][8], sc[2][8];
#pragma unroll
        for (int r = 0; r < 4; ++r)
#pragma unroll
            for (int j = 0; j < 2; ++j) raw[r][j] = __builtin_nontemporal_load((const u32x4*)(Z + (size_t)(m0 + r) * DM + 8 * lane + 512 * j));
#pragma unroll
        for (int j = 0; j < 2; ++j) { ld8f(MOD + (size_t)b * 6144 + 3072 + 8 * lane + 512 * j, sh[j]); ld8f(MOD + (size_t)b * 6144 + 4096 + 8 * lane + 512 * j, sc[j]); }
        asm volatile("" ::: "memory");
#pragma unroll
        for (int r = 0; r < 4; ++r) {
            float v[2][8]; unpack8(raw[r][0], v[0]); unpack8(raw[r][1], v[1]);
            ln16(v);
#pragma unroll
            for (int j = 0; j < 2; ++j) {
#pragma unroll
                for (int e = 0; e < 8; ++e) v[j][e] = v[j][e] * gg[j][e] + bq[j][e];
                __builtin_nontemporal_store(pack8(v[j]), (u32x4*)(X1 + (size_t)(m0 + r) * DM + 8 * lane + 512 * j)); }
            ln16(v);
#pragma unroll
            for (int j = 0; j < 2; ++j) {
#pragma unroll
                for (int e = 0; e < 8; ++e) v[j][e] = v[j][e] * (sc[j][e] + 1.0f) + sh[j][e];
                *(u32x4*)(H2 + (size_t)(m0 + r) * DM + 8 * lane + 512 * j) = pack8(v[j]); }
        }
    }
}
__device__ __forceinline__ void ln_out_phase(const bf16_t* Z, const float* lg, const float* lb, float* OUT) {
    const int tid = threadIdx.x, lane = tid & 63, wave = __builtin_amdgcn_readfirstlane(tid >> 6);
    float gg[2][8], bq[2][8];
#pragma unroll
    for (int j = 0; j < 2; ++j) { ld8f(lg + 8 * lane + 512 * j, gg[j]); ld8f(lb + 8 * lane + 512 * j, bq[j]); }
    for (int m0 = (blockIdx.x * 8 + wave) * 4; m0 < MT; m0 += gridDim.x * 32) {
        u32x4 raw[4][2];
#pragma unroll
        for (int r = 0; r < 4; ++r)
#pragma unroll
            for (int j = 0; j < 2; ++j) raw[r][j] = *(const u32x4*)(Z + (size_t)(m0 + r) * DM + 8 * lane + 512 * j);
#pragma unroll
        for (int r = 0; r < 4; ++r) {
            float v[2][8]; unpack8(raw[r][0], v[0]); unpack8(raw[r][1], v[1]);
            ln16(v);
#pragma unroll
            for (int j = 0; j < 2; ++j) { float* op = OUT + (size_t)(m0 + r) * DM + 8 * lane + 512 * j;
                *(f32x4*)op = (f32x4){v[j][0] * gg[j][0] + bq[j][0], v[j][1] * gg[j][1] + bq[j][1], v[j][2] * gg[j][2] + bq[j][2], v[j][3] * gg[j][3] + bq[j][3]};
                *(f32x4*)(op + 4) = (f32x4){v[j][4] * gg[j][4] + bq[j][4], v[j][5] * gg[j][5] + bq[j][5], v[j][6] * gg[j][6] + bq[j][6], v[j][7] * gg[j][7] + bq[j][7]}; }
        }
    }
}

#define XB_TMO      128
#define XB_XCNT(j)  (256  + 64 * (j))
#define XB_XSUB(j)  (1280 + 64 * (j))
#define XB_XGEN(j)  (2304 + 64 * (j))
#define XB_TOP      3328
#define XB_TOPGEN   3392
#define XCD_BAR_WORDS 3456
#define XB_SPIN_CAP (1u << 22)
__device__ __forceinline__ unsigned xb_ld(unsigned* p)              { return __hip_atomic_load(p, __ATOMIC_RELAXED, __HIP_MEMORY_SCOPE_AGENT); }
__device__ __forceinline__ unsigned xb_add(unsigned* p, unsigned v) { return __hip_atomic_fetch_add(p, v, __ATOMIC_RELAXED, __HIP_MEMORY_SCOPE_AGENT); }
__device__ __forceinline__ unsigned xb_xcc_id() { return (unsigned)__builtin_amdgcn_s_getreg((3 << 11) | 20) & 0xFu; }
#define XB_SPIN(cond, bar) do { unsigned _sp = 0; while (cond) { __builtin_amdgcn_s_sleep(1); \
    if ((++_sp & 255u) == 0u) { if (xb_ld(&(bar)[XB_TMO])) break; if (_sp > XB_SPIN_CAP) { atomicAdd(&(bar)[XB_TMO], 1u); break; } } } } while (0)
struct XcdBarrier { unsigned* bar; unsigned x; volatile LAS unsigned* st; };
__device__ __forceinline__ XcdBarrier xcd_barrier_post(unsigned* bar, volatile LAS unsigned* st) {
    XcdBarrier b; b.bar = bar; b.x = xb_xcc_id(); b.st = st;
    if (threadIdx.x == 0) (void)xb_add(&bar[XB_XCNT(b.x)], 1u);
    return b;
}
__device__ __forceinline__ void xcd_barrier_complete(unsigned* bar, unsigned x, unsigned& nloc, unsigned& nx) {
    const unsigned G = gridDim.x * gridDim.y * gridDim.z;
    unsigned sum, cnt, mine, sp = 0u;
    for (;;) {
        sum = 0u; cnt = 0u; mine = 0u;
#pragma unroll
        for (unsigned j = 0; j < 16; ++j) { const unsigned c = xb_ld(&bar[XB_XCNT(j)]); sum += c; cnt += (c > 0u) ? 1u : 0u; mine = (j == x) ? c : mine; }
        if (sum == G) break;
        __builtin_amdgcn_s_sleep(1);
        if ((++sp & 255u) == 0u) { if (xb_ld(&bar[XB_TMO])) break; if (sp > XB_SPIN_CAP) { atomicAdd(&bar[XB_TMO], 1u); break; } }
    }
    nloc = mine > 0u ? mine : 1u; nx = cnt > 0u ? cnt : 1u;
}
__device__ __forceinline__ void xcd_barrier(const XcdBarrier& b) {
    asm volatile("s_waitcnt vmcnt(0)" ::: "memory");
    __syncthreads();
    if (threadIdx.x == 0) {
        unsigned* bar = b.bar;
        __builtin_amdgcn_s_waitcnt(0);
        unsigned nloc = b.st[0], nx = b.st[1];
        if (nloc == 0u) { xcd_barrier_complete(bar, b.x, nloc, nx); b.st[0] = nloc; b.st[1] = nx; }
        const unsigned old = xb_add(&bar[XB_XSUB(b.x)], 1u);
        const unsigned gen = old / nloc;
        if (old + 1u == (gen + 1u) * nloc) {
            __builtin_amdgcn_fence(__ATOMIC_RELEASE, "agent");
            asm volatile("s_waitcnt vmcnt(0)" ::: "memory");
            const unsigned og = xb_add(&bar[XB_TOP], 1u);
            const unsigned tg = og / nx;
            if (og + 1u == (tg + 1u) * nx) xb_add(&bar[XB_TOPGEN], 1u);
            else XB_SPIN(xb_ld(&bar[XB_TOPGEN]) == tg, bar);
            __builtin_amdgcn_fence(__ATOMIC_ACQUIRE, "agent");
            xb_add(&bar[XB_XGEN(b.x)], 1u);
            asm volatile("s_waitcnt vmcnt(0)" ::: "memory");
        } else {
            XB_SPIN(xb_ld(&bar[XB_XGEN(b.x)]) == gen, bar);
            __builtin_amdgcn_fence(__ATOMIC_ACQUIRE, "agent");
            asm volatile("s_waitcnt vmcnt(0)" ::: "memory");
        }
    }
    __syncthreads();
}

__device__ __forceinline__ void split_arrive(unsigned* ctr) {
    asm volatile("s_waitcnt vmcnt(0)" ::: "memory");
    __syncthreads();
    if (threadIdx.x == 0) { __builtin_amdgcn_fence(__ATOMIC_RELEASE, "agent"); asm volatile("s_waitcnt vmcnt(0)" ::: "memory"); (void)xb_add(ctr, 1u); }
}
__device__ __forceinline__ void split_wait(unsigned* ctr, unsigned want) {
    if (threadIdx.x == 0) { unsigned sp = 0; while (xb_ld(ctr) < want) { __builtin_amdgcn_s_sleep(2); if (++sp > (1u << 24)) break; }
        __builtin_amdgcn_fence(__ATOMIC_ACQUIRE, "agent"); asm volatile("s_waitcnt vmcnt(0)" ::: "memory"); }
    __syncthreads();
}

constexpr int N_PHASES = 12;
struct Args { const float* in[20]; float* out; unsigned char* ws; int ph_lo, ph_hi; };

__global__ void __launch_bounds__(512, 2) fwd_megakernel(Args a) {
    extern __shared__ __attribute__((aligned(16))) unsigned char lds_raw[];
    LAS unsigned char* lds = (LAS unsigned char*)lds_raw;
    cg::grid_group grid = cg::this_grid();
    unsigned char* ws = a.ws; unsigned char* dob = (unsigned char*)a.out;
    const int lo = a.ph_lo, hi = a.ph_hi, G = gridDim.x;
#ifndef REP_ID
#define REP_ID 0
#endif
#ifndef PH_MASK
#define PH_MASK 0x1ff
#endif
#define IN(k) (((PH_MASK >> (k)) & 1) && lo <= (k) && (k) < hi)
#define SEAM(k) do { if (IN(k) && IN((k) + 1)) { xcd_barrier(xbar); } } while (0)
    volatile LAS unsigned* MISC = (volatile LAS unsigned*)(lds + 131072 + 320);
    if (threadIdx.x < 32) MISC[threadIdx.x] = 0u;
    __syncthreads();
    XcdBarrier xbar = xcd_barrier_post((unsigned*)ws, MISC + 8);
    float* MOD = (float*)(ws + WS_MOD); float* G16 = (float*)(ws + WS_G16); float* FCUM = (float*)(ws + WS_FCUM);
    bf16_t* PROJ = (bf16_t*)(ws + WS_PROJ); bf16_t* ATT = (bf16_t*)(ws + WS_ATT);
    bf16_t* BUFA = (bf16_t*)(dob + DO_A); bf16_t* BUFB = (bf16_t*)(dob + DO_B);

    unsigned* SC = (unsigned*)(ws + WS_CNT + 98304);
    if (lo > 1000) grid.sync();
    if (IN(0)) {
        p0_prologue(lds, a.in, ws, SC);
        p1_ln_gates(lds, a.in[0], MOD, (const float*)(ws + WS_WG), (const float*)(ws + WS_BG), BUFA, G16);
    }
    SEAM(0);
    if (IN(1)) {
        fscan(lds, G16, FCUM);
        pg8::Gemm g{BUFA, (const bf16_t*)(ws + WS_WT_IN), MT, NP, 1024, 1024, 1024, 0}; pg8::StaticOrder S; S.init(MT, NP, G, (int)blockIdx.x);
        pg8::EpiProj E{PROJ, NP, a.in[5], 1};
        pg8::gemm_phase(lds, g, S, E);
    }
    SEAM(1);
    if (IN(2)) {
        conv_phase(PROJ, a.in[6], a.in[7], BUFA);
        split_arrive(SC + 64);
#if FOX_REF_ATTN
        attn_phase_ref((char*)lds_raw, PROJ, FCUM, ATT);
#else
        attn_phase(lds, PROJ, FCUM, ATT);
#endif
        split_wait(SC + 64, G);
        pg8::Gemm g{BUFA, (const bf16_t*)(ws + WS_WT_QK), MT, 1024, 256, 1024, 256, 512}; pg8::StaticOrder S; S.init(MT, 1024, G, (int)blockIdx.x);
        pg8::EpiProj E{BUFB, 1024, nullptr, 0};
        pg8::gemm_phase(lds, g, S, E);
    }
    SEAM(2);
    if (IN(3)) mlstm_phase(lds, PROJ, BUFB, G16, BUFA);
    SEAM(3);
    if (IN(4)) {
        headnorm_phase(PROJ, a.in[10], BUFA);
        split_arrive(SC + 128);
        { pg8::Gemm g{ATT, (const bf16_t*)(ws + WS_WT_PA), MT, 1024, 512, 512, 512, 0}; pg8::StaticOrder S; S.init(MT, 1024, G, (int)blockIdx.x);
          pg8::EpiY<0> E{BUFB, PROJ + C_GA};
          pg8::gemm_phase(lds, g, S, E); }
        split_wait(SC + 128, G);
        { pg8::Gemm g{BUFA, (const bf16_t*)(ws + WS_WT_PB), MT, 1024, 1024, 1024, 1024, 0}; pg8::StaticOrder S; S.init(MT, 1024, G, (int)blockIdx.x);
          pg8::EpiY<1> E{BUFB, PROJ + C_GB};
          pg8::gemm_phase(lds, g, S, E); }
    }
    SEAM(4);
    if (IN(5)) {
        pg8::Gemm g{BUFB, (const bf16_t*)(ws + WS_WT_OUT), MT, 1024, 1024, 1024, 1024, 0}; pg8::StaticOrder S; S.init(MT, 1024, G, (int)blockIdx.x);
        pg8::EpiRes<0> E{(const void*)a.in[0], MOD + 2048, (bf16_t*)(ws + WS_Z)};
        pg8::gemm_phase(lds, g, S, E);
    }
    SEAM(5);
    if (IN(6)) ln_mid_phase((const bf16_t*)(ws + WS_Z), a.in[14], a.in[15], MOD, (bf16_t*)(ws + WS_X1), BUFA);
    SEAM(6);
    if (IN(7)) {
        pg8::Gemm g{BUFA, (const bf16_t*)(ws + WS_WT_FI), MT, 2 * DFF, 1024, 1024, 1024, 0}; pg8::StaticOrder S; S.init(MT, 2 * DFF, G, (int)blockIdx.x);
        pg8::EpiSwiglu E{(bf16_t*)(ws + WS_ACT)};
        pg8::gemm_phase(lds, g, S, E);
    }
    SEAM(7);
    if (IN(8)) {
        pg8::Gemm g{(const bf16_t*)(ws + WS_ACT), (const bf16_t*)(ws + WS_WT_FD), MT, 1024, DFF, DFF, DFF, 0}; pg8::StaticOrder S; S.init(MT, 1024, G, (int)blockIdx.x);
        pg8::PanelStats st{(unsigned long long*)(ws + WS_XB3), (unsigned*)(ws + WS_CNT + 65536), lds + 132096};
        pg8::EpiLnOut E{(const bf16_t*)(ws + WS_X1), MOD + 5120, a.in[18], a.in[19], a.out, st};
        pg8::gemm_phase(lds, g, S, E);
    }
#undef IN
#undef SEAM
}

extern "C" void kernel_launch(void* const* d_in, const int* in_sizes, int n_in, void* d_out, int out_size, void* d_ws, size_t ws_size, hipStream_t stream) {
    static int grid = 0;
    if (grid == 0) {
        int dev = 0, cus = 0, per_cu = 0;
        hipGetDevice(&dev);
        hipDeviceGetAttribute(&cus, hipDeviceAttributeMultiprocessorCount, dev);
        if (hipFuncSetAttribute((const void*)fwd_megakernel, hipFuncAttributeMaxDynamicSharedMemorySize, LDS_BYTES) != hipSuccess) fprintf(stderr, "kernel_launch: hipFuncSetAttribute failed\n");
        if (hipOccupancyMaxActiveBlocksPerMultiprocessor(&per_cu, (const void*)fwd_megakernel, 512, LDS_BYTES) != hipSuccess || per_cu < 1) per_cu = 1;
        (void)hipGetLastError();
        grid = cus * per_cu; if (grid <= 0) grid = 256;
    }
    (void)hipMemsetAsync(d_ws, 0, 262144, stream);
    Args a{};
    for (int i = 0; i < 20; ++i) a.in[i] = (const float*)d_in[i];
    a.out = (float*)d_out; a.ws = (unsigned char*)d_ws;
    constexpr int NPH = 9;
    const int nl = MK_N_LAUNCHES;
    for (int li = 0; li < nl; ++li) {
        a.ph_lo = (nl == 1) ? 0 : li; a.ph_hi = (nl == 1) ? NPH : li + 1;
        void* args[] = {&a};
        hipError_t e = hipLaunchCooperativeKernel((const void*)fwd_megakernel, dim3(grid), dim3(512), args, LDS_BYTES, stream);
        if (e != hipSuccess) { fprintf(stderr, "cooperative launch failed: %s (grid %d)\n", hipGetErrorString(e), grid); break; }
    }
}
```

```cpp
#include <hip/hip_runtime.h>
#include <hip/hip_cooperative_groups.h>
#include <hip/hip_bf16.h>
#include <cmath>
#include <cstdio>
#include <cstdint>
namespace cg = cooperative_groups;

#ifndef FOX_REF_ATTN
#define FOX_REF_ATTN 1
#endif
#ifndef MK_N_LAUNCHES
#define MK_N_LAUNCHES 1
#endif

#define LAS __attribute__((address_space(3)))
typedef unsigned short bf16_t;
typedef short bf16x8 __attribute__((ext_vector_type(8)));
typedef short s16x4 __attribute__((ext_vector_type(4)));
typedef short v4i16_t __attribute__((ext_vector_type(4)));
typedef float f32x4 __attribute__((ext_vector_type(4)));
typedef float f32x2 __attribute__((ext_vector_type(2)));
typedef unsigned u32x4 __attribute__((ext_vector_type(4)));
typedef unsigned u32x2 __attribute__((ext_vector_type(2)));
typedef __bf16 bf16x2_t __attribute__((ext_vector_type(2)));

constexpr int BATCH = 16, SEQ = 2048, DM = 1024, MT = BATCH * SEQ;
constexpr int DIN = 6672, NP = 6656, DFF = 2816;
constexpr int C_FQ = 0, C_FK = 512, C_FV = 1024, C_MU = 1536, C_MV = 2560, C_MO = 3584, C_GA = 4608, C_GB = 5632;
constexpr float LN_EPS = 1e-5f, ALPHA = 1.189207115002721f, LOG2E = 1.4426950408889634f;
constexpr int LDS_BYTES = 147456;

constexpr size_t MiB = 1u << 20;
constexpr size_t WS_MOD = 1 * MiB, WS_WG = 2 * MiB, WS_BG = 2 * MiB + 65536, WS_FCUM = 3 * MiB, WS_G16 = 4 * MiB;
constexpr size_t WS_WT_IN = 8 * MiB, WS_WT_QK = 21 * MiB, WS_WT_PA = 22 * MiB, WS_WT_PB = 23 * MiB, WS_WT_OUT = 25 * MiB, WS_WT_FI = 27 * MiB, WS_WT_FD = 38 * MiB;
constexpr size_t WS_XB1 = 44 * MiB, WS_XB2 = 45 * MiB, WS_XB3 = 46 * MiB;
constexpr size_t WS_CNT = 65536;
constexpr size_t WS_PROJ = 48 * MiB;
constexpr size_t WS_ATT = 464 * MiB;
constexpr size_t WS_Z = 48 * MiB;
constexpr size_t WS_X1 = 176 * MiB;
constexpr size_t WS_ACT = 304 * MiB;
constexpr size_t WS_Z2 = 48 * MiB;
constexpr size_t DO_A = 0, DO_B = 64 * MiB;

__device__ __forceinline__ unsigned pk2(float lo, float hi) { f32x2 v = {lo, hi}; bf16x2_t b = __builtin_convertvector(v, bf16x2_t); return __builtin_bit_cast(unsigned, b); }
__device__ __forceinline__ float bflo(unsigned w) { return __uint_as_float(w << 16); }
__device__ __forceinline__ float bfhi(unsigned w) { return __uint_as_float(w & 0xffff0000u); }
__device__ __forceinline__ float sigmoidf_(float x) { return __builtin_amdgcn_rcpf(1.0f + __expf(-x)); }
__device__ __forceinline__ float logsig(float x) { return fminf(x, 0.f) - log1pf(expf(-fabsf(x))); }
__device__ __forceinline__ float wave_sum(float v) {
#pragma unroll
    for (int o = 1; o < 64; o <<= 1) v += __shfl_xor(v, o);
    return v;
}
__device__ __forceinline__ s16x4 vtr(const LAS unsigned char* p) { return __builtin_bit_cast(s16x4, __builtin_amdgcn_ds_read_tr16_b64_v4i16((LAS v4i16_t*)p)); }
#define LDS_WAIT() asm volatile("s_waitcnt lgkmcnt(0)" ::: "memory")
#define LBAR() do { asm volatile("s_waitcnt lgkmcnt(0)" ::: "memory"); __builtin_amdgcn_s_barrier(); asm volatile("" ::: "memory"); } while (0)

__device__ __forceinline__ void unpack8(const u32x4 w, float (&v)[8]) { v[0] = bflo(w.x); v[1] = bfhi(w.x); v[2] = bflo(w.y); v[3] = bfhi(w.y); v[4] = bflo(w.z); v[5] = bfhi(w.z); v[6] = bflo(w.w); v[7] = bfhi(w.w); }
__device__ __forceinline__ u32x4 pack8(const float (&v)[8]) { u32x4 w; w.x = pk2(v[0], v[1]); w.y = pk2(v[2], v[3]); w.z = pk2(v[4], v[5]); w.w = pk2(v[6], v[7]); return w; }
__device__ __forceinline__ void ld8f(const float* p, float (&v)[8]) { const f32x4 a = *(const f32x4*)p, b = *(const f32x4*)(p + 4); v[0] = a[0]; v[1] = a[1]; v[2] = a[2]; v[3] = a[3]; v[4] = b[0]; v[5] = b[1]; v[6] = b[2]; v[7] = b[3]; }

namespace pg8 {
constexpr int BM = 256, BK = 64, HALF = 128, HTB = HALF * BK * 2, STAGE_BYTES = 8 * HTB, NXCD = 8, WGM = 8;
__host__ __device__ __forceinline__ int lds_byte(int r, int c) { const int st = (r >> 4) * 2 + (c >> 5), rr = r & 15, cc = c & 31, ob = rr * 64 + cc * 2; return st * 1024 + (ob ^ (((ob >> 9) & 1) << 5)); }
__host__ __device__ __forceinline__ void stage_rc(int b, int& R, int& C) { const int st = b / 1024, sb = b % 1024, swz = sb ^ (((sb >> 9) & 1) << 5); R = (st >> 1) * 16 + swz / 64; C = (st & 1) * 32 + (swz % 64) / 2; }
__host__ __device__ __forceinline__ int perm32(int rho) { const int n = rho >> 4, i = rho & 15; return 8 * (i >> 2) + 4 * n + (i & 3); }

struct Unit { int pm, pn; };
struct Gemm { const bf16_t* A; const bf16_t* Bt; int M, N, K, lda, ldb, aoffN; };

struct StaticOrder {
    int nM, nN, nwg, G, c;
    __device__ void init(int M, int N, int G_, int c_) { nM = M / BM; nN = N / BM; nwg = nM * nN; G = G_; c = c_; }
    __device__ bool next(int i, Unit& u) const {
        const long L = (long)i * G + c; if (L >= nwg) return false;
        int wgid = (int)L; { const int q = nwg / NXCD, r = nwg % NXCD, xcd = wgid % NXCD, off = wgid / NXCD; wgid = (xcd < r ? xcd * (q + 1) : r * (q + 1) + (xcd - r) * q) + off; }
        const int nig = WGM * nN, gid = wgid / nig, fm = gid * WGM, gsz = (nM - fm) < WGM ? (nM - fm) : WGM;
        u.pm = fm + ((wgid % nig) % gsz); u.pn = (wgid % nig) / gsz; return true;
    }
};
template <class E, class = void> struct has_pre { static constexpr bool value = false; };
template <class E> struct has_pre<E, decltype((void)E::HAS_PRE)> { static constexpr bool value = true; };
template <class Epi, class Sched>
__device__ __forceinline__ void gemm_phase(LAS unsigned char* lds, const Gemm g, const Sched& S, const Epi& E) {
    const int tid = threadIdx.x, wid = __builtin_amdgcn_readfirstlane(tid >> 6), lane = tid & 63, wr = wid >> 2, wc = wid & 3, fr = lane & 15, fq = lane >> 4;
    const int K = g.K, nt = K / BK;
    unsigned voffA[2], voffB[2];
#pragma unroll
    for (int i = 0; i < 2; ++i) { int R, C; stage_rc(tid * 16 + i * 8192, R, C); const int Rb = Epi::PERM ? ((R & ~31) + perm32(R & 31)) : R;
        voffA[i] = (unsigned)(R * g.lda + C) * 2u; voffB[i] = (unsigned)(Rb * g.ldb + C) * 2u; }
    const size_t kstep = (size_t)(BK * 2);
    const size_t hstepA = (size_t)HALF * g.lda * 2, hstepB = (size_t)HALF * g.ldb * 2;
    const size_t tstepA = 2 * hstepA, tstepB = 2 * hstepB;
    const unsigned ldsw = (unsigned)wid * 1024u;
    const int aoff = lds_byte(wr * 64 + fr, fq * 8), boff = lds_byte(wc * 32 + fr, fq * 8);
#define PG8_SA(b, h) (((b) * 2 + (h)) * HTB)
#define PG8_SB(b, h) ((4 + (b) * 2 + (h)) * HTB)
#define PG8_STAGE(bufoff, gbase, voff) do { _Pragma("unroll") for (int _i = 0; _i < 2; ++_i) \
        __builtin_amdgcn_global_load_lds((const unsigned*)((const char*)(gbase) + (voff)[_i]), (LAS unsigned*)(lds + (bufoff) + ldsw + _i * 8192), 16, 0, 0); } while (0)
#define PG8_LDA(dst, b, h) do { _Pragma("unroll") for (int m = 0; m < 4; ++m) _Pragma("unroll") for (int k = 0; k < 2; ++k) dst[m][k] = *(const LAS bf16x8*)(lds + PG8_SA(b, h) + aoff + m * 2048 + k * 1024); } while (0)
#define PG8_LDB(dst, b, h) do { _Pragma("unroll") for (int n = 0; n < 2; ++n) _Pragma("unroll") for (int k = 0; k < 2; ++k) dst[n][k] = *(const LAS bf16x8*)(lds + PG8_SB(b, h) + boff + n * 2048 + k * 1024); } while (0)
#define PG8_MMA(ai, bj, At, Bt) do { __builtin_amdgcn_s_setprio(1); _Pragma("unroll") for (int m = 0; m < 4; ++m) _Pragma("unroll") for (int n = 0; n < 2; ++n) _Pragma("unroll") for (int k = 0; k < 2; ++k) \
        acc[ai][bj][m][n] = __builtin_amdgcn_mfma_f32_16x16x32_bf16(Bt[n][k], At[m][k], acc[ai][bj][m][n], 0, 0, 0); __builtin_amdgcn_s_setprio(0); } while (0)
#define PG8_WAIT_V(n) asm volatile("s_waitcnt vmcnt(" #n ")" ::: "memory")
#define PG8_WAIT_L(n) asm volatile("s_waitcnt lgkmcnt(" #n ")" ::: "memory")
#define PG8_BAR __builtin_amdgcn_s_barrier()
#define PG8_SCHED __builtin_amdgcn_sched_barrier(0)
    Unit cur, nxt; int ui = 0;
    if (!S.next(0, cur)) return;
    f32x4 acc[2][2][4][2];
#pragma unroll
    for (int a = 0; a < 2; ++a)
#pragma unroll
        for (int b = 0; b < 2; ++b)
#pragma unroll
            for (int m = 0; m < 4; ++m)
#pragma unroll
                for (int n = 0; n < 2; ++n) acc[a][b][m][n] = (f32x4){0.f, 0.f, 0.f, 0.f};
    bf16x8 At[4][2], B0[2][2], B1[2][2];
    LAS unsigned char* bslot = lds + 142592;
#define PG8_BIAS_DMA(unit, slotidx) do { if constexpr (has_pre<Epi>::value) { if (wid == 0) { const float* bp_ = E.bias_tile(unit); \
        if (bp_) __builtin_amdgcn_global_load_lds((const unsigned*)((const char*)bp_ + lane * 16), (LAS unsigned*)(bslot + ((slotidx) & 1) * 1024), 16, 0, 0); } } } while (0)
    PG8_BIAS_DMA(cur, 0);
    const char* cA = (const char*)g.A + (size_t)cur.pm * tstepA + (size_t)cur.pn * g.aoffN; const char* cB = (const char*)g.Bt + (size_t)cur.pn * tstepB;
    PG8_STAGE(PG8_SB(0, 0), cB, voffB); PG8_STAGE(PG8_SB(0, 1), cB + hstepB, voffB); PG8_STAGE(PG8_SA(0, 0), cA, voffA); PG8_STAGE(PG8_SA(0, 1), cA + hstepA, voffA);
    if (wr == 1) PG8_BAR;
    PG8_WAIT_V(2); PG8_BAR;
    PG8_STAGE(PG8_SB(1, 0), cB + kstep, voffB); PG8_STAGE(PG8_SA(1, 0), cA + kstep, voffA); PG8_STAGE(PG8_SB(1, 1), cB + hstepB + kstep, voffB);
    PG8_WAIT_V(6); PG8_BAR;
    for (;;) {
        const bool has_next = S.next(ui + 1, nxt);
        const char* nA = has_next ? (const char*)g.A + (size_t)nxt.pm * tstepA + (size_t)nxt.pn * g.aoffN : cA; const char* nB = has_next ? (const char*)g.Bt + (size_t)nxt.pn * tstepB : cB;
        for (int t = 0; t < nt; t += 2) {
            const bool last = (t == nt - 2);
            if (last && has_next) PG8_BIAS_DMA(nxt, ui + 1);
            const char* a1 = cA + (size_t)(t + 1) * kstep;
            const char* a2 = last ? nA : cA + (size_t)(t + 2) * kstep; const char* b2 = last ? nB : cB + (size_t)(t + 2) * kstep;
            const char* a3 = a2 + kstep; const char* b3 = b2 + kstep;
            PG8_LDB(B0, 0, 0); PG8_LDB(B1, 0, 1); PG8_SCHED; PG8_LDA(At, 0, 0); PG8_STAGE(PG8_SA(1, 1), a1 + hstepA, voffA);
            PG8_WAIT_V(8); PG8_WAIT_L(0); PG8_BAR; PG8_MMA(0, 0, At, B0); PG8_MMA(0, 1, At, B1); PG8_BAR; PG8_SCHED;
            PG8_LDA(At, 0, 1); PG8_STAGE(PG8_SB(0, 0), b2, voffB); PG8_STAGE(PG8_SB(0, 1), b2 + hstepB, voffB); PG8_STAGE(PG8_SA(0, 0), a2, voffA);
            PG8_WAIT_V(8); PG8_WAIT_L(0); PG8_BAR; PG8_MMA(1, 0, At, B0); PG8_MMA(1, 1, At, B1); PG8_BAR; PG8_SCHED;
            PG8_LDB(B0, 1, 0); PG8_LDB(B1, 1, 1); PG8_SCHED; PG8_LDA(At, 1, 0); PG8_STAGE(PG8_SA(0, 1), a2 + hstepA, voffA);
            PG8_WAIT_V(8); PG8_WAIT_L(0); PG8_BAR; PG8_MMA(0, 0, At, B0); PG8_MMA(0, 1, At, B1); PG8_BAR; PG8_SCHED;
            PG8_LDA(At, 1, 1); PG8_STAGE(PG8_SB(1, 0), b3, voffB); PG8_STAGE(PG8_SB(1, 1), b3 + hstepB, voffB); PG8_STAGE(PG8_SA(1, 0), a3, voffA);
            PG8_WAIT_V(8); PG8_WAIT_L(0); PG8_BAR; PG8_MMA(1, 0, At, B0); PG8_MMA(1, 1, At, B1); PG8_BAR; PG8_SCHED;
        }
        if (wr == 0) PG8_BAR;
        asm volatile("" ::: "memory"); PG8_SCHED;
        if constexpr (has_pre<Epi>::value) E.run(acc, cur, wr, wc, fr, fq, (const LAS float*)(bslot + (ui & 1) * 1024)); else E(acc, cur, wr, wc, fr, fq);
        if (!has_next) break;
#pragma unroll
        for (int a = 0; a < 2; ++a)
#pragma unroll
            for (int b = 0; b < 2; ++b)
#pragma unroll
                for (int m = 0; m < 4; ++m)
#pragma unroll
                    for (int n = 0; n < 2; ++n) acc[a][b][m][n] = (f32x4){0.f, 0.f, 0.f, 0.f};
        cur = nxt; cA = nA; cB = nB; ++ui;
        if (wr == 1) PG8_BAR;
    }
    PG8_WAIT_V(0);
    PG8_BAR;
#undef PG8_BIAS_DMA
#undef PG8_SA
#undef PG8_SB
#undef PG8_STAGE
#undef PG8_LDA
#undef PG8_LDB
#undef PG8_MMA
#undef PG8_WAIT_V
#undef PG8_WAIT_L
#undef PG8_BAR
#undef PG8_SCHED
}

struct EpiProj {
    static constexpr bool PERM = true; static constexpr bool HAS_PRE = true;
    bf16_t* O; int ldc; const float* bias; int has_shift;
    __device__ __forceinline__ const float* bias_tile(const Unit& u) const {
        if (!bias) return nullptr;
        const int colt = u.pn * BM; int shift = 0; if (has_shift) shift = (colt >= 1536 ? 8 : 0) + (colt >= 3584 ? 8 : 0);
        return bias + colt + shift;
    }
    __device__ __forceinline__ void run(f32x4 (&acc)[2][2][4][2], const Unit& u, int wr, int wc, int fr, int fq, const LAS float* bl) const {
        const int row0 = u.pm * BM + wr * 64 + fr; const int col0 = u.pn * BM + wc * 32 + 8 * fq;
        f32x4 bv[2][2];
#pragma unroll
        for (int bj = 0; bj < 2; ++bj)
#pragma unroll
            for (int n = 0; n < 2; ++n) bv[bj][n] = bias ? *(const LAS f32x4*)(bl + wc * 32 + 8 * fq + bj * HALF + 4 * n) : (f32x4){0.f, 0.f, 0.f, 0.f};
#pragma unroll
        for (int ai = 0; ai < 2; ++ai)
#pragma unroll
            for (int m = 0; m < 4; ++m) { bf16_t* rowp = O + (size_t)(row0 + ai * HALF + m * 16) * ldc + col0;
#pragma unroll
                for (int bj = 0; bj < 2; ++bj) { const f32x4 v0 = acc[ai][bj][m][0] + bv[bj][0], v1 = acc[ai][bj][m][1] + bv[bj][1];
                    u32x4 w; w.x = pk2(v0[0], v0[1]); w.y = pk2(v0[2], v0[3]); w.z = pk2(v1[0], v1[1]); w.w = pk2(v1[2], v1[3]);
                    __builtin_nontemporal_store(w, (u32x4*)(rowp + bj * HALF)); } }
    }
};
template <int MODE> struct EpiY {
    static constexpr bool PERM = true;
    bf16_t* Y; const bf16_t* G;
    __device__ __forceinline__ void operator()(f32x4 (&acc)[2][2][4][2], const Unit& u, int wr, int wc, int fr, int fq) const {
        const int row0 = u.pm * BM + wr * 64 + fr; const int col0 = u.pn * BM + wc * 32 + 8 * fq;
#pragma unroll
        for (int ai = 0; ai < 2; ++ai) {
            u32x4 gv[4][2], yo[4][2];
#pragma unroll
            for (int m = 0; m < 4; ++m)
#pragma unroll
                for (int bj = 0; bj < 2; ++bj) { const size_t row = (size_t)(row0 + ai * HALF + m * 16); const int col = col0 + bj * HALF;
                    gv[m][bj] = __builtin_nontemporal_load((const u32x4*)(G + row * NP + col)); if (MODE == 1) yo[m][bj] = *(const u32x4*)(Y + row * DM + col); }
            asm volatile("" ::: "memory");
#pragma unroll
            for (int m = 0; m < 4; ++m)
#pragma unroll
                for (int bj = 0; bj < 2; ++bj) { const size_t row = (size_t)(row0 + ai * HALF + m * 16); const int col = col0 + bj * HALF;
                    const f32x4 a0 = acc[ai][bj][m][0], a1 = acc[ai][bj][m][1]; float gsg[8], r[8]; unpack8(gv[m][bj], gsg);
#pragma unroll
                    for (int e = 0; e < 4; ++e) { r[e] = sigmoidf_(gsg[e]) * a0[e]; r[4 + e] = sigmoidf_(gsg[4 + e]) * a1[e]; }
                    if (MODE == 1) { float yv[8]; unpack8(yo[m][bj], yv);
#pragma unroll
                        for (int e = 0; e < 8; ++e) r[e] += yv[e]; }
                    *(u32x4*)(Y + row * DM + col) = pack8(r); }
            asm volatile("" ::: "memory");
        }
    }
};
template <int XBF> struct EpiRes {
    static constexpr bool PERM = true;
    const void* X; const float* gmod; bf16_t* Z;
    __device__ __forceinline__ void operator()(f32x4 (&acc)[2][2][4][2], const Unit& u, int wr, int wc, int fr, int fq) const {
        const int row0 = u.pm * BM + wr * 64 + fr; const int col0 = u.pn * BM + wc * 32 + 8 * fq; const int b = (u.pm * BM) >> 11;
        f32x4 gv[2][2];
#pragma unroll
        for (int bj = 0; bj < 2; ++bj)
#pragma unroll
            for (int n = 0; n < 2; ++n) gv[bj][n] = *(const f32x4*)(gmod + (size_t)b * 6144 + col0 + bj * HALF + n * 4);
#pragma unroll
        for (int ai = 0; ai < 2; ++ai) {
            f32x4 xv[4][2][2];
#pragma unroll
            for (int m = 0; m < 4; ++m)
#pragma unroll
                for (int bj = 0; bj < 2; ++bj) { const size_t off = (size_t)(row0 + ai * HALF + m * 16) * DM + col0 + bj * HALF;
                    if (XBF) { const u32x4 w = *(const u32x4*)((const bf16_t*)X + off); xv[m][bj][0] = (f32x4){bflo(w.x), bfhi(w.x), bflo(w.y), bfhi(w.y)}; xv[m][bj][1] = (f32x4){bflo(w.z), bfhi(w.z), bflo(w.w), bfhi(w.w)}; }
                    else { xv[m][bj][0] = __builtin_nontemporal_load((const f32x4*)((const float*)X + off)); xv[m][bj][1] = __builtin_nontemporal_load((const f32x4*)((const float*)X + off + 4)); } }
            asm volatile("" ::: "memory");
#pragma unroll
            for (int m = 0; m < 4; ++m)
#pragma unroll
                for (int bj = 0; bj < 2; ++bj) { const size_t off = (size_t)(row0 + ai * HALF + m * 16) * DM + col0 + bj * HALF;
                    const f32x4 o0 = xv[m][bj][0] * ALPHA + gv[bj][0] * acc[ai][bj][m][0], o1 = xv[m][bj][1] * ALPHA + gv[bj][1] * acc[ai][bj][m][1];
                    u32x4 w; w.x = pk2(o0[0], o0[1]); w.y = pk2(o0[2], o0[3]); w.z = pk2(o1[0], o1[1]); w.w = pk2(o1[2], o1[3]);
                    *(u32x4*)(Z + off) = w; }
            asm volatile("" ::: "memory");
        }
    }
};
struct EpiSwiglu {
    static constexpr bool PERM = true;
    bf16_t* O;
    __device__ __forceinline__ void operator()(f32x4 (&acc)[2][2][4][2], const Unit& u, int wr, int wc, int fr, int fq) const {
        const int row0 = u.pm * BM + wr * 64 + fr; const int col0 = u.pn * HALF + wc * 32 + 8 * fq;
#pragma unroll
        for (int ai = 0; ai < 2; ++ai)
#pragma unroll
            for (int m = 0; m < 4; ++m) { bf16_t* rowp = O + (size_t)(row0 + ai * HALF + m * 16) * DFF + col0;
                const f32x4 g0 = acc[ai][0][m][0], g1 = acc[ai][0][m][1], u0 = acc[ai][1][m][0], u1 = acc[ai][1][m][1];
                float r[8];
#pragma unroll
                for (int e = 0; e < 4; ++e) { r[e] = g0[e] * sigmoidf_(g0[e]) * u0[e]; r[4 + e] = g1[e] * sigmoidf_(g1[e]) * u1[e]; }
                u32x4 w; w.x = pk2(r[0], r[1]); w.y = pk2(r[2], r[3]); w.z = pk2(r[4], r[5]); w.w = pk2(r[6], r[7]);
                __builtin_nontemporal_store(w, (u32x4*)rowp); }
    }
};

struct PanelStats {
    unsigned long long* xbuf;
    unsigned* cnt;
    LAS unsigned char* scr;
    __device__ __forceinline__ void run(const f32x4 (&v)[2][2][4][2], const Unit& u, int wr, int wc, int fr, int fq) const {
        const int lane = threadIdx.x & 63, wid = __builtin_amdgcn_readfirstlane(threadIdx.x >> 6);
        LAS f32x2* P = (LAS f32x2*)scr;
        LAS f32x2* S = (LAS f32x2*)(scr + 8192);
#pragma unroll
        for (int ai = 0; ai < 2; ++ai)
#pragma unroll
            for (int m = 0; m < 4; ++m) {
                float s = 0.f;
#pragma unroll
                for (int bj = 0; bj < 2; ++bj)
#pragma unroll
                    for (int n = 0; n < 2; ++n) { const f32x4 x = v[ai][bj][m][n]; s += (x[0] + x[1]) + (x[2] + x[3]); }
                s += __shfl_xor(s, 16); s += __shfl_xor(s, 32);
                const float mw = s * (1.0f / 64.0f); float q = 0.f;
#pragma unroll
                for (int bj = 0; bj < 2; ++bj)
#pragma unroll
                    for (int n = 0; n < 2; ++n) { const f32x4 d = v[ai][bj][m][n] - mw; q += (d[0] * d[0] + d[1] * d[1]) + (d[2] * d[2] + d[3] * d[3]); }
                q += __shfl_xor(q, 16); q += __shfl_xor(q, 32);
                if (fq == 0) P[(ai * HALF + wr * 64 + m * 16 + fr) * 4 + wc] = (f32x2){mw, q};
            }
        asm volatile("s_waitcnt lgkmcnt(0)" ::: "memory"); __builtin_amdgcn_s_barrier(); asm volatile("" ::: "memory");
        const int row = wid * 32 + (lane & 31);
        if (lane < 32) {
            const f32x2 a = P[row * 4 + 0], b = P[row * 4 + 1], c = P[row * 4 + 2], d = P[row * 4 + 3];
            const float mt = (a.x + b.x + c.x + d.x) * 0.25f;
            const float da = a.x - mt, db = b.x - mt, dc = c.x - mt, dd = d.x - mt;
            const float m2 = (a.y + b.y) + (c.y + d.y) + 64.0f * ((da * da + db * db) + (dc * dc + dd * dd));
            unsigned long long* slot = xbuf + ((size_t)(u.pm * BM + row) * 4 + u.pn);
            __hip_atomic_store(slot, ((unsigned long long)__float_as_uint(m2) << 32) | __float_as_uint(mt), __ATOMIC_RELAXED, __HIP_MEMORY_SCOPE_AGENT);
        }
        asm volatile("s_waitcnt vmcnt(0)" ::: "memory");
        if (lane == 0) __hip_atomic_fetch_add(cnt + 64 * u.pm, 1u, __ATOMIC_RELAXED, __HIP_MEMORY_SCOPE_AGENT);
        if (wid == 0) {
            unsigned sp = 0;
            for (;;) {
                if ((unsigned)__builtin_amdgcn_readfirstlane(__hip_atomic_load(cnt + 64 * u.pm, __ATOMIC_RELAXED, __HIP_MEMORY_SCOPE_AGENT)) >= 32u) break;
                if (++sp > (1u << 24)) break;
                __builtin_amdgcn_s_sleep(2);
            }
            __builtin_amdgcn_fence(__ATOMIC_ACQUIRE, "agent");
        }
        asm volatile("s_waitcnt vmcnt(0) lgkmcnt(0)" ::: "memory"); __builtin_amdgcn_s_barrier(); asm volatile("" ::: "memory");
        if (lane < 32) {
            const unsigned long long* slot = xbuf + (size_t)(u.pm * BM + row) * 4; float mt[4], m2[4]; float ms = 0.f;
#pragma unroll
            for (int t = 0; t < 4; ++t) { const unsigned long long w = __hip_atomic_load(slot + t, __ATOMIC_RELAXED, __HIP_MEMORY_SCOPE_AGENT); mt[t] = __uint_as_float((unsigned)w); m2[t] = __uint_as_float((unsigned)(w >> 32)); ms += mt[t]; }
            const float mean = ms * 0.25f; float q = 0.f;
#pragma unroll
            for (int t = 0; t < 4; ++t) { const float dm = mt[t] - mean; q += m2[t] + 256.0f * dm * dm; }
            S[row] = (f32x2){mean, 1.0f / sqrtf(q * (1.0f / 1024.0f) + LN_EPS)};
        }
        asm volatile("s_waitcnt lgkmcnt(0)" ::: "memory"); __builtin_amdgcn_s_barrier(); asm volatile("" ::: "memory");
    }
};
__device__ __forceinline__ const char* uptr(const void* p) { const unsigned long long v = (unsigned long long)p;
    const unsigned lo = __builtin_amdgcn_readfirstlane((unsigned)v), hi = __builtin_amdgcn_readfirstlane((unsigned)(v >> 32)); return (const char*)(((unsigned long long)hi << 32) | lo); }
__device__ __forceinline__ f32x4 ld4bf(const bf16_t* p) { const u32x2 w = __builtin_nontemporal_load((const u32x2*)p); return (f32x4){bflo(w.x), bfhi(w.x), bflo(w.y), bfhi(w.y)}; }
#define EPI_FOR4 _Pragma("unroll") for (int bj = 0; bj < 2; ++bj) _Pragma("unroll") for (int n = 0; n < 2; ++n)
#define EPI_ROWS _Pragma("unroll") for (int ai = 0; ai < 2; ++ai) _Pragma("unroll") for (int m = 0; m < 4; ++m)
struct EpiLnOut {
    static constexpr bool PERM = false;
    const bf16_t* X1; const float* gmod; const float* lg; const float* lb; float* OUT; PanelStats st;
    __device__ __forceinline__ void operator()(f32x4 (&acc)[2][2][4][2], const Unit& u, int wr, int wc, int fr, int fq) const {
        const int b = (u.pm * BM) >> 11; const unsigned loff = (unsigned)(fr * DM + 4 * fq), coff = 4 * fq;
        const size_t ub = (size_t)(u.pm * BM + wr * 64) * DM + u.pn * BM + wc * 32; const int cb = u.pn * BM + wc * 32;
        const float* gm = gmod + (size_t)b * 6144 + cb;
        EPI_FOR4 { const f32x4 gv = *(const f32x4*)(gm + (bj * HALF + n * 16) + coff);
            EPI_ROWS { const f32x4 xv = ld4bf(X1 + (ub + (size_t)((ai * HALF + m * 16) * DM + bj * HALF + n * 16)) + loff);
                acc[ai][bj][m][n] = xv * ALPHA + gv * acc[ai][bj][m][n]; }
            asm volatile("" ::: "memory"); __builtin_amdgcn_sched_barrier(0); }
        st.run(acc, u, wr, wc, fr, fq);
        const LAS f32x2* S = (const LAS f32x2*)(st.scr + 8192) + (wr * 64 + fr);
        EPI_FOR4 { const f32x4 g4 = *(const f32x4*)(lg + (cb + bj * HALF + n * 16) + coff), b4 = *(const f32x4*)(lb + (cb + bj * HALF + n * 16) + coff);
            EPI_ROWS { const f32x2 sr = S[ai * HALF + m * 16];
                __builtin_nontemporal_store((f32x4)((acc[ai][bj][m][n] - sr.x) * sr.y * g4 + b4), (f32x4*)(OUT + (ub + (size_t)((ai * HALF + m * 16) * DM + bj * HALF + n * 16)) + loff)); }
            asm volatile("" ::: "memory"); __builtin_amdgcn_sched_barrier(0); }
    }
};
struct EpiLnMid {
    static constexpr bool PERM = false;
    const float* X; const float* lg; const float* lb; unsigned char* wsb; bf16_t* H2; LAS unsigned char* scr;
    __device__ __forceinline__ void operator()(f32x4 (&acc)[2][2][4][2], const Unit& u, int wr, int wc, int fr, int fq) const {
        const int b = (u.pm * BM) >> 11; const unsigned loff = (unsigned)(fr * DM + 4 * fq), coff = 4 * fq;
        const size_t ub = (size_t)(u.pm * BM + wr * 64) * DM + u.pn * BM + wc * 32; const int cb = u.pn * BM + wc * 32;
        const float* modb = (const float*)(wsb + WS_MOD) + (size_t)b * 6144 + cb; bf16_t* X1 = (bf16_t*)(wsb + WS_X1);
        const PanelStats st1{(unsigned long long*)(wsb + WS_XB1), (unsigned*)(wsb + WS_CNT), scr}, st2{(unsigned long long*)(wsb + WS_XB2), (unsigned*)(wsb + WS_CNT + 32768), scr};
        EPI_FOR4 { const f32x4 gv = *(const f32x4*)(modb + (2048 + bj * HALF + n * 16) + coff);
            EPI_ROWS { const f32x4 xv = *(const f32x4*)(X + (ub + (size_t)((ai * HALF + m * 16) * DM + bj * HALF + n * 16)) + loff);
                acc[ai][bj][m][n] = xv * ALPHA + gv * acc[ai][bj][m][n]; if (m & 1) asm volatile("" ::: "memory"); __builtin_amdgcn_sched_barrier(0); }
            asm volatile("" ::: "memory"); __builtin_amdgcn_sched_barrier(0); }
        st1.run(acc, u, wr, wc, fr, fq);
        { const LAS f32x2* S = (const LAS f32x2*)(st1.scr + 8192) + (wr * 64 + fr);
        EPI_FOR4 { const f32x4 g4 = *(const f32x4*)(lg + (cb + bj * HALF + n * 16) + coff), b4 = *(const f32x4*)(lb + (cb + bj * HALF + n * 16) + coff);
            EPI_ROWS { const f32x2 sr = S[ai * HALF + m * 16];
                const f32x4 o = (acc[ai][bj][m][n] - sr.x) * sr.y * g4 + b4; acc[ai][bj][m][n] = o;
                u32x2 w; w.x = pk2(o[0], o[1]); w.y = pk2(o[2], o[3]);
                *(u32x2*)(X1 + (ub + (size_t)((ai * HALF + m * 16) * DM + bj * HALF + n * 16)) + loff) = w; }
            asm volatile("" ::: "memory"); __builtin_amdgcn_sched_barrier(0); } }
        st2.run(acc, u, wr, wc, fr, fq);
        { const LAS f32x2* S = (const LAS f32x2*)(st2.scr + 8192) + (wr * 64 + fr);
        EPI_FOR4 { const f32x4 sh = *(const f32x4*)(modb + (3072 + bj * HALF + n * 16) + coff), sc = *(const f32x4*)(modb + (4096 + bj * HALF + n * 16) + coff) + 1.0f;
            EPI_ROWS { const f32x2 sr = S[ai * HALF + m * 16];
                const f32x4 o = (acc[ai][bj][m][n] - sr.x) * sr.y * sc + sh;
                u32x2 w; w.x = pk2(o[0], o[1]); w.y = pk2(o[2], o[3]);
                *(u32x2*)(H2 + (ub + (size_t)((ai * HALF + m * 16) * DM + bj * HALF + n * 16)) + loff) = w; }
            asm volatile("" ::: "memory"); __builtin_amdgcn_sched_barrier(0); } }
    }
};
#undef EPI_FOR4
#undef EPI_ROWS
}

__device__ __forceinline__ void tr_item(const float* __restrict__ src, int ld, int k0, int c0, bf16_t* dst, int dstK, int r0, LAS float* scr, int lane) {
    f32x4 t[8];
#pragma unroll
    for (int i = 0; i < 8; ++i) t[i] = *(const f32x4*)(src + (size_t)(k0 + 8 * i + (lane >> 3)) * ld + c0 + 4 * (lane & 7));
#pragma unroll
    for (int i = 0; i < 8; ++i) { LAS float* d = scr + (8 * i + (lane >> 3)) * 33 + 4 * (lane & 7); d[0] = t[i][0]; d[1] = t[i][1]; d[2] = t[i][2]; d[3] = t[i][3]; }
    LDS_WAIT();
    const int c = lane & 7;
#pragma unroll
    for (int j = 0; j < 4; ++j) { const int n = (lane >> 3) + 8 * j; const LAS float* s = scr + (8 * c) * 33 + n;
        u32x4 o; o.x = pk2(s[0 * 33], s[1 * 33]); o.y = pk2(s[2 * 33], s[3 * 33]); o.z = pk2(s[4 * 33], s[5 * 33]); o.w = pk2(s[6 * 33], s[7 * 33]);
        *(u32x4*)(dst + (size_t)(r0 + n) * dstK + k0 + 8 * c) = o; }
    LDS_WAIT();
}

__device__ __forceinline__ void split_arrive(unsigned* ctr);
__device__ __forceinline__ void split_wait(unsigned* ctr, unsigned want);
__device__ __forceinline__ void p0_prologue(LAS unsigned char* lds, const float* const* in, unsigned char* ws, unsigned* ctr) {
    const int tid = threadIdx.x, lane = tid & 63, wave = __builtin_amdgcn_readfirstlane(tid >> 6);
    const int G = gridDim.x;
    {
        const float* c = in[1]; const float* w_ada = in[2]; const float* b_ada = in[3]; float* MOD = (float*)(ws + WS_MOD);
        LAS float* sc = (LAS float*)lds; LAS float* red = (LAS float*)(lds + 65536);
        if ((int)blockIdx.x < 192) {
            for (int idx = tid; idx < 16384; idx += 512) { const int b = idx & 15, k = idx >> 4; const float v = c[b * 1024 + k]; sc[k * 16 + b] = v / (1.0f + expf(-v)); }
            __syncthreads();
            for (int item = blockIdx.x; item < 192; item += G) {
                const int e = item * 32 + (lane & 31), kbase = wave * 128 + (lane >> 5) * 64;
                float acc[16];
#pragma unroll
                for (int b = 0; b < 16; ++b) acc[b] = 0.f;
                for (int kk0 = 0; kk0 < 64; kk0 += 16) {
                    float wv[16];
#pragma unroll
                    for (int i = 0; i < 16; ++i) wv[i] = w_ada[(size_t)(kbase + kk0 + i) * 6144 + e];
#pragma unroll
                    for (int i = 0; i < 16; ++i) { const int k = kbase + kk0 + i; const float w = wv[i];
                        const LAS f32x4* s = (const LAS f32x4*)(sc + k * 16);
#pragma unroll
                        for (int q = 0; q < 4; ++q) { const f32x4 sv = s[q]; acc[4 * q + 0] += sv[0] * w; acc[4 * q + 1] += sv[1] * w; acc[4 * q + 2] += sv[2] * w; acc[4 * q + 3] += sv[3] * w; } } }
#pragma unroll
                for (int b = 0; b < 16; ++b) { acc[b] += __shfl_xor(acc[b], 32); if (lane < 32) red[(wave * 16 + b) * 32 + lane] = acc[b]; }
                __syncthreads();
                { const int b = tid >> 5, col = tid & 31; float s = 0.f;
#pragma unroll
                  for (int w = 0; w < 8; ++w) s += red[(w * 16 + b) * 32 + col];
                  MOD[b * 6144 + item * 32 + col] = s + b_ada[item * 32 + col]; }
                __syncthreads();
            }
        }
        __syncthreads();
    }
    {
        const float* w_in = in[4]; const float* b_in = in[5]; float* WG = (float*)(ws + WS_WG); float* BG = (float*)(ws + WS_BG);
        for (int idx = blockIdx.x * 512 + tid; idx < 16384; idx += G * 512) { const int j = idx >> 10, k = idx & 1023;
            const int col = j < 8 ? 1536 + j : (j < 12 ? 3592 + (j - 8) : 3596 + (j - 12));
            WG[idx] = w_in[(size_t)k * DIN + col]; if (k == 0) BG[j] = b_in[col]; }
    }
    split_arrive(ctr);
    {
        LAS float* scr = (LAS float*)(lds + wave * 16384);
        const int gw = blockIdx.x * 8 + wave, NGW = G * 8;
        constexpr int NITEMS = 3328 + 128 + 256 + 512 + 512 + 2816 + 1408;
        for (int it = gw; it < NITEMS; it += NGW) {
            int r = it; const float* src; int ld, k0, c0, dstK, r0; bf16_t* dst;
            if (r < 3328) { const int kb = r / 208, nb = r % 208, n0 = nb * 32; src = in[4]; ld = DIN; k0 = kb * 64; c0 = n0 + (n0 >= 1536 ? 8 : 0) + (n0 >= 3584 ? 8 : 0); dst = (bf16_t*)(ws + WS_WT_IN); dstK = 1024; r0 = n0; }
            else if ((r -= 3328) < 128) { const int sj = r >> 4, q = r & 15, h = sj >> 1, which = sj & 1, kb = q >> 2, nb = q & 3; src = (which ? in[9] : in[8]) + (size_t)h * 256 * 128; ld = 128; k0 = kb * 64; c0 = nb * 32; dst = (bf16_t*)(ws + WS_WT_QK); dstK = 256; r0 = h * 256 + which * 128 + nb * 32; }
            else if ((r -= 128) < 256) { const int kb = r >> 5, nb = r & 31; src = in[11]; ld = 1024; k0 = kb * 64; c0 = nb * 32; dst = (bf16_t*)(ws + WS_WT_PA); dstK = 512; r0 = nb * 32; }
            else if ((r -= 256) < 512) { const int kb = r >> 5, nb = r & 31; src = in[12]; ld = 1024; k0 = kb * 64; c0 = nb * 32; dst = (bf16_t*)(ws + WS_WT_PB); dstK = 1024; r0 = nb * 32; }
            else if ((r -= 512) < 512) { const int kb = r >> 5, nb = r & 31; src = in[13]; ld = 1024; k0 = kb * 64; c0 = nb * 32; dst = (bf16_t*)(ws + WS_WT_OUT); dstK = 1024; r0 = nb * 32; }
            else if ((r -= 512) < 2816) { const int kb = r / 176, nb = r % 176, n0 = nb * 32, pn = n0 >> 8, hh = (n0 & 255) >> 7, j = n0 & 127; src = in[16]; ld = 2 * DFF; k0 = kb * 64; c0 = hh * DFF + 128 * pn + j; dst = (bf16_t*)(ws + WS_WT_FI); dstK = 1024; r0 = n0; }
            else { r -= 2816; const int kb = r >> 5, nb = r & 31; src = in[17]; ld = 1024; k0 = kb * 64; c0 = nb * 32; dst = (bf16_t*)(ws + WS_WT_FD); dstK = DFF; r0 = nb * 32; }
            tr_item(src, ld, k0, c0, dst, dstK, r0, scr, lane);
        }
    }
    split_wait(ctr, gridDim.x);
}

__device__ __forceinline__ void p1_ln_gates(LAS unsigned char* lds, const float* x, const float* MOD, const float* WG, const float* BG, bf16_t* H1, float* G16) {
    const int tid = threadIdx.x, lane = tid & 63, wave = __builtin_amdgcn_readfirstlane(tid >> 6);
    LAS f32x4* WGl = (LAS f32x4*)lds;
    for (int idx = tid; idx < 4096; idx += 512) WGl[idx] = ((const f32x4*)WG)[idx];
    __syncthreads();
    for (int rp = blockIdx.x * 8 + wave; rp < MT / 2; rp += gridDim.x * 8) {
        const int r0 = 2 * rp, b = r0 >> 11;
        f32x4 v[2][4], shv[4], scv[4];
#pragma unroll
        for (int r = 0; r < 2; ++r)
#pragma unroll
            for (int j = 0; j < 4; ++j) v[r][j] = __builtin_nontemporal_load((const f32x4*)(x + (size_t)(r0 + r) * DM + 4 * lane + 256 * j));
#pragma unroll
        for (int j = 0; j < 4; ++j) { shv[j] = *(const f32x4*)(MOD + (size_t)b * 6144 + 4 * lane + 256 * j); scv[j] = *(const f32x4*)(MOD + (size_t)b * 6144 + 1024 + 4 * lane + 256 * j) + 1.0f; }
        asm volatile("" ::: "memory");
#pragma unroll
        for (int r = 0; r < 2; ++r) {
            float s = 0.f;
#pragma unroll
            for (int j = 0; j < 4; ++j) s += (v[r][j][0] + v[r][j][1]) + (v[r][j][2] + v[r][j][3]);
            const float mean = wave_sum(s) * (1.f / DM); float s2 = 0.f;
#pragma unroll
            for (int j = 0; j < 4; ++j) { v[r][j] = v[r][j] - mean; s2 += (v[r][j][0] * v[r][j][0] + v[r][j][1] * v[r][j][1]) + (v[r][j][2] * v[r][j][2] + v[r][j][3] * v[r][j][3]); }
            const float rstd = 1.f / sqrtf(wave_sum(s2) * (1.f / DM) + LN_EPS);
#pragma unroll
            for (int j = 0; j < 4; ++j) {
                v[r][j] = v[r][j] * rstd * scv[j] + shv[j];
                u32x2 o; o.x = pk2(v[r][j][0], v[r][j][1]); o.y = pk2(v[r][j][2], v[r][j][3]);
                *(u32x2*)(H1 + (size_t)(r0 + r) * DM + 4 * lane + 256 * j) = o; }
        }
        float vals[32];
#pragma unroll
        for (int j16 = 0; j16 < 16; ++j16) { float p0 = 0.f, p1 = 0.f;
#pragma unroll
            for (int q = 0; q < 4; ++q) { const f32x4 w = WGl[j16 * 256 + lane + 64 * q];
                p0 += (v[0][q][0] * w[0] + v[0][q][1] * w[1]) + (v[0][q][2] * w[2] + v[0][q][3] * w[3]);
                p1 += (v[1][q][0] * w[0] + v[1][q][1] * w[1]) + (v[1][q][2] * w[2] + v[1][q][3] * w[3]); }
            vals[j16] = p0; vals[16 + j16] = p1; asm volatile("" ::: "memory"); }
#define BFLY(N, MASK) { const bool up = (lane & MASK) != 0; _Pragma("unroll") for (int i = 0; i < N; ++i) { const float lo = vals[i], hi = vals[i + N]; const float send = up ? lo : hi, keep = up ? hi : lo; vals[i] = keep + __shfl_xor(send, MASK); } }
        BFLY(16, 32) BFLY(8, 16) BFLY(4, 8) BFLY(2, 4) BFLY(1, 2)
#undef BFLY
        const float tot = vals[0] + __shfl_xor(vals[0], 1);
        const int idx = lane >> 1;
        if (!(lane & 1)) G16[(size_t)(r0 + (idx >> 4)) * 16 + (idx & 15)] = tot + BG[idx & 15];
    }
}

__device__ __forceinline__ void fscan(LAS unsigned char* lds, const float* G16, float* FCUM) {
    const int tid = threadIdx.x, lane = tid & 63, wave = __builtin_amdgcn_readfirstlane(tid >> 6);
    LAS float* wsum = (LAS float*)lds;
    for (int s = blockIdx.x; s < 128; s += gridDim.x) {
        const int b = s >> 3, hh = s & 7;
        float v[4];
#pragma unroll
        for (int i = 0; i < 4; ++i) v[i] = logsig(G16[(size_t)(b * SEQ + 4 * tid + i) * 16 + hh]) * LOG2E;
        v[1] += v[0]; v[2] += v[1]; v[3] += v[2];
        const float tot = v[3]; float sc = tot;
#pragma unroll
        for (int o = 1; o < 64; o <<= 1) { const float y = __shfl_up(sc, o); if (lane >= o) sc += y; }
        if (lane == 63) wsum[wave] = sc;
        __syncthreads();
        float off = 0.f;
        for (int w = 0; w < wave; ++w) off += wsum[w];
        const float excl = off + sc - tot;
#pragma unroll
        for (int i = 0; i < 4; ++i) FCUM[(size_t)s * SEQ + 4 * tid + i] = v[i] + excl;
        __syncthreads();
    }
}

__device__ __forceinline__ void conv_phase(const bf16_t* PROJ, const float* conv_w, const float* conv_b, bf16_t* U) {
    const int tid = threadIdx.x, lane = tid & 63, wave = __builtin_amdgcn_readfirstlane(tid >> 6);
    const int gw = blockIdx.x * 8 + wave, NGW = gridDim.x * 8;
    for (int it = gw; it < 4096; it += NGW) {
        const int rg = it >> 1, chf = it & 1, m0 = rg * 16, c = chf * 512 + lane * 8;
        float w[4][8], cb[8];
#pragma unroll
        for (int j = 0; j < 4; ++j) { const f32x4 a = *(const f32x4*)(conv_w + j * 1024 + c), bq = *(const f32x4*)(conv_w + j * 1024 + c + 4);
            w[j][0] = a[0]; w[j][1] = a[1]; w[j][2] = a[2]; w[j][3] = a[3]; w[j][4] = bq[0]; w[j][5] = bq[1]; w[j][6] = bq[2]; w[j][7] = bq[3]; }
        { const f32x4 a = *(const f32x4*)(conv_b + c), bq = *(const f32x4*)(conv_b + c + 4); cb[0] = a[0]; cb[1] = a[1]; cb[2] = a[2]; cb[3] = a[3]; cb[4] = bq[0]; cb[5] = bq[1]; cb[6] = bq[2]; cb[7] = bq[3]; }
        const bool has_prev = (m0 & (SEQ - 1)) != 0;
        u32x4 raw[19];
#pragma unroll
        for (int j = 0; j < 3; ++j) { raw[j] = (u32x4){0u, 0u, 0u, 0u}; if (has_prev) raw[j] = __builtin_nontemporal_load((const u32x4*)(PROJ + (size_t)(m0 - 3 + j) * NP + C_MU + c)); }
#pragma unroll
        for (int r = 0; r < 16; ++r) raw[3 + r] = __builtin_nontemporal_load((const u32x4*)(PROJ + (size_t)(m0 + r) * NP + C_MU + c));
#pragma unroll
        for (int r = 0; r < 16; ++r) {
            float x0[8], x1[8], x2[8], x3[8]; unpack8(raw[r], x0); unpack8(raw[r + 1], x1); unpack8(raw[r + 2], x2); unpack8(raw[r + 3], x3);
            float y[8];
#pragma unroll
            for (int e = 0; e < 8; ++e) { const float t = w[0][e] * x0[e] + w[1][e] * x1[e] + w[2][e] * x2[e] + w[3][e] * x3[e] + cb[e]; y[e] = t * sigmoidf_(t); }
            *(u32x4*)(U + (size_t)(m0 + r) * DM + c) = pack8(y);
        }
    }
}


namespace fox_attn {
using bf16=__hip_bfloat16;
using bf16x8=__attribute__((ext_vector_type(8)))short;
using s16x4=__attribute__((ext_vector_type(4)))short;
using f32x16=__attribute__((ext_vector_type(16)))float;
using u32x4=__attribute__((ext_vector_type(4)))unsigned;
using f32x4v=__attribute__((ext_vector_type(4)))float;
constexpr int BATCH=16,NHEAD=8,SEQ=2048,D=64,DM=6656,OP=512;
constexpr int NW=8,QBLK=32,QB=QBLK*NW,KVBLK=64,NQB=SEQ/QB;
constexpr int ATTN_UNIT_ROWS=QB;
__device__ __forceinline__ int crow(int r,int hi){return (r&3)+8*(r>>2)+4*hi;}
#define SBAR() __builtin_amdgcn_sched_barrier(0)
__device__ __forceinline__ void cmask(f32x16&p0,f32x16&p1,int jb,int qrel,int hi){
  const float NEG=-INFINITY; int kb=64*jb+4*hi;
  #pragma unroll
  for(int r=0;r<16;++r){int kv=kb+(r&3)+8*(r>>2); if(kv>qrel)p0[r]=NEG; if(kv+32>qrel)p1[r]=NEG;}
}

constexpr int NSLOT=3, SLOTB=8192;
constexpr int LDS_K=0, LDS_V=NSLOT*SLOTB, LDS_WS=2*NSLOT*SLOTB, LDS_OST=LDS_WS+NW*64*4, LDS_BYTES=LDS_OST+NW*4096;
constexpr float C2=0.125f*1.4426950408889634f;
__device__ __forceinline__ void glds16(const void*gsrc,unsigned lds_dst){unsigned keep;
  asm volatile("s_mov_b32 %0, m0\n\ts_mov_b32 m0, %2\n\ts_nop 0\n\tglobal_load_lds_dwordx4 %1, off\n\ts_mov_b32 m0, %0":"=&s"(keep):"v"(gsrc),"s"(lds_dst):"memory");}
__device__ __forceinline__ float max3f(float a,float b,float c){float r;asm("v_max3_f32 %0, %1, %2, %3":"=v"(r):"v"(a),"v"(b),"v"(c));return r;}
__device__ __forceinline__ float max2f(float a,float b){float r;asm("v_max_f32_e32 %0, %1, %2":"=v"(r):"v"(a),"v"(b));return r;}
__device__ __forceinline__ float fadd_s(float a,float b){float r;asm("v_add_f32_e32 %0, %1, %2":"=v"(r):"v"(a),"v"(b));return r;}
__device__ __forceinline__ float fsub_s(float a,float b){float r;asm("v_sub_f32_e32 %0, %1, %2":"=v"(r):"v"(a),"v"(b));return r;}
typedef float f32x2_t __attribute__((ext_vector_type(2))); typedef __bf16 bf16x2_t __attribute__((ext_vector_type(2)));
__device__ __forceinline__ unsigned cvtpk_s(float lo,float hi){f32x2_t v={lo,hi};bf16x2_t b=__builtin_convertvector(v,bf16x2_t);return __builtin_bit_cast(unsigned,b);}
#define WAIT_BAR(N) asm volatile("s_waitcnt vmcnt(" #N ") lgkmcnt(0)\n\ts_barrier":::"memory")

__device__ __forceinline__ void qkt(f32x16&p0,f32x16&p1,const char*Kslot,const bf16x8*qr,const f32x16&negm,int r32,int hi){
  const char*kb=Kslot+hi*1024+r32*16;
  #pragma unroll
  for(int d0=0;d0<4;++d0){
    const bf16x8 b0=*reinterpret_cast<const bf16x8*>(kb+d0*2048);
    const bf16x8 b1=*reinterpret_cast<const bf16x8*>(kb+d0*2048+512);
    if(d0==0){p0=__builtin_amdgcn_mfma_f32_32x32x16_bf16(b0,qr[0],negm,0,0,0);p1=__builtin_amdgcn_mfma_f32_32x32x16_bf16(b1,qr[0],negm,0,0,0);}
    else{p0=__builtin_amdgcn_mfma_f32_32x32x16_bf16(b0,qr[d0],p0,0,0,0);p1=__builtin_amdgcn_mfma_f32_32x32x16_bf16(b1,qr[d0],p1,0,0,0);}}
}
typedef __attribute__((address_space(3))) const char* lds_cptr;
typedef short v4i16_t __attribute__((ext_vector_type(4)));
__device__ __forceinline__ void kload8(bf16x8*kf,lds_cptr kp){
  kf[0]=*(const __attribute__((address_space(3))) bf16x8*)(kp);      kf[1]=*(const __attribute__((address_space(3))) bf16x8*)(kp+512);
  kf[2]=*(const __attribute__((address_space(3))) bf16x8*)(kp+2048); kf[3]=*(const __attribute__((address_space(3))) bf16x8*)(kp+2560);
  kf[4]=*(const __attribute__((address_space(3))) bf16x8*)(kp+4096); kf[5]=*(const __attribute__((address_space(3))) bf16x8*)(kp+4608);
  kf[6]=*(const __attribute__((address_space(3))) bf16x8*)(kp+6144); kf[7]=*(const __attribute__((address_space(3))) bf16x8*)(kp+6656);
}
__device__ __forceinline__ void kload2(bf16x8*kf,lds_cptr kp,int j){ kf[2*j]=*(const __attribute__((address_space(3))) bf16x8*)(kp+j*2048); kf[2*j+1]=*(const __attribute__((address_space(3))) bf16x8*)(kp+j*2048+512); }
__device__ __forceinline__ s16x4 vtr(lds_cptr p){ return __builtin_bit_cast(s16x4,__builtin_amdgcn_ds_read_tr16_b64_v4i16((__attribute__((address_space(3))) v4i16_t*)p)); }
__device__ __forceinline__ float rowmax(const f32x16&p0,const f32x16&p1){
  float a=max3f(p0[0],p0[1],p1[0]),b=max3f(p0[2],p0[3],p1[1]);a=max3f(a,p1[2],p1[3]);
  #pragma unroll
  for(int r=4;r<16;r+=4){a=max3f(a,p0[r],p0[r+1]);b=max3f(b,p0[r+2],p0[r+3]);a=max3f(a,p1[r],p1[r+1]);b=max3f(b,p1[r+2],p1[r+3]);}
  const float m=max2f(a,b);
  auto rr=__builtin_amdgcn_permlane32_swap(__float_as_uint(m),__float_as_uint(m),false,false);
  return max2f(__uint_as_float(rr[0]),__uint_as_float(rr[1]));
}
__device__ __forceinline__ void pv(f32x16*o,int vb,bf16x8 pa0,bf16x8 pa1,bf16x8 pa2,bf16x8 pa3){
  #pragma unroll
  for(int d0=0;d0<2;++d0){s16x4 lo[4],hi[4];
    #pragma unroll
    for(int ks=0;ks<4;++ks){
      asm volatile("ds_read_b64_tr_b16 %0,%1 offset:%c2":"=&v"(lo[ks]):"v"(vb),"i"(d0*4096+ks*1024):"memory");
      asm volatile("ds_read_b64_tr_b16 %0,%1 offset:%c2":"=&v"(hi[ks]):"v"(vb),"i"(d0*4096+ks*1024+512):"memory");}
    asm volatile("s_waitcnt lgkmcnt(0)":::"memory");SBAR();
    #define PK(k) (bf16x8){lo[k][0],lo[k][1],lo[k][2],lo[k][3],hi[k][0],hi[k][1],hi[k][2],hi[k][3]}
    o[d0]=__builtin_amdgcn_mfma_f32_32x32x16_bf16(pa0,PK(0),o[d0],0,0,0);
    o[d0]=__builtin_amdgcn_mfma_f32_32x32x16_bf16(pa1,PK(1),o[d0],0,0,0);
    o[d0]=__builtin_amdgcn_mfma_f32_32x32x16_bf16(pa2,PK(2),o[d0],0,0,0);
    o[d0]=__builtin_amdgcn_mfma_f32_32x32x16_bf16(pa3,PK(3),o[d0],0,0,0);
    #undef PK
  }
}

#ifndef ATTN_STORE16
#define ATTN_STORE16(p,v) (*(u32x4*)(p)=(v))
#endif
template<int THRL> __device__ __forceinline__ void attn_unit(int b,int h,int qb,const bf16*Q,const bf16*__restrict__ K,const bf16*__restrict__ V,bf16*O,const float*__restrict__ Frow,char*shm){
  int tid_=threadIdx.x; asm volatile("":"+v"(tid_));
  const int tid=tid_,lane=tid&63,r32=lane&31,hi=lane>>5; const int wid=__builtin_amdgcn_readfirstlane(tid>>6);
  const long rowbase=(long)b*SEQ; const int q0=qb*QB;
  const bf16*Qw=Q+(rowbase+q0+wid*QBLK)*DM+h*D;
  const bf16*Kh=K+rowbase*DM+h*D,*Vh=V+rowbase*DM+h*D;
  const unsigned lds0=(unsigned)(uintptr_t)shm;
  float*wsf=(float*)(shm+LDS_WS)+wid*64;
  const bf16*ksrc=Kh+(long)lane*DM+wid*8;
  const bf16*vsrc=Vh+(long)(16*(wid&3)+(lane>>2))*DM+(wid>>2)*32+(lane&3)*8;
  const unsigned kdst=lds0+LDS_K+wid*1024, vdst=lds0+LDS_V+wid*1024;
  #define DMA_K(t,slot) glds16(ksrc+(long)(t)*KVBLK*DM,(unsigned)__builtin_amdgcn_readfirstlane(kdst+(slot)))
  #define DMA_V(t,slot) glds16(vsrc+(long)(t)*KVBLK*DM,(unsigned)__builtin_amdgcn_readfirstlane(vdst+(slot)))
  const int vb0=(int)(lds0+LDS_V)+((lane>>4)&1)*32+(lane&3)*8+(4*hi+((lane&15)>>2))*64;
  const char*Kbase=shm+LDS_K; bf16x8 kf[8];
  const lds_cptr shm3=(lds_cptr)shm; const lds_cptr kp0=shm3+LDS_K+hi*1024+r32*16; const lds_cptr vp0=shm3+LDS_V+((lane>>4)&1)*32+(lane&3)*8+(4*hi+((lane&15)>>2))*64;
  const int NT=(q0+QB)/KVBLK;
  float*nfk=(float*)(shm+LDS_BYTES);
  for(int i=tid;i<NT*KVBLK;i+=512)nfk[i]=-Frow[i];
  asm volatile("s_waitcnt vmcnt(0) lgkmcnt(0)\n\ts_barrier":::"memory");
  #define BIAS(P0,P1,t) do{ const float*nb_=nfk+(t)*KVBLK+4*hi; const float mh_=mhat; _Pragma("unroll") for(int r_=0;r_<16;++r_){ P0[r_]+=nb_[(r_&3)+8*(r_>>2)]-mh_; } \
      _Pragma("unroll") for(int r_=0;r_<16;++r_){ P1[r_]+=nb_[(r_&3)+8*(r_>>2)+32]-mh_; } }while(0)
  DMA_K(0,0);DMA_V(0,0);DMA_K(1,SLOTB);
  bf16x8 qr[4];
  #pragma unroll
  for(int d0=0;d0<4;++d0){ const u32x4 qw_=*reinterpret_cast<const u32x4*>(&Qw[(long)r32*DM+d0*16+hi*8]); u32x4 qs_;
    #define QSC(w) cvtpk_s(__uint_as_float((w)<<16)*C2,__uint_as_float((w)&0xffff0000u)*C2)
    qs_.x=QSC(qw_.x);qs_.y=QSC(qw_.y);qs_.z=QSC(qw_.z);qs_.w=QSC(qw_.w);
    #undef QSC
    qr[d0]=__builtin_bit_cast(bf16x8,qs_); }
  float mhat=0.f,l_reg=0.f;f32x16 o[2];o[0]=f32x16{};o[1]=f32x16{};const f32x16 negm=f32x16{};
  const int qrel=wid*QBLK+r32;
  #define CMASK(P0,P1,t) do{int jb_=(t)-(NT-4); if(jb_>=0)cmask(P0,P1,jb_,qrel,hi);}while(0)
  bool resc=false;
  #define START(P0,P1) do{ const float rm=rowmax(P0,P1); resc=false; \
    { const float dl=rm; mhat=fadd_s(mhat,dl); \
      _Pragma("unroll") for(int r=0;r<16;++r){P0[r]=fsub_s(P0[r],dl);P1[r]=fsub_s(P1[r],dl);} \
        } \
    _Pragma("unroll") for(int r=0;r<16;++r)P0[r]=__builtin_amdgcn_exp2f(P0[r]); }while(0)
  #define RESC() do{ if(resc){ asm volatile("s_waitcnt lgkmcnt(0)":::"memory"); \
      _Pragma("unroll") for(int d_=0;d_<2;++d_) _Pragma("unroll") for(int r=0;r<16;++r)o[d_][r]*=wsf[crow(r,hi)]; } }while(0)
  f32x16 pA0,pA1,pB0,pB1;
  int sl_prev=0,sl_cur=0,sl_next=SLOTB;
  #define ROT() do{sl_prev=sl_cur;sl_cur=sl_next;sl_next=(sl_next==(NSLOT-1)*SLOTB)?0:sl_next+SLOTB;}while(0)
  DMA_K(2,2*SLOTB);
  WAIT_BAR(3);
  qkt(pA0,pA1,Kbase,qr,negm,r32,hi);asm volatile("s_nop 15\n\ts_nop 7":"+v"(pA0),"+v"(pA1));BIAS(pA0,pA1,0);CMASK(pA0,pA1,0);
  START(pA0,pA1);
  _Pragma("unroll") for(int r=0;r<16;++r)pA1[r]=__builtin_amdgcn_exp2f(pA1[r]);
  WAIT_BAR(0);
  DMA_K(3,0);DMA_V(1,SLOTB);
  ROT();
  kload8(kf,kp0+sl_cur);
  WAIT_BAR(2);
  s16x4 vlo[8],vhi[8]; u32x4 pw0,pw1,pw2,pw3;
  #define PKW(P,B) cvtpk_s(P[B],P[B+1])
  #define PAF(k) __builtin_bit_cast(bf16x8,pw##k)
  #define VFR(i) (bf16x8){vlo[i][0],vlo[i][1],vlo[i][2],vlo[i][3],vhi[i][0],vhi[i][1],vhi[i][2],vhi[i][3]}
  #define PIN(x) asm volatile("":"+v"(x))
  #define MX3(a,b,c) __builtin_fmaxf(__builtin_fmaxf((a),(b)),(c))
  #define GAPA(MF,A0,A1,A2,A3,W0,W1,PW) do{ MF; sacc+=A0; sacc+=A1; sacc+=A2; sacc+=A3; PIN(sacc); W0; W1; PIN(PW); SBAR(); }while(0)
  #define EX(v) __builtin_amdgcn_exp2f(v)
  #define GAPB(MF,X,B) do{ MF; X[B]=EX(X[B]); X[B+1]=EX(X[B+1]); X[B+2]=EX(X[B+2]); X[B+3]=EX(X[B+3]); PIN(X); SBAR(); }while(0)
  #define VRD(i) do{ vlo[i]=vtr(vp_+(((i)>>2)*4096+((i)&3)*1024)); vhi[i]=vtr(vp_+(((i)>>2)*4096+((i)&3)*1024+512)); }while(0)
  #define KRD(G,j) do{ if(G){ kload2(kf,kp0+sl_next,j); SBAR(); } }while(0)
  #define STEP(C0,C1,P0,P1,t,GK,GV,GL) do{ SBAR(); \
    const lds_cptr vp_=vp0+sl_prev; \
    VRD(0); SBAR(); float sacc=(P0[0]+P0[1]); \
    GAPA(C0=__builtin_amdgcn_mfma_f32_32x32x16_bf16(kf[0],qr[0],negm,0,0,0), P0[2],P0[3],P0[4],P0[5],     pw0[0]=PKW(P0,0), pw0[1]=PKW(P0,2), pw0); \
    VRD(4); SBAR(); GAPA(C1=__builtin_amdgcn_mfma_f32_32x32x16_bf16(kf[1],qr[0],negm,0,0,0), P0[6],P0[7],P0[8],P0[9],     pw0[2]=PKW(P0,4), pw0[3]=PKW(P0,6), pw0); \
    VRD(1); SBAR(); GAPA(C0=__builtin_amdgcn_mfma_f32_32x32x16_bf16(kf[2],qr[1],C0,0,0,0),   P0[10],P0[11],P0[12],P0[13], pw1[0]=PKW(P0,8), pw1[1]=PKW(P0,10), pw1); \
    VRD(5); SBAR(); GAPA(C1=__builtin_amdgcn_mfma_f32_32x32x16_bf16(kf[3],qr[1],C1,0,0,0),   P0[14],P0[15],P1[0],P1[1],   pw1[2]=PKW(P0,12),pw1[3]=PKW(P0,14), pw1); \
    VRD(2); SBAR(); GAPA(C0=__builtin_amdgcn_mfma_f32_32x32x16_bf16(kf[4],qr[2],C0,0,0,0),   P1[2],P1[3],P1[4],P1[5],     pw2[0]=PKW(P1,0), pw2[1]=PKW(P1,2), pw2); \
    VRD(6); SBAR(); GAPA(C1=__builtin_amdgcn_mfma_f32_32x32x16_bf16(kf[5],qr[2],C1,0,0,0),   P1[6],P1[7],P1[8],P1[9],     pw2[2]=PKW(P1,4), pw2[3]=PKW(P1,6), pw2); \
    VRD(3); SBAR(); GAPA(C0=__builtin_amdgcn_mfma_f32_32x32x16_bf16(kf[6],qr[3],C0,0,0,0),   P1[10],P1[11],P1[12],P1[13], pw3[0]=PKW(P1,8), pw3[1]=PKW(P1,10), pw3); \
    VRD(7); SBAR(); GAPA(C1=__builtin_amdgcn_mfma_f32_32x32x16_bf16(kf[7],qr[3],C1,0,0,0),   P1[14],P1[15],0.f,0.f,       pw3[2]=PKW(P1,12),pw3[3]=PKW(P1,14), pw3); \
    l_reg+=sacc; \
    if(GK){DMA_K((t)+3,sl_cur);} if(GV){DMA_V((t)+1,sl_next);} \
    BIAS(C0,C1,t); CMASK(C0,C1,t); \
    { float a=MX3(C0[0],C0[1],C1[0]),b=MX3(C0[2],C0[3],C1[1]); a=MX3(a,C1[2],C1[3]); \
      _Pragma("unroll") for(int r=4;r<16;r+=4){a=MX3(a,C0[r],C0[r+1]);b=MX3(b,C0[r+2],C0[r+3]);a=MX3(a,C1[r],C1[r+1]);b=MX3(b,C1[r+2],C1[r+3]);} \
      float rm=__builtin_fmaxf(a,b); { auto rr=__builtin_amdgcn_permlane32_swap(__float_as_uint(rm),__float_as_uint(rm),false,false); rm=__builtin_fmaxf(__uint_as_float(rr[0]),__uint_as_float(rr[1])); } \
      resc=false; \
      if(__builtin_expect(__any(rm>(float)THRL),0)){ const float dl=__builtin_fmaxf(rm,0.f); mhat+=dl; \
        _Pragma("unroll") for(int r=0;r<16;++r){C0[r]-=dl;C1[r]-=dl;} \
          \
        const float f=__builtin_amdgcn_exp2f(-dl); l_reg*=f; if(hi==0)wsf[r32]=f; resc=true; } } \
    SBAR(); \
    GAPB(o[0]=__builtin_amdgcn_mfma_f32_32x32x16_bf16(PAF(0),VFR(0),o[0],0,0,0), C0,0); \
    GAPB(o[1]=__builtin_amdgcn_mfma_f32_32x32x16_bf16(PAF(0),VFR(4),o[1],0,0,0), C0,4); \
    KRD(GL,0); GAPB(o[0]=__builtin_amdgcn_mfma_f32_32x32x16_bf16(PAF(1),VFR(1),o[0],0,0,0), C0,8); \
    KRD(GL,1); GAPB(o[1]=__builtin_amdgcn_mfma_f32_32x32x16_bf16(PAF(1),VFR(5),o[1],0,0,0), C0,12); \
    KRD(GL,2); GAPB(o[0]=__builtin_amdgcn_mfma_f32_32x32x16_bf16(PAF(2),VFR(2),o[0],0,0,0), C1,0); \
    KRD(GL,3); GAPB(o[1]=__builtin_amdgcn_mfma_f32_32x32x16_bf16(PAF(2),VFR(6),o[1],0,0,0), C1,4); \
    GAPB(o[0]=__builtin_amdgcn_mfma_f32_32x32x16_bf16(PAF(3),VFR(3),o[0],0,0,0), C1,8); \
    GAPB(o[1]=__builtin_amdgcn_mfma_f32_32x32x16_bf16(PAF(3),VFR(7),o[1],0,0,0), C1,12); \
    }while(0)
  int t=1;
  #undef CMASK
  #define CMASK(P0,P1,t) do{}while(0)
  for(;t+5<NT;t+=2){
    STEP(pB0,pB1,pA0,pA1,t,true,true,true);     WAIT_BAR(2); RESC(); ROT();
    STEP(pA0,pA1,pB0,pB1,t+1,true,true,true);   WAIT_BAR(2); RESC(); ROT();
  }
  #undef CMASK
  #define CMASK(P0,P1,t) do{int jb_=(t)-(NT-4); if(jb_>=0)cmask(P0,P1,jb_,qrel,hi);}while(0)
  #define ENDW(tt) do{ if((tt)+3<NT){WAIT_BAR(2);} else if((tt)+2<NT){WAIT_BAR(1);} else {WAIT_BAR(0);} }while(0)
  for(;t+1<NT;t+=2){
    STEP(pB0,pB1,pA0,pA1,t,(t+3<NT),(t+1<NT),(t+1<NT));       ENDW(t);   RESC(); ROT();
    STEP(pA0,pA1,pB0,pB1,t+1,(t+4<NT),(t+2<NT),(t+2<NT));     ENDW(t+1); RESC(); ROT();
  }
  STEP(pB0,pB1,pA0,pA1,NT-1,false,false,false); RESC();
  { float sacc=pB0[0]+pB0[1]; _Pragma("unroll") for(int r=2;r<16;++r)sacc+=pB0[r]; _Pragma("unroll") for(int r=0;r<16;++r)sacc+=pB1[r]; l_reg+=sacc;
    pw0=(u32x4){PKW(pB0,0),PKW(pB0,2),PKW(pB0,4),PKW(pB0,6)};pw1=(u32x4){PKW(pB0,8),PKW(pB0,10),PKW(pB0,12),PKW(pB0,14)};pw2=(u32x4){PKW(pB1,0),PKW(pB1,2),PKW(pB1,4),PKW(pB1,6)};pw3=(u32x4){PKW(pB1,8),PKW(pB1,10),PKW(pB1,12),PKW(pB1,14)};
    SBAR(); pv(o,vb0+sl_cur,PAF(0),PAF(1),PAF(2),PAF(3)); }
  #undef PKW
  #undef PAF
  #undef VFR
  #undef PIN
  #undef MX3
  #undef GAPA
  #undef GAPB
  #undef EX
  #undef VRD
  #undef KRD
  #undef STEP
  #undef ENDW
  {auto rr=__builtin_amdgcn_permlane32_swap(__float_as_uint(l_reg),__float_as_uint(l_reg),false,false);l_reg=__uint_as_float(rr[0])+__uint_as_float(rr[1]);}
  if(hi==0)wsf[32+r32]=l_reg;asm volatile("s_waitcnt lgkmcnt(0)":::"memory");
  float rli[16];
  #pragma unroll
  for(int r=0;r<16;++r)rli[r]=__builtin_amdgcn_rcpf(wsf[32+crow(r,hi)]);
  bf16*Ow=O+(rowbase+q0+wid*QBLK)*OP+h*D;
  { bf16*stg=(bf16*)(shm+LDS_OST)+wid*2048;
    #pragma unroll
    for(int r=0;r<16;++r){const int orow=crow(r,hi);
      #pragma unroll
      for(int d0=0;d0<2;++d0)stg[orow*64+d0*32+r32]=__float2bfloat16(o[d0][r]*rli[r]);}
    asm volatile("s_waitcnt lgkmcnt(0)":::"memory");
    #pragma unroll
    for(int i=0;i<4;++i){const int row=i*8+(lane>>3),ch=lane&7; const u32x4 v=*(const u32x4*)(stg+row*64+ch*8); ATTN_STORE16(Ow+(long)row*OP+ch*8,v);} }
  asm volatile("s_waitcnt lgkmcnt(0)\n\ts_barrier":::"memory");
  #undef BIAS
  #undef DMA_K
  #undef DMA_V
  #undef CMASK
  #undef START
  #undef RESC
  #undef ROT
}
constexpr int ATTN_LDS_BYTES=LDS_BYTES+8192;
#undef SBAR
#undef WAIT_BAR
}

__device__ __forceinline__ void attn_phase_ref(char* shm, const bf16_t* PROJ, const float* FCUM, bf16_t* ATT) {
    const int vblk = (gridDim.x % 8 == 0) ? (int)((blockIdx.x & 7) * (gridDim.x >> 3) + (blockIdx.x >> 3)) : (int)blockIdx.x;
    for (int uid = vblk; uid < 1024; uid += gridDim.x) {
        const int round = uid >> 8, v = uid & 255, bh = v >> 1, par = v & 1, b = bh >> 3, hh = bh & 7;
        const int qb = par ? (round == 0 ? 1 : round == 1 ? 6 : round == 2 ? 3 : 4) : (round == 0 ? 0 : round == 1 ? 7 : round == 2 ? 2 : 5);
        fox_attn::attn_unit<12>(b, hh, qb, (const fox_attn::bf16*)(PROJ + C_FQ), (const fox_attn::bf16*)(PROJ + C_FK), (const fox_attn::bf16*)(PROJ + C_FV), (fox_attn::bf16*)ATT, FCUM + (size_t)bh * SEQ, shm);
    }
}

__device__ __forceinline__ float xmax16(float m) { auto r = __builtin_amdgcn_permlane16_swap(__float_as_uint(m), __float_as_uint(m), false, false); return fmaxf(__uint_as_float(r[0]), __uint_as_float(r[1])); }
__device__ __forceinline__ float xmax32(float m) { auto r = __builtin_amdgcn_permlane32_swap(__float_as_uint(m), __float_as_uint(m), false, false); return fmaxf(__uint_as_float(r[0]), __uint_as_float(r[1])); }
__device__ __forceinline__ float xadd16(float m) { auto r = __builtin_amdgcn_permlane16_swap(__float_as_uint(m), __float_as_uint(m), false, false); return __uint_as_float(r[0]) + __uint_as_float(r[1]); }
__device__ __forceinline__ float xadd32(float m) { auto r = __builtin_amdgcn_permlane32_swap(__float_as_uint(m), __float_as_uint(m), false, false); return __uint_as_float(r[0]) + __uint_as_float(r[1]); }
template <bool MASK> struct BoolC { static constexpr bool value = MASK; };
__device__ __forceinline__ void attn_phase(LAS unsigned char* lds, const bf16_t* PROJ, const float* FCUM, bf16_t* ATT) {
    const int tid = threadIdx.x, lane = tid & 63, wave = __builtin_amdgcn_readfirstlane(tid >> 6);
    const int g = lane >> 4, c16 = lane & 15, q4 = (lane & 15) >> 2, p4 = lane & 3;
    LAS unsigned char* Ks = lds;
    constexpr float C1 = 0.125f * LOG2E;
    const int lrow = tid >> 3, lch = tid & 7;
    const int vblk = (gridDim.x % 8 == 0) ? (int)((blockIdx.x & 7) * (gridDim.x >> 3) + (blockIdx.x >> 3)) : (int)blockIdx.x;
    for (int uid = vblk; uid < 1024; uid += gridDim.x) {
        const int round = uid >> 8, v = uid & 255, bh = v >> 1, par = v & 1, b = bh >> 3, hh = bh & 7;
        const int qb = par ? (round == 0 ? 1 : round == 1 ? 6 : round == 2 ? 3 : 4) : (round == 0 ? 0 : round == 1 ? 7 : round == 2 ? 2 : 5);
        const int q0 = qb * 256, NT = 4 * (qb + 1);
        const size_t rowbase = (size_t)b * SEQ;
        bf16x8 qf[2][2]; float mrun[2], lrun[2]; f32x4 acc[2][4];
#pragma unroll
        for (int qt = 0; qt < 2; ++qt) { const int qr = q0 + 32 * wave + 16 * qt + c16;
#pragma unroll
            for (int kd = 0; kd < 2; ++kd) qf[qt][kd] = *(const bf16x8*)(PROJ + (rowbase + qr) * NP + C_FQ + hh * 64 + 32 * kd + 8 * g);
            mrun[qt] = -1e30f; lrun[qt] = 0.f;
#pragma unroll
            for (int dt = 0; dt < 4; ++dt) acc[qt][dt] = (f32x4){0.f, 0.f, 0.f, 0.f}; }
        u32x4 kreg[2], vreg[2]; float freg[2];
#define ATT_LOAD(tt, S) do { const size_t r_ = rowbase + (size_t)(tt) * 64 + lrow; \
            kreg[S] = *(const u32x4*)(PROJ + r_ * NP + C_FK + hh * 64 + lch * 8); vreg[S] = *(const u32x4*)(PROJ + r_ * NP + C_FV + hh * 64 + lch * 8); \
            freg[S] = FCUM[(size_t)bh * SEQ + (tt) * 64 + (tid & 63)]; } while (0)
#define ATT_STORE(tt, S) do { LAS unsigned char* kb_ = Ks + ((tt) & 1) * 18688; \
            *(LAS u32x4*)(kb_ + lrow * 128 + ((lch ^ ((lrow >> 1) & 7)) * 16)) = kreg[S]; *(LAS u32x4*)(kb_ + 9216 + lrow * 144 + lch * 16) = vreg[S]; if (tid < 64) ((LAS float*)(kb_ + 18432))[tid] = -freg[S]; } while (0)
        ATT_LOAD(0, 0); ATT_LOAD(1, 1);
        LBAR();
        ATT_STORE(0, 0);
        LBAR();
        auto tile = [&](const int t, auto maskc) {
            constexpr bool MASK = decltype(maskc)::value;
            const LAS unsigned char* Kb = Ks + (t & 1) * 18688; const LAS unsigned char* Vb = Kb + 9216; const LAS float* fb = (const LAS float*)(Kb + 18432);
            if (!MASK || 64 * t <= q0 + 32 * wave + 31) {
                f32x4 s[4][2];
#pragma unroll
                for (int kt = 0; kt < 4; ++kt) {
#pragma unroll
                    for (int kd = 0; kd < 2; ++kd) { const bf16x8 kf = *(const LAS bf16x8*)(Kb + (16 * kt + c16) * 128 + (((4 * kd + g) ^ ((c16 >> 1) & 7)) * 16));
#pragma unroll
                        for (int qt = 0; qt < 2; ++qt) s[kt][qt] = __builtin_amdgcn_mfma_f32_16x16x32_bf16(kf, qf[qt][kd], kd == 0 ? (f32x4){0.f, 0.f, 0.f, 0.f} : s[kt][qt], 0, 0, 0); } }
#pragma unroll
                for (int kt = 0; kt < 4; ++kt) { const f32x4 nfk = *(const LAS f32x4*)(fb + 16 * kt + 4 * g);
#pragma unroll
                    for (int qt = 0; qt < 2; ++qt) { s[kt][qt] = s[kt][qt] * C1 + nfk;
                        if (MASK) {
#pragma unroll
                            for (int i = 0; i < 4; ++i) { const int kv = 64 * t + 16 * kt + 4 * g + i, qq = q0 + 32 * wave + 16 * qt + c16; if (kv > qq) s[kt][qt][i] = -1e30f; } } } }
                bf16x8 pf[2][2];
#pragma unroll
                for (int qt = 0; qt < 2; ++qt) {
                    float m0 = fmaxf(fmaxf(s[0][qt][0], s[0][qt][1]), fmaxf(s[0][qt][2], s[0][qt][3]));
#pragma unroll
                    for (int kt = 1; kt < 4; ++kt) { m0 = fmaxf(fmaxf(m0, s[kt][qt][0]), s[kt][qt][1]); m0 = fmaxf(fmaxf(m0, s[kt][qt][2]), s[kt][qt][3]); }
                    m0 = xmax32(xmax16(m0));
                    const float mnew = fmaxf(mrun[qt], m0), corr = __builtin_amdgcn_exp2f(mrun[qt] - mnew);
                    mrun[qt] = mnew;
#pragma unroll
                    for (int dt = 0; dt < 4; ++dt) acc[qt][dt] = acc[qt][dt] * corr;
                    f32x4 ps = (f32x4){0.f, 0.f, 0.f, 0.f};
#pragma unroll
                    for (int kt = 0; kt < 4; ++kt) { const f32x4 d = s[kt][qt] - mnew; f32x4 p;
                        p[0] = __builtin_amdgcn_exp2f(d[0]); p[1] = __builtin_amdgcn_exp2f(d[1]); p[2] = __builtin_amdgcn_exp2f(d[2]); p[3] = __builtin_amdgcn_exp2f(d[3]);
                        ps = ps + p; s[kt][qt] = p; }
                    lrun[qt] = lrun[qt] * corr + ((ps[0] + ps[1]) + (ps[2] + ps[3]));
#pragma unroll
                    for (int ks = 0; ks < 2; ++ks) { u32x4 w; w.x = pk2(s[2 * ks][qt][0], s[2 * ks][qt][1]); w.y = pk2(s[2 * ks][qt][2], s[2 * ks][qt][3]);
                        w.z = pk2(s[2 * ks + 1][qt][0], s[2 * ks + 1][qt][1]); w.w = pk2(s[2 * ks + 1][qt][2], s[2 * ks + 1][qt][3]); pf[qt][ks] = __builtin_bit_cast(bf16x8, w); }
                }
#pragma unroll
                for (int dt = 0; dt < 4; ++dt)
#pragma unroll
                    for (int ks = 0; ks < 2; ++ks) {
                        const s16x4 lo = vtr(Vb + (32 * ks + 4 * g + q4) * 144 + (16 * dt + 4 * p4) * 2), hi = vtr(Vb + (32 * ks + 16 + 4 * g + q4) * 144 + (16 * dt + 4 * p4) * 2);
                        const bf16x8 vf = (bf16x8){lo[0], lo[1], lo[2], lo[3], hi[0], hi[1], hi[2], hi[3]};
#pragma unroll
                        for (int qt = 0; qt < 2; ++qt) acc[qt][dt] = __builtin_amdgcn_mfma_f32_16x16x32_bf16(vf, pf[qt][ks], acc[qt][dt], 0, 0, 0);
                    }
            }
        };
        for (int t0 = 0; t0 < NT; t0 += 2) {
            const bool diag = (t0 >= NT - 4);
            ATT_LOAD(t0 + 2 < NT ? t0 + 2 : NT - 1, 0);
            if (diag) tile(t0, BoolC<true>{}); else tile(t0, BoolC<false>{});
            ATT_STORE(t0 + 1, 1); LBAR();
            ATT_LOAD(t0 + 3 < NT ? t0 + 3 : NT - 1, 1);
            if (diag) tile(t0 + 1, BoolC<true>{}); else tile(t0 + 1, BoolC<false>{});
            if (t0 + 2 < NT) ATT_STORE(t0 + 2, 0);
            LBAR();
        }
#undef ATT_LOAD
#undef ATT_STORE
#pragma unroll
        for (int qt = 0; qt < 2; ++qt) { float lt = xadd32(xadd16(lrun[qt])); const float inv = 1.0f / lt;
            const size_t qr = rowbase + q0 + 32 * wave + 16 * qt + c16;
#pragma unroll
            for (int dt = 0; dt < 4; ++dt) { const f32x4 o = acc[qt][dt] * inv; u32x2 w; w.x = pk2(o[0], o[1]); w.y = pk2(o[2], o[3]);
                *(u32x2*)(ATT + qr * 512 + hh * 64 + 16 * dt + 4 * g) = w; } }
    }
    LBAR();
}

__device__ __forceinline__ void mlstm_phase(LAS unsigned char* lds, const bf16_t* PROJ, const bf16_t* MQK, const float* G16, bf16_t* HRAW) {
    const int tid = threadIdx.x, lane = tid & 63, wave = __builtin_amdgcn_readfirstlane(tid >> 6);
    const int g = lane >> 4, c16 = lane & 15, q4 = (lane & 15) >> 2, p4 = lane & 3;
    LAS unsigned char* Qs = lds; LAS unsigned char* Ks = lds + 17408; LAS unsigned char* Vs = lds + 34816; LAS unsigned char* Vw = lds + 44032; LAS unsigned char* Cbt = lds + 53248;
    LAS float* bb = (LAS float*)(lds + 70656); LAS float* ee = (LAS float*)(lds + 78848); LAS float* cm = (LAS float*)(lds + 87040);
    LAS float* nbuf = (LAS float*)(lds + 95232); LAS float* wl = (LAS float*)(lds + 96256); LAS float* gch = (LAS float*)(lds + 96512);
    LAS float* amax = (LAS float*)(lds + 96640); LAS float* mprev = (LAS float*)(lds + 96768); LAS unsigned char* Hs = lds + 97280;
    constexpr float QSCALE = 0.08838834764831845f;
    const int vblk = (gridDim.x % 8 == 0) ? (int)((blockIdx.x & 7) * (gridDim.x >> 3) + (blockIdx.x >> 3)) : (int)blockIdx.x;
    for (int item = vblk; item < 256; item += gridDim.x) {
        const int bhid = item >> 2, vs = item & 3, b = bhid >> 2, h = bhid & 3;
        const size_t rowbase = (size_t)b * SEQ;
        {
            float lf[4], ig[4];
#pragma unroll
            for (int i = 0; i < 4; ++i) { const float* gp = G16 + (rowbase + 4 * tid + i) * 16; lf[i] = logsig(gp[12 + h]); ig[i] = gp[8 + h]; }
            lf[1] += lf[0]; lf[2] += lf[1]; lf[3] += lf[2];
            const float tot = lf[3]; float sc = tot;
#pragma unroll
            for (int o = 1; o < 16; o <<= 1) { const float y = __shfl_up(sc, o, 16); if (c16 >= o) sc += y; }
            const float excl = sc - tot;
            float bi[4], ei[4], pm[4];
#pragma unroll
            for (int i = 0; i < 4; ++i) { bi[i] = lf[i] + excl; ei[i] = ig[i] - bi[i]; }
            pm[0] = ei[0]; pm[1] = fmaxf(pm[0], ei[1]); pm[2] = fmaxf(pm[1], ei[2]); pm[3] = fmaxf(pm[2], ei[3]);
            float scm = pm[3];
#pragma unroll
            for (int o = 1; o < 16; o <<= 1) { const float y = __shfl_up(scm, o, 16); if (c16 >= o) scm = fmaxf(scm, y); }
            float exm = __shfl_up(scm, 1, 16); if (c16 == 0) exm = -1e30f;
#pragma unroll
            for (int i = 0; i < 4; ++i) { bb[4 * tid + i] = bi[i]; ee[4 * tid + i] = ei[i]; cm[4 * tid + i] = fmaxf(pm[i], exm); }
            if (c16 == 15) { gch[tid >> 4] = bi[3]; amax[tid >> 4] = bi[3] + fmaxf(pm[3], exm); }
            if (tid < 128) nbuf[tid] = 0.f;
            for (int i = tid; i < 17408 / 4; i += 512) ((LAS unsigned*)Cbt)[i] = 0u;
        }
        LBAR();
        if (tid == 0) { float m = 0.f; for (int c = 0; c < 32; ++c) { mprev[c] = m; m = fmaxf(gch[c] + m, amax[c]); } mprev[32] = m; }
        LBAR();
        f32x4 Cst[2][4], Cn[2];
#pragma unroll
        for (int dd = 0; dd < 2; ++dd) { Cn[dd] = (f32x4){0.f, 0.f, 0.f, 0.f};
#pragma unroll
            for (int vt = 0; vt < 4; ++vt) Cst[dd][vt] = (f32x4){0.f, 0.f, 0.f, 0.f}; }
        const int vrow = tid >> 3, vch = tid & 7;
#define MLOAD(cc, Q, K, V) do { _Pragma("unroll") for (int i_ = 0; i_ < 2; ++i_) { const int p_ = tid + 512 * i_, row_ = p_ >> 4, ch_ = p_ & 15; const size_t r_ = rowbase + (size_t)(cc) * 64 + row_; \
            Q[i_] = *(const u32x4*)(MQK + r_ * DM + h * 256 + ch_ * 8); K[i_] = *(const u32x4*)(MQK + r_ * DM + h * 256 + 128 + ch_ * 8); } \
            V = __builtin_nontemporal_load((const u32x4*)(PROJ + (rowbase + (size_t)(cc) * 64 + vrow) * NP + C_MV + h * 256 + vs * 64 + vch * 8)); } while (0)
        u32x4 qA[2], kA[2], vA, qB[2], kB[2], vB;
        MLOAD(0, qA, kA, vA); MLOAD(1, qB, kB, vB);
        auto chunk = [&](const int c, u32x4 (&qreg)[2], u32x4 (&kreg)[2], u32x4& vreg) {
            const float mp = mprev[c], mn = mprev[c + 1], gc = gch[c];
#pragma unroll
            for (int i = 0; i < 2; ++i) { const int p = tid + 512 * i, row = p >> 4, ch = p & 15;
                *(LAS u32x4*)(Qs + row * 272 + ch * 16) = qreg[i]; *(LAS u32x4*)(Ks + row * 272 + ch * 16) = kreg[i]; }
            *(LAS u32x4*)(Vs + vrow * 144 + vch * 16) = vreg;
            { const float wv = __expf(gc + ee[64 * c + vrow] - mn); u32x4 o;
              o.x = pk2(bflo(vreg.x) * wv, bfhi(vreg.x) * wv); o.y = pk2(bflo(vreg.y) * wv, bfhi(vreg.y) * wv); o.z = pk2(bflo(vreg.z) * wv, bfhi(vreg.z) * wv); o.w = pk2(bflo(vreg.w) * wv, bfhi(vreg.w) * wv);
              *(LAS u32x4*)(Vw + vrow * 144 + vch * 16) = o; }
            if (tid < 64) wl[tid] = __expf(gc + ee[64 * c + tid] - mn);
            LBAR();
            MLOAD(c + 2 < 32 ? c + 2 : 31, qreg, kreg, vreg);
            const float decay = __expf(gc + mp - mn);
            if (wave < 4) {
                const int lt = wave, l = 16 * lt + c16;
                const float mx_l = fmaxf(mp, cm[64 * c + l]), winter = __expf(mp - mx_l);
                const LAS float* nb_ = nbuf + (c & 1) * 128;
                bf16x8 qf[4]; f32x4 n0[4], n1[4], e4[4];
#pragma unroll
                for (int kd = 0; kd < 4; ++kd) { qf[kd] = *(const LAS bf16x8*)(Qs + l * 272 + (32 * kd + 8 * g) * 2); n0[kd] = *(const LAS f32x4*)(nb_ + 32 * kd + 8 * g); n1[kd] = *(const LAS f32x4*)(nb_ + 32 * kd + 8 * g + 4); }
#pragma unroll
                for (int st = 0; st < 4; ++st) e4[st] = *(const LAS f32x4*)(ee + 64 * c + 16 * st + 4 * g);
                f32x4 sT[4], acc[4];
#pragma unroll
                for (int h2 = 0; h2 < 2; ++h2) {
                    bf16x8 kf[2][4];
#pragma unroll
                    for (int s2 = 0; s2 < 2; ++s2)
#pragma unroll
                        for (int kd = 0; kd < 4; ++kd) kf[s2][kd] = *(const LAS bf16x8*)(Ks + (16 * (2 * h2 + s2) + c16) * 272 + (32 * kd + 8 * g) * 2);
#pragma unroll
                    for (int s2 = 0; s2 < 2; ++s2) { sT[2 * h2 + s2] = (f32x4){0.f, 0.f, 0.f, 0.f};
#pragma unroll
                        for (int kd = 0; kd < 4; ++kd) sT[2 * h2 + s2] = __builtin_amdgcn_mfma_f32_16x16x32_bf16(kf[s2][kd], qf[kd], sT[2 * h2 + s2], 0, 0, 0); }
                    asm volatile("" ::: "memory");
                }
                float qn = 0.f;
#pragma unroll
                for (int kd = 0; kd < 4; ++kd) { const u32x4 qw = __builtin_bit_cast(u32x4, qf[kd]);
                    qn += bflo(qw.x) * n0[kd][0] + bfhi(qw.x) * n0[kd][1] + bflo(qw.y) * n0[kd][2] + bfhi(qw.y) * n0[kd][3] + bflo(qw.z) * n1[kd][0] + bfhi(qw.z) * n1[kd][1] + bflo(qw.w) * n1[kd][2] + bfhi(qw.w) * n1[kd][3]; }
                qn = xadd32(xadd16(qn));
#pragma unroll
                for (int h2 = 0; h2 < 2; ++h2) {
                    bf16x8 cf[2][4];
#pragma unroll
                    for (int j2 = 0; j2 < 2; ++j2)
#pragma unroll
                        for (int kd = 0; kd < 4; ++kd) cf[j2][kd] = *(const LAS bf16x8*)(Cbt + (16 * (2 * h2 + j2) + c16) * 272 + (32 * kd + 8 * g) * 2);
#pragma unroll
                    for (int j2 = 0; j2 < 2; ++j2) { acc[2 * h2 + j2] = (f32x4){0.f, 0.f, 0.f, 0.f};
#pragma unroll
                        for (int kd = 0; kd < 4; ++kd) acc[2 * h2 + j2] = __builtin_amdgcn_mfma_f32_16x16x32_bf16(cf[j2][kd], qf[kd], acc[2 * h2 + j2], 0, 0, 0); }
                    asm volatile("" ::: "memory");
                }
                bf16x8 vf[2][4];
#pragma unroll
                for (int ks = 0; ks < 2; ++ks)
#pragma unroll
                    for (int j = 0; j < 4; ++j) {
                        const s16x4 lo = vtr(Vs + (32 * ks + 4 * g + q4) * 144 + (16 * j + 4 * p4) * 2), hi = vtr(Vs + (32 * ks + 16 + 4 * g + q4) * 144 + (16 * j + 4 * p4) * 2);
                        vf[ks][j] = (bf16x8){lo[0], lo[1], lo[2], lo[3], hi[0], hi[1], hi[2], hi[3]}; }
                float psum = 0.f;
#pragma unroll
                for (int st = 0; st < 4; ++st)
#pragma unroll
                    for (int i = 0; i < 4; ++i) { const int sidx = 16 * st + 4 * g + i; float val = sT[st][i] * QSCALE * __expf(e4[st][i] - mx_l); if (sidx > l) val = 0.f; psum += val; sT[st][i] = val; }
                const float wis = winter * QSCALE;
#pragma unroll
                for (int j = 0; j < 4; ++j) acc[j] = acc[j] * wis;
#pragma unroll
                for (int ks = 0; ks < 2; ++ks) {
                    u32x4 w; w.x = pk2(sT[2 * ks][0], sT[2 * ks][1]); w.y = pk2(sT[2 * ks][2], sT[2 * ks][3]); w.z = pk2(sT[2 * ks + 1][0], sT[2 * ks + 1][1]); w.w = pk2(sT[2 * ks + 1][2], sT[2 * ks + 1][3]);
                    const bf16x8 pf = __builtin_bit_cast(bf16x8, w);
#pragma unroll
                    for (int j = 0; j < 4; ++j) acc[j] = __builtin_amdgcn_mfma_f32_16x16x32_bf16(vf[ks][j], pf, acc[j], 0, 0, 0);
                }
                psum = xadd32(xadd16(psum));
                const float den = wis * qn + psum, mt = bb[64 * c + l] + mx_l;
                const float inv = 1.0f / fmaxf(fabsf(den), __expf(-mt));
#pragma unroll
                for (int j = 0; j < 4; ++j) { const f32x4 o = acc[j] * inv; u32x2 w; w.x = pk2(o[0], o[1]); w.y = pk2(o[2], o[3]);
                    *(LAS u32x2*)(Hs + l * 144 + (16 * j + 4 * g) * 2) = w; }
            } else {
                const int dt0 = 2 * (wave - 4);
                bf16x8 vb[2][4], ka[2][2]; f32x4 w0[2], w1[2];
#pragma unroll
                for (int kl = 0; kl < 2; ++kl) {
                    w0[kl] = *(const LAS f32x4*)(wl + 32 * kl + 8 * g); w1[kl] = *(const LAS f32x4*)(wl + 32 * kl + 8 * g + 4);
#pragma unroll
                    for (int dd = 0; dd < 2; ++dd) {
                        const s16x4 alo = vtr(Ks + (32 * kl + 8 * g + q4) * 272 + (16 * (dt0 + dd) + 4 * p4) * 2), ahi = vtr(Ks + (32 * kl + 8 * g + 4 + q4) * 272 + (16 * (dt0 + dd) + 4 * p4) * 2);
                        ka[kl][dd] = (bf16x8){alo[0], alo[1], alo[2], alo[3], ahi[0], ahi[1], ahi[2], ahi[3]}; }
#pragma unroll
                    for (int vt = 0; vt < 4; ++vt) {
                        const s16x4 blo = vtr(Vw + (32 * kl + 8 * g + q4) * 144 + (16 * vt + 4 * p4) * 2), bhi = vtr(Vw + (32 * kl + 8 * g + 4 + q4) * 144 + (16 * vt + 4 * p4) * 2);
                        vb[kl][vt] = (bf16x8){blo[0], blo[1], blo[2], blo[3], bhi[0], bhi[1], bhi[2], bhi[3]}; }
                }
#pragma unroll
                for (int dd = 0; dd < 2; ++dd) { Cn[dd] = Cn[dd] * decay;
#pragma unroll
                    for (int vt = 0; vt < 4; ++vt) Cst[dd][vt] = Cst[dd][vt] * decay; }
#pragma unroll
                for (int kl = 0; kl < 2; ++kl) {
                    u32x4 wa; wa.x = pk2(w0[kl][0], w0[kl][1]); wa.y = pk2(w0[kl][2], w0[kl][3]); wa.z = pk2(w1[kl][0], w1[kl][1]); wa.w = pk2(w1[kl][2], w1[kl][3]);
                    if (c16 != 0) wa = (u32x4){0u, 0u, 0u, 0u};
#pragma unroll
                    for (int dd = 0; dd < 2; ++dd) {
                        Cn[dd] = __builtin_amdgcn_mfma_f32_16x16x32_bf16(ka[kl][dd], __builtin_bit_cast(bf16x8, wa), Cn[dd], 0, 0, 0);
#pragma unroll
                        for (int vt = 0; vt < 4; ++vt) Cst[dd][vt] = __builtin_amdgcn_mfma_f32_16x16x32_bf16(ka[kl][dd], vb[kl][vt], Cst[dd][vt], 0, 0, 0);
                    }
                }
                if (c16 == 0) {
#pragma unroll
                    for (int dd = 0; dd < 2; ++dd) *(LAS f32x4*)(nbuf + ((c + 1) & 1) * 128 + 16 * (dt0 + dd) + 4 * g) = Cn[dd]; }
            }
            LBAR();
            *(u32x4*)(HRAW + (rowbase + (size_t)c * 64 + vrow) * DM + h * 256 + vs * 64 + vch * 8) = *(const LAS u32x4*)(Hs + vrow * 144 + vch * 16);
            if (wave >= 4) {
                const int dt0 = 2 * (wave - 4);
#pragma unroll
                for (int dd = 0; dd < 2; ++dd)
#pragma unroll
                    for (int vt = 0; vt < 4; ++vt) { u32x2 w; w.x = pk2(Cst[dd][vt][0], Cst[dd][vt][1]); w.y = pk2(Cst[dd][vt][2], Cst[dd][vt][3]);
                        *(LAS u32x2*)(Cbt + (16 * vt + c16) * 272 + (16 * (dt0 + dd) + 4 * g) * 2) = w; }
            }
        };
        for (int c0 = 0; c0 < 32; c0 += 2) { chunk(c0, qA, kA, vA); chunk(c0 + 1, qB, kB, vB); }
#undef MLOAD
        LBAR();
    }
}

__device__ __forceinline__ void headnorm_phase(const bf16_t* PROJ, const float* gnorm, bf16_t* HM) {
    const int tid = threadIdx.x, lane = tid & 63, wave = __builtin_amdgcn_readfirstlane(tid >> 6);
    float gq[16]; { float t0[8], t1[8]; ld8f(gnorm + 16 * lane, t0); ld8f(gnorm + 16 * lane + 8, t1);
#pragma unroll
        for (int e = 0; e < 8; ++e) { gq[e] = t0[e]; gq[8 + e] = t1[e]; } }
    for (int m0 = (blockIdx.x * 8 + wave) * 4; m0 < MT; m0 += gridDim.x * 32) {
        u32x4 hr[4][2], mr[4][2];
#pragma unroll
        for (int r = 0; r < 4; ++r) { const bf16_t* hp = HM + (size_t)(m0 + r) * DM + 16 * lane; const bf16_t* mo = PROJ + (size_t)(m0 + r) * NP + C_MO + 16 * lane;
            hr[r][0] = __builtin_nontemporal_load((const u32x4*)hp); hr[r][1] = __builtin_nontemporal_load((const u32x4*)(hp + 8)); mr[r][0] = __builtin_nontemporal_load((const u32x4*)mo); mr[r][1] = __builtin_nontemporal_load((const u32x4*)(mo + 8)); }
#pragma unroll
        for (int r = 0; r < 4; ++r) {
            float v[16], og[16];
            { float t0[8], t1[8]; unpack8(hr[r][0], t0); unpack8(hr[r][1], t1);
#pragma unroll
              for (int e = 0; e < 8; ++e) { v[e] = t0[e]; v[8 + e] = t1[e]; }
              unpack8(mr[r][0], t0); unpack8(mr[r][1], t1);
#pragma unroll
              for (int e = 0; e < 8; ++e) { og[e] = t0[e]; og[8 + e] = t1[e]; } }
            float s = 0.f;
#pragma unroll
            for (int i = 0; i < 16; ++i) s += v[i];
#pragma unroll
            for (int o = 1; o < 16; o <<= 1) s += __shfl_xor(s, o);
            const float mean = s * (1.f / 256.f); float s2 = 0.f;
#pragma unroll
            for (int i = 0; i < 16; ++i) { v[i] -= mean; s2 += v[i] * v[i]; }
#pragma unroll
            for (int o = 1; o < 16; o <<= 1) s2 += __shfl_xor(s2, o);
            const float rstd = 1.f / sqrtf(s2 * (1.f / 256.f) + LN_EPS);
            float r0[8], r1[8];
#pragma unroll
            for (int e = 0; e < 8; ++e) { r0[e] = v[e] * rstd * gq[e] * sigmoidf_(og[e]); r1[e] = v[8 + e] * rstd * gq[8 + e] * sigmoidf_(og[8 + e]); }
            bf16_t* hp = HM + (size_t)(m0 + r) * DM + 16 * lane;
            *(u32x4*)hp = pack8(r0); *(u32x4*)(hp + 8) = pack8(r1);
        }
    }
}

__device__ __forceinline__ void ln16(float (&v)[2][8]) {
    float s = 0.f;
#pragma unroll
    for (int j = 0; j < 2; ++j)
#pragma unroll
        for (int e = 0; e < 8; ++e) s += v[j][e];
    const float mean = wave_sum(s) * (1.f / DM); float s2 = 0.f;
#pragma unroll
    for (int j = 0; j < 2; ++j)
#pragma unroll
        for (int e = 0; e < 8; ++e) { v[j][e] -= mean; s2 += v[j][e] * v[j][e]; }
    const float rstd = 1.f / sqrtf(wave_sum(s2) * (1.f / DM) + LN_EPS);
#pragma unroll
    for (int j = 0; j < 2; ++j)
#pragma unroll
        for (int e = 0; e < 8; ++e) v[j][e] *= rstd;
}
__device__ __forceinline__ void ln_mid_phase(const bf16_t* Z, const float* lg, const float* lb, const float* MOD, bf16_t* X1, bf16_t* H2) {
    const int tid = threadIdx.x, lane = tid & 63, wave = __builtin_amdgcn_readfirstlane(tid >> 6);
    float gg[2][8], bq[2][8];
#pragma unroll
    for (int j = 0; j < 2; ++j) { ld8f(lg + 8 * lane + 512 * j, gg[j]); ld8f(lb + 8 * lane + 512 * j, bq[j]); }
    for (int m0 = (blockIdx.x * 8 + wave) * 4; m0 < MT; m0 += gridDim.x * 32) {
        const int b = m0 >> 11;
        u32x4 raw[4][2]; float sh[2][8], sc[2][8];
#pragma unroll
        for (int r = 0; r < 4; ++r)
#pragma unroll
            for (int j = 0; j < 2; ++j) raw[r][j] = __builtin_nontemporal_load((const u32x4*)(Z + (size_t)(m0 + r) * DM + 8 * lane + 512 * j));
#pragma unroll
        for (int j = 0; j < 2; ++j) { ld8f(MOD + (size_t)b * 6144 + 3072 + 8 * lane + 512 * j, sh[j]); ld8f(MOD + (size_t)b * 6144 + 4096 + 8 * lane + 512 * j, sc[j]); }
        asm volatile("" ::: "memory");
#pragma unroll
        for (int r = 0; r < 4; ++r) {
            float v[2][8]; unpack8(raw[r][0], v[0]); unpack8(raw[r][1], v[1]);
            ln16(v);
#pragma unroll
            for (int j = 0; j < 2; ++j) {
#pragma unroll
                for (int e = 0; e < 8; ++e) v[j][e] = v[j][e] * gg[j][e] + bq[j][e];
                __builtin_nontemporal_store(pack8(v[j]), (u32x4*)(X1 + (size_t)(m0 + r) * DM + 8 * lane + 512 * j)); }
            ln16(v);
#pragma unroll
            for (int j = 0; j < 2; ++j) {
#pragma unroll
                for (int e = 0; e < 8; ++e) v[j][e] = v[j][e] * (sc[j][e] + 1.0f) + sh[j][e];
                *(u32x4*)(H2 + (size_t)(m0 + r) * DM + 8 * lane + 512 * j) = pack8(v[j]); }
        }
    }
}
__device__ __forceinline__ void ln_out_phase(const bf16_t* Z, const float* lg, const float* lb, float* OUT) {
    const int tid = threadIdx.x, lane = tid & 63, wave = __builtin_amdgcn_readfirstlane(tid >> 6);
    float gg[2][8], bq[2][8];
#pragma unroll
    for (int j = 0; j < 2; ++j) { ld8f(lg + 8 * lane + 512 * j, gg[j]); ld8f(lb + 8 * lane + 512 * j, bq[j]); }
    for (int m0 = (blockIdx.x * 8 + wave) * 4; m0 < MT; m0 += gridDim.x * 32) {
        u32x4 raw[4][2];
#pragma unroll
        for (int r = 0; r < 4; ++r)
#pragma unroll
            for (int j = 0; j < 2; ++j) raw[r][j] = *(const u32x4*)(Z + (size_t)(m0 + r) * DM + 8 * lane + 512 * j);
#pragma unroll
        for (int r = 0; r < 4; ++r) {
            float v[2][8]; unpack8(raw[r][0], v[0]); unpack8(raw[r][1], v[1]);
            ln16(v);
#pragma unroll
            for (int j = 0; j < 2; ++j) { float* op = OUT + (size_t)(m0 + r) * DM + 8 * lane + 512 * j;
                *(f32x4*)op = (f32x4){v[j][0] * gg[j][0] + bq[j][0], v[j][1] * gg[j][1] + bq[j][1], v[j][2] * gg[j][2] + bq[j][2], v[j][3] * gg[j][3] + bq[j][3]};
                *(f32x4*)(op + 4) = (f32x4){v[j][4] * gg[j][4] + bq[j][4], v[j][5] * gg[j][5] + bq[j][5], v[j][6] * gg[j][6] + bq[j][6], v[j][7] * gg[j][7] + bq[j][7]}; }
        }
    }
}

#define XB_TMO      128
#define XB_XCNT(j)  (256  + 64 * (j))
#define XB_XSUB(j)  (1280 + 64 * (j))
#define XB_XGEN(j)  (2304 + 64 * (j))
#define XB_TOP      3328
#define XB_TOPGEN   3392
#define XCD_BAR_WORDS 3456
#define XB_SPIN_CAP (1u << 22)
__device__ __forceinline__ unsigned xb_ld(unsigned* p)              { return __hip_atomic_load(p, __ATOMIC_RELAXED, __HIP_MEMORY_SCOPE_AGENT); }
__device__ __forceinline__ unsigned xb_add(unsigned* p, unsigned v) { return __hip_atomic_fetch_add(p, v, __ATOMIC_RELAXED, __HIP_MEMORY_SCOPE_AGENT); }
__device__ __forceinline__ unsigned xb_xcc_id() { return (unsigned)__builtin_amdgcn_s_getreg((3 << 11) | 20) & 0xFu; }
#define XB_SPIN(cond, bar) do { unsigned _sp = 0; while (cond) { __builtin_amdgcn_s_sleep(1); \
    if ((++_sp & 255u) == 0u) { if (xb_ld(&(bar)[XB_TMO])) break; if (_sp > XB_SPIN_CAP) { atomicAdd(&(bar)[XB_TMO], 1u); break; } } } } while (0)
struct XcdBarrier { unsigned* bar; unsigned x; volatile LAS unsigned* st; };
__device__ __forceinline__ XcdBarrier xcd_barrier_post(unsigned* bar, volatile LAS unsigned* st) {
    XcdBarrier b; b.bar = bar; b.x = xb_xcc_id(); b.st = st;
    if (threadIdx.x == 0) (void)xb_add(&bar[XB_XCNT(b.x)], 1u);
    return b;
}
__device__ __forceinline__ void xcd_barrier_complete(unsigned* bar, unsigned x, unsigned& nloc, unsigned& nx) {
    const unsigned G = gridDim.x * gridDim.y * gridDim.z;
    unsigned sum, cnt, mine, sp = 0u;
    for (;;) {
        sum = 0u; cnt = 0u; mine = 0u;
#pragma unroll
        for (unsigned j = 0; j < 16; ++j) { const unsigned c = xb_ld(&bar[XB_XCNT(j)]); sum += c; cnt += (c > 0u) ? 1u : 0u; mine = (j == x) ? c : mine; }
        if (sum == G) break;
        __builtin_amdgcn_s_sleep(1);
        if ((++sp & 255u) == 0u) { if (xb_ld(&bar[XB_TMO])) break; if (sp > XB_SPIN_CAP) { atomicAdd(&bar[XB_TMO], 1u); break; } }
    }
    nloc = mine > 0u ? mine : 1u; nx = cnt > 0u ? cnt : 1u;
}
__device__ __forceinline__ void xcd_barrier(const XcdBarrier& b) {
    asm volatile("s_waitcnt vmcnt(0)" ::: "memory");
    __syncthreads();
    if (threadIdx.x == 0) {
        unsigned* bar = b.bar;
        __builtin_amdgcn_s_waitcnt(0);
        unsigned nloc = b.st[0], nx = b.st[1];
        if (nloc == 0u) { xcd_barrier_complete(bar, b.x, nloc, nx); b.st[0] = nloc; b.st[1] = nx; }
        const unsigned old = xb_add(&bar[XB_XSUB(b.x)], 1u);
        const unsigned gen = old / nloc;
        if (old + 1u == (gen + 1u) * nloc) {
            __builtin_amdgcn_fence(__ATOMIC_RELEASE, "agent");
            asm volatile("s_waitcnt vmcnt(0)" ::: "memory");
            const unsigned og = xb_add(&bar[XB_TOP], 1u);
            const unsigned tg = og / nx;
            if (og + 1u == (tg + 1u) * nx) xb_add(&bar[XB_TOPGEN], 1u);
            else XB_SPIN(xb_ld(&bar[XB_TOPGEN]) == tg, bar);
            __builtin_amdgcn_fence(__ATOMIC_ACQUIRE, "agent");
            xb_add(&bar[XB_XGEN(b.x)], 1u);
            asm volatile("s_waitcnt vmcnt(0)" ::: "memory");
        } else {
            XB_SPIN(xb_ld(&bar[XB_XGEN(b.x)]) == gen, bar);
            __builtin_amdgcn_fence(__ATOMIC_ACQUIRE, "agent");
            asm volatile("s_waitcnt vmcnt(0)" ::: "memory");
        }
    }
    __syncthreads();
}

__device__ __forceinline__ void split_arrive(unsigned* ctr) {
    asm volatile("s_waitcnt vmcnt(0)" ::: "memory");
    __syncthreads();
    if (threadIdx.x == 0) { __builtin_amdgcn_fence(__ATOMIC_RELEASE, "agent"); asm volatile("s_waitcnt vmcnt(0)" ::: "memory"); (void)xb_add(ctr, 1u); }
}
__device__ __forceinline__ void split_wait(unsigned* ctr, unsigned want) {
    if (threadIdx.x == 0) { unsigned sp = 0; while (xb_ld(ctr) < want) { __builtin_amdgcn_s_sleep(2); if (++sp > (1u << 24)) break; }
        __builtin_amdgcn_fence(__ATOMIC_ACQUIRE, "agent"); asm volatile("s_waitcnt vmcnt(0)" ::: "memory"); }
    __syncthreads();
}

constexpr int N_PHASES = 12;
struct Args { const float* in[20]; float* out; unsigned char* ws; int ph_lo, ph_hi; };

__global__ void __launch_bounds__(512, 2) fwd_megakernel(Args a) {
    extern __shared__ __attribute__((aligned(16))) unsigned char lds_raw[];
    LAS unsigned char* lds = (LAS unsigned char*)lds_raw;
    cg::grid_group grid = cg::this_grid();
    unsigned char* ws = a.ws; unsigned char* dob = (unsigned char*)a.out;
    const int lo = a.ph_lo, hi = a.ph_hi, G = gridDim.x;
#ifndef REP_ID
#define REP_ID 0
#endif
#ifndef PH_MASK
#define PH_MASK 0x1ff
#endif
#define IN(k) (((PH_MASK >> (k)) & 1) && lo <= (k) && (k) < hi)
#define SEAM(k) do { if (IN(k) && IN((k) + 1)) { xcd_barrier(xbar); } } while (0)
    volatile LAS unsigned* MISC = (volatile LAS unsigned*)(lds + 131072 + 320);
    if (threadIdx.x < 32) MISC[threadIdx.x] = 0u;
    __syncthreads();
    XcdBarrier xbar = xcd_barrier_post((unsigned*)ws, MISC + 8);
    float* MOD = (float*)(ws + WS_MOD); float* G16 = (float*)(ws + WS_G16); float* FCUM = (float*)(ws + WS_FCUM);
    bf16_t* PROJ = (bf16_t*)(ws + WS_PROJ); bf16_t* ATT = (bf16_t*)(ws + WS_ATT);
    bf16_t* BUFA = (bf16_t*)(dob + DO_A); bf16_t* BUFB = (bf16_t*)(dob + DO_B);

    unsigned* SC = (unsigned*)(ws + WS_CNT + 98304);
    if (lo > 1000) grid.sync();
    if (IN(0)) {
        p0_prologue(lds, a.in, ws, SC);
        p1_ln_gates(lds, a.in[0], MOD, (const float*)(ws + WS_WG), (const float*)(ws + WS_BG), BUFA, G16);
    }
    SEAM(0);
    if (IN(1)) {
        fscan(lds, G16, FCUM);
        pg8::Gemm g{BUFA, (const bf16_t*)(ws + WS_WT_IN), MT, NP, 1024, 1024, 1024, 0}; pg8::StaticOrder S; S.init(MT, NP, G, (int)blockIdx.x);
        pg8::EpiProj E{PROJ, NP, a.in[5], 1};
        pg8::gemm_phase(lds, g, S, E);
    }
    SEAM(1);
    if (IN(2)) {
        conv_phase(PROJ, a.in[6], a.in[7], BUFA);
        split_arrive(SC + 64);
#if FOX_REF_ATTN
        attn_phase_ref((char*)lds_raw, PROJ, FCUM, ATT);
#else
        attn_phase(lds, PROJ, FCUM, ATT);
#endif
        split_wait(SC + 64, G);
        pg8::Gemm g{BUFA, (const bf16_t*)(ws + WS_WT_QK), MT, 1024, 256, 1024, 256, 512}; pg8::StaticOrder S; S.init(MT, 1024, G, (int)blockIdx.x);
        pg8::EpiProj E{BUFB, 1024, nullptr, 0};
        pg8::gemm_phase(lds, g, S, E);
    }
    SEAM(2);
    if (IN(3)) mlstm_phase(lds, PROJ, BUFB, G16, BUFA);
    SEAM(3);
    if (IN(4)) {
        headnorm_phase(PROJ, a.in[10], BUFA);
        split_arrive(SC + 128);
        { pg8::Gemm g{ATT, (const bf16_t*)(ws + WS_WT_PA), MT, 1024, 512, 512, 512, 0}; pg8::StaticOrder S; S.init(MT, 1024, G, (int)blockIdx.x);
          pg8::EpiY<0> E{BUFB, PROJ + C_GA};
          pg8::gemm_phase(lds, g, S, E); }
        split_wait(SC + 128, G);
        { pg8::Gemm g{BUFA, (const bf16_t*)(ws + WS_WT_PB), MT, 1024, 1024, 1024, 1024, 0}; pg8::StaticOrder S; S.init(MT, 1024, G, (int)blockIdx.x);
          pg8::EpiY<1> E{BUFB, PROJ + C_GB};
          pg8::gemm_phase(lds, g, S, E); }
    }
    SEAM(4);
    if (IN(5)) {
        pg8::Gemm g{BUFB, (const bf16_t*)(ws + WS_WT_OUT), MT, 1024, 1024, 1024, 1024, 0}; pg8::StaticOrder S; S.init(MT, 1024, G, (int)blockIdx.x);
        pg8::EpiRes<0> E{(const void*)a.in[0], MOD + 2048, (bf16_t*)(ws + WS_Z)};
        pg8::gemm_phase(lds, g, S, E);
    }
    SEAM(5);
    if (IN(6)) ln_mid_phase((const bf16_t*)(ws + WS_Z), a.in[14], a.in[15], MOD, (bf16_t*)(ws + WS_X1), BUFA);
    SEAM(6);
    if (IN(7)) {
        pg8::Gemm g{BUFA, (const bf16_t*)(ws + WS_WT_FI), MT, 2 * DFF, 1024, 1024, 1024, 0}; pg8::StaticOrder S; S.init(MT, 2 * DFF, G, (int)blockIdx.x);
        pg8::EpiSwiglu E{(bf16_t*)(ws + WS_ACT)};
        pg8::gemm_phase(lds, g, S, E);
    }
    SEAM(7);
    if (IN(8)) {
        pg8::Gemm g{(const bf16_t*)(ws + WS_ACT), (const bf16_t*)(ws + WS_WT_FD), MT, 1024, DFF, DFF, DFF, 0}; pg8::StaticOrder S; S.init(MT, 1024, G, (int)blockIdx.x);
        pg8::PanelStats st{(unsigned long long*)(ws + WS_XB3), (unsigned*)(ws + WS_CNT + 65536), lds + 132096};
        pg8::EpiLnOut E{(const bf16_t*)(ws + WS_X1), MOD + 5120, a.in[18], a.in[19], a.out, st};
        pg8::gemm_phase(lds, g, S, E);
    }
#undef IN
#undef SEAM
}

extern "C" void kernel_launch(void* const* d_in, const int* in_sizes, int n_in, void* d_out, int out_size, void* d_ws, size_t ws_size, hipStream_t stream) {
    static int grid = 0;
    if (grid == 0) {
        int dev = 0, cus = 0, per_cu = 0;
        hipGetDevice(&dev);
        hipDeviceGetAttribute(&cus, hipDeviceAttributeMultiprocessorCount, dev);
        if (hipFuncSetAttribute((const void*)fwd_megakernel, hipFuncAttributeMaxDynamicSharedMemorySize, LDS_BYTES) != hipSuccess) fprintf(stderr, "kernel_launch: hipFuncSetAttribute failed\n");
        if (hipOccupancyMaxActiveBlocksPerMultiprocessor(&per_cu, (const void*)fwd_megakernel, 512, LDS_BYTES) != hipSuccess || per_cu < 1) per_cu = 1;
        (void)hipGetLastError();
        grid = cus * per_cu; if (grid <= 0) grid = 256;
    }
    (void)hipMemsetAsync(d_ws, 0, 262144, stream);
    Args a{};
    for (int i = 0; i < 20; ++i) a.in[i] = (const float*)d_in[i];
    a.out = (float*)d_out; a.ws = (unsigned char*)d_ws;
    constexpr int NPH = 9;
    const int nl = MK_N_LAUNCHES;
    for (int li = 0; li < nl; ++li) {
        a.ph_lo = (nl == 1) ? 0 : li; a.ph_hi = (nl == 1) ? NPH : li + 1;
        void* args[] = {&a};
        hipError_t e = hipLaunchCooperativeKernel((const void*)fwd_megakernel, dim3(grid), dim3(512), args, LDS_BYTES, stream);
        if (e != hipSuccess) { fprintf(stderr, "cooperative launch failed: %s (grid %d)\n", hipGetErrorString(e), grid); break; }
    }
}
```
